# Optimizing an MI355X kernel written in HIP

```python
import math
import jax
import jax.numpy as jnp
from jax import lax
import numpy as np

D_MODEL = 1024
BATCH = 8
SEQ = 2048
DEPTH = 2

CTX_LEN = 256
GRID_W = 64
N_MIXERS = 4
GROUP = D_MODEL // N_MIXERS
HEAD_DIM = 64
GROUP_HEADS = GROUP // HEAD_DIM
D_FF = ((8 * D_MODEL // 3 + 255) // 256) * 256
N_MOD = 9
NORM_EPS = 1e-6

HY_ORDER = 2
HY_SHORT_W = 3
HY_BANDS = 16
HY_EMB = 1 + 2 * HY_BANDS
HY_FILTER_HIDDEN = 64
HY_TARGET = 1e-2
HY_SHORT_DECAY_PCT = 0.3
HY_LONG_DECAY_PCT = 1.5

NA_WIN_ROWS = 8
NA_WIN_COLS = 16

DN_SHORT_W = 3
DN_CHUNK = 64

RW_DECAY_RANK = 32
RW_AAA_RANK = 32
RW_GATE_RANK = 64
RW_LN_EPS = 64e-5

HY_COLS = 3 * GROUP
NA_COLS = 3 * GROUP
DN_COLS = 4 * GROUP + 4 * GROUP_HEADS
RW_COLS = 3 * GROUP + RW_DECAY_RANK + RW_AAA_RANK + RW_GATE_RANK
P_TOTAL = HY_COLS + NA_COLS + DN_COLS + RW_COLS

kernel_name = 'hybrid_hyena_natten_deltanet_rwkv7_dit_block'


def rms_norm(x, w, eps=NORM_EPS):
    xf = x.astype(jnp.float32)
    y = xf * lax.rsqrt(jnp.mean(xf * xf, axis=-1, keepdims=True) + eps)
    return (y * w.astype(jnp.float32)).astype(x.dtype)


def l2_normalize(x, eps=1e-6):
    xf = x.astype(jnp.float32)
    return xf * lax.rsqrt(jnp.sum(xf * xf, axis=-1, keepdims=True) + eps)


def _rev(t):
    return jnp.flip(t, axis=1)


def _same(t):
    return t


def centred_dwconv(u, w):
    k_w = w.shape[0]
    pad = k_w // 2
    n = u.shape[1]
    up = jnp.pad(u, ((0, 0), (pad, pad), (0, 0)))
    out = up[:, 0:n] * w[0]
    for i in range(1, k_w):
        out = out + up[:, i:i + n] * w[i]
    return out


def token_shift_centred(u, mu):
    prev = jnp.pad(u, ((0, 0), (1, 0), (0, 0)))[:, :-1]
    nxt = jnp.pad(u, ((0, 0), (0, 1), (0, 0)))[:, 1:]
    return u + mu[0] * (prev - u) + mu[1] * (nxt - u)


def swiglu(h, w_gu, w_down):
    gate, up = jnp.split(h @ w_gu, 2, axis=-1)
    return (jax.nn.silu(gate) * up) @ w_down


def modulation(cond, w_mod, b_mod):
    m = jax.nn.silu(cond) @ w_mod + b_mod
    return m.reshape(cond.shape[:-1] + (N_MOD, D_MODEL))


def adaln(x, norm_w, mod, i):
    return rms_norm(x, norm_w) * (1.0 + mod[:, 3 * i + 1, None]) + mod[:, 3 * i, None]


def gate_of(mod, i):
    return mod[:, 3 * i + 2, None]


def hyena_filters(n, f_w1, f_b1, f_w2, f_b2, f_w3, f_freq):
    f32 = jnp.float32
    t = jnp.linspace(0.0, 1.0, n, dtype=f32)[:, None]
    ang = 2.0 * math.pi * jnp.arange(n, dtype=f32)[:, None] / n
    bands = jnp.linspace(1e-4, HY_BANDS - 1, HY_BANDS, dtype=f32)[None]
    z = jnp.concatenate([t, jnp.cos(bands * ang), -jnp.sin(bands * ang)], axis=-1)
    freq = f_freq.astype(f32)
    hid = jnp.sin(freq * (z @ f_w1.astype(f32) + f_b1.astype(f32)))
    hid = jnp.sin(freq * (hid @ f_w2.astype(f32) + f_b2.astype(f32)))
    h = (hid @ f_w3.astype(f32)).reshape(n, 2, HY_ORDER, GROUP)
    max_decay = math.log(HY_TARGET) / HY_SHORT_DECAY_PCT
    min_decay = math.log(HY_TARGET) / HY_LONG_DECAY_PCT
    deltas = jnp.linspace(min_decay, max_decay, HY_ORDER * GROUP, dtype=f32).reshape(HY_ORDER, GROUP)
    h = h * jnp.exp(-t[:, :, None, None] * jnp.abs(deltas))
    k = jnp.concatenate([h[:, 0], jnp.zeros((1, HY_ORDER, GROUP), f32), h[:0:-1, 1]], axis=0)
    return k / jnp.sum(jnp.abs(k), axis=0, keepdims=True)


def fft_longconv(u, k, bias):
    n = u.shape[1]
    uf = jnp.fft.rfft(u.astype(jnp.float32), n=2 * n, axis=1)
    kf = jnp.fft.rfft(k, n=2 * n, axis=0)
    y = jnp.fft.irfft(uf * kf[None], n=2 * n, axis=1)[:, :n]
    return (y + u.astype(jnp.float32) * bias.astype(jnp.float32)).astype(u.dtype)


def hyena_mixer(slab, conv_w, f_w1, f_b1, f_w2, f_b2, f_w3, f_freq, bias):
    u = centred_dwconv(slab, conv_w)
    v, x1, x2 = jnp.split(u, 3, axis=-1)
    k = hyena_filters(slab.shape[1], f_w1, f_b1, f_w2, f_b2, f_w3, f_freq)
    z = x1 * fft_longconv(v, k[:, 0], bias[0])
    return x2 * fft_longconv(z, k[:, 1], bias[1])


def na_qkv(slab, q_norm, k_norm):
    b, n, _ = slab.shape
    q, k, v = (t.reshape(b, n, GROUP_HEADS, HEAD_DIM) for t in jnp.split(slab, 3, axis=-1))
    return rms_norm(q, q_norm), rms_norm(k, k_norm), v


def na_latent(q, k, v, kc, vc, rpb):
    b, n, h, d = q.shape
    rows = n // GRID_W
    wr = min(NA_WIN_ROWS, rows)
    scale = d ** -0.5
    qg = q.reshape(b, rows, GRID_W, h, d)
    kg = k.reshape(b, rows, GRID_W, h, d)
    vg = v.reshape(b, rows, GRID_W, h, d)
    r = jnp.arange(rows)
    row_idx = jnp.clip(r - wr // 2, 0, rows - wr)[:, None] + jnp.arange(wr)[None]
    k_blk = kg[:, row_idx]
    v_blk = vg[:, row_idx]
    col = jnp.arange(GRID_W)
    col_start = jnp.clip(col - NA_WIN_COLS // 2, 0, GRID_W - NA_WIN_COLS)
    in_win = (col[None, :] >= col_start[:, None]) & (col[None, :] < col_start[:, None] + NA_WIN_COLS)
    d_row = row_idx - r[:, None]
    d_col = jnp.clip(col[None, :] - col[:, None], 1 - NA_WIN_COLS, NA_WIN_COLS - 1)
    bias = rpb[:, (d_row + NA_WIN_ROWS - 1)[:, None, :, None], (d_col + NA_WIN_COLS - 1)[None, :, None, :]]
    s_loc = jnp.einsum('brchd,brwjhd->bhrcwj', qg, k_blk).astype(jnp.float32) * scale
    s_loc = jnp.where(in_win[:, None, :], s_loc + bias[None].astype(jnp.float32), -jnp.inf)
    s_ctx = jnp.einsum('brchd,bmhd->bhrcm', qg, kc).astype(jnp.float32) * scale
    n_loc = wr * GRID_W
    p = jax.nn.softmax(jnp.concatenate([s_loc.reshape(b, h, rows, GRID_W, n_loc), s_ctx], axis=-1), axis=-1)
    p = p.astype(v.dtype)
    p_loc = p[..., :n_loc].reshape(b, h, rows, GRID_W, wr, GRID_W)
    o = jnp.einsum('bhrcwj,brwjhd->brchd', p_loc, v_blk) + jnp.einsum('bhrcm,bmhd->brchd', p[..., n_loc:], vc)
    return o.reshape(b, n, h * d)


def na_context(qc, kc, vc):
    b, m, h, d = qc.shape
    s = jnp.einsum('bqhd,bkhd->bhqk', qc, kc).astype(jnp.float32) * d ** -0.5
    p = jax.nn.softmax(s, axis=-1).astype(vc.dtype)
    return jnp.einsum('bhqk,bkhd->bqhd', p, vc).reshape(b, m, h * d)


def gated_delta_chunked(q, k, v, beta, g, s0):
    f32 = jnp.float32
    q, k, v, beta, g = (t.astype(f32) for t in (q, k, v, beta, g))
    b, n, h, dk = q.shape
    dv = v.shape[-1]
    n_chunks = n // DN_CHUNK

    def blocks(t):
        t = t.reshape((b, n_chunks, DN_CHUNK) + t.shape[2:])
        return jnp.moveaxis(t, 3, 1)

    q = blocks(q) * dk ** -0.5
    k, v, beta, g = blocks(k), blocks(v), blocks(beta), blocks(g)
    gcum = jnp.cumsum(g, axis=-1)
    lower = jnp.tril(jnp.ones((DN_CHUNK, DN_CHUNK), bool))
    strict = jnp.tril(jnp.ones((DN_CHUNK, DN_CHUNK), bool), -1)
    decay = jnp.exp(jnp.where(lower, gcum[..., :, None] - gcum[..., None, :], -jnp.inf))
    kb = k * beta[..., None]
    m = jnp.where(strict, jnp.einsum('bhnik,bhnjk->bhnij', kb, k) * decay, 0.0)
    rhs = jnp.concatenate([v * beta[..., None], kb * jnp.exp(gcum)[..., None]], axis=-1)
    sol = lax.linalg.triangular_solve(m, rhs, left_side=True, lower=True, unit_diagonal=True)
    u, w = sol[..., :dv], sol[..., dv:]
    attn = jnp.einsum('bhnik,bhnjk->bhnij', q, k) * decay
    q_dec = q * jnp.exp(gcum)[..., None]
    k_dec = k * jnp.exp(gcum[..., -1:] - gcum)[..., None]
    g_last = jnp.exp(gcum[..., -1])

    def step(s, xs):
        u_i, w_i, attn_i, q_i, k_i, gl_i = xs
        v_new = u_i - jnp.einsum('bhck,bhkv->bhcv', w_i, s)
        o_i = jnp.einsum('bhck,bhkv->bhcv', q_i, s) + jnp.einsum('bhij,bhjv->bhiv', attn_i, v_new)
        s = s * gl_i[..., None, None] + jnp.einsum('bhck,bhcv->bhkv', k_i, v_new)
        return s, o_i

    xs = tuple(jnp.moveaxis(t, 2, 0) for t in (u, w, attn, q_dec, k_dec, g_last))
    s_final, o = lax.scan(step, s0.astype(f32), xs)
    o = jnp.moveaxis(o, 0, 2)
    return jnp.moveaxis(o, 1, 3).reshape(b, n, h, dv), s_final


def deltanet_inputs(slab, conv_w, a_log, dt_bias):
    b, n, _ = slab.shape
    qkv = jax.nn.silu(centred_dwconv(slab[..., :3 * GROUP], conv_w))
    q, k, v = (t.reshape(b, n, GROUP_HEADS, HEAD_DIM) for t in jnp.split(qkv, 3, axis=-1))
    z = slab[..., 3 * GROUP:4 * GROUP]
    ba = slab[..., 4 * GROUP:].astype(jnp.float32).reshape(b, n, 2, 2, GROUP_HEADS)
    beta = jax.nn.sigmoid(ba[:, :, :, 0])
    g = -jnp.exp(a_log.astype(jnp.float32)) * jax.nn.softplus(ba[:, :, :, 1] + dt_bias.astype(jnp.float32))
    return l2_normalize(q), l2_normalize(k), v, z, beta, g


def deltanet_gated_out(o, z, norm_w):
    b, n = z.shape[:2]
    zh = z.reshape(b, n, GROUP_HEADS, HEAD_DIM).astype(jnp.float32)
    return (rms_norm(o, norm_w) * jax.nn.silu(zh)).reshape(b, n, GROUP)


def deltanet_mixer(slab, slab_c, conv_w, a_log, dt_bias, norm_w, need_ctx):
    q, k, v, z, beta, g = deltanet_inputs(slab, conv_w, a_log, dt_bias)
    qc, kc, vc, zc, betac, gc = deltanet_inputs(slab_c, conv_w, a_log, dt_bias)
    b = slab.shape[0]
    o_lat, o_ctx = [], []
    for d in range(2):
        orient = _rev if d == 1 else _same
        s0 = jnp.zeros((b, GROUP_HEADS, HEAD_DIM, HEAD_DIM), jnp.float32)
        oc_d, s_ctx = gated_delta_chunked(*(orient(t) for t in (qc, kc, vc, betac[:, :, d], gc[:, :, d])), s0)
        ol_d, _ = gated_delta_chunked(*(orient(t) for t in (q, k, v, beta[:, :, d], g[:, :, d])), s_ctx)
        o_lat.append(orient(ol_d))
        o_ctx.append(orient(oc_d))
    y = deltanet_gated_out(o_lat[0] + o_lat[1], z, norm_w)
    yc = deltanet_gated_out(o_ctx[0] + o_ctx[1], zc, norm_w) if need_ctx else None
    return y, yc


def rwkv7_scan(r, w, k, v, a, b, s0):
    def step(s, xs):
        r_t, w_t, k_t, v_t, a_t, b_t = xs
        s = (s * w_t[:, :, None, :]
             + jnp.einsum('bhvk,bhk->bhv', s, a_t)[..., None] * b_t[:, :, None, :]
             + v_t[..., None] * k_t[:, :, None, :])
        return s, jnp.einsum('bhvk,bhk->bhv', s, r_t)
    xs = tuple(jnp.moveaxis(t.astype(jnp.float32), 1, 0) for t in (r, w, k, v, a, b))
    s_final, y = lax.scan(step, s0, xs)
    return jnp.moveaxis(y, 0, 1), s_final


def rwkv_inputs(slab, mu, w0, w_up, a0, a_up, g_up, k_k, k_a):
    b, n, _ = slab.shape
    s = token_shift_centred(slab, mu).astype(jnp.float32)
    o1 = 3 * GROUP
    r, k, v, wd, ad, gd = jnp.split(
        s, [GROUP, 2 * GROUP, o1, o1 + RW_DECAY_RANK, o1 + RW_DECAY_RANK + RW_AAA_RANK], axis=-1)

    def heads(t):
        return t.reshape(b, n, GROUP_HEADS, HEAD_DIM)

    kk = l2_normalize(heads(k * k_k))
    dirs = []
    for d in range(2):
        w_log = -jax.nn.softplus(-(w0[d] + jnp.tanh(wd) @ w_up[d])) - 0.5
        a = jax.nn.sigmoid(a0[d] + ad @ a_up[d])
        dirs.append((heads(jnp.exp(-jnp.exp(w_log))), heads(k * (1.0 + (a - 1.0) * k_a)), heads(a)))
    g = jax.nn.sigmoid(gd) @ g_up
    return heads(r), heads(v), kk, g, dirs


def rwkv_output(y, r, v, k_dirs, g, r_k, ln_w, ln_b):
    b, n = y.shape[:2]
    mean = jnp.mean(y, axis=-1, keepdims=True)
    var = jnp.mean(jnp.square(y - mean), axis=-1, keepdims=True)
    yn = ((y - mean) * lax.rsqrt(var + RW_LN_EPS)).reshape(b, n, GROUP) * ln_w + ln_b
    bonus = (jnp.sum(r * (k_dirs[0] + k_dirs[1]) * r_k, axis=-1, keepdims=True) * v).reshape(b, n, GROUP)
    return (yn + bonus) * g


def rwkv_mixer(slab, slab_c, rw, need_ctx):
    mu, w0, w_up, a0, a_up, g_up, k_k, k_a, r_k, ln_w, ln_b = rw
    r, v, kk, g, dirs = rwkv_inputs(slab, mu, w0, w_up, a0, a_up, g_up, k_k, k_a)
    rc, vc, kkc, gc, dirs_c = rwkv_inputs(slab_c, mu, w0, w_up, a0, a_up, g_up, k_k, k_a)
    b = slab.shape[0]
    y_lat, y_ctx = [], []
    for d in range(2):
        orient = _rev if d == 1 else _same
        (w_l, k_l, a_l), (w_c, k_c, a_c) = dirs[d], dirs_c[d]
        s0 = jnp.zeros((b, GROUP_HEADS, HEAD_DIM, HEAD_DIM), jnp.float32)
        yc_d, s_ctx = rwkv7_scan(*(orient(t) for t in (rc, w_c, k_c, vc, -kkc, kkc * a_c)), s0)
        yl_d, _ = rwkv7_scan(*(orient(t) for t in (r, w_l, k_l, v, -kk, kk * a_l)), s_ctx)
        y_lat.append(orient(yl_d))
        y_ctx.append(orient(yc_d))
    y = rwkv_output(y_lat[0] + y_lat[1], r, v, [dirs[0][1], dirs[1][1]], g, r_k, ln_w, ln_b)
    if not need_ctx:
        return y, None
    yc = rwkv_output(y_ctx[0] + y_ctx[1], rc, vc, [dirs_c[0][1], dirs_c[1][1]], gc, r_k, ln_w, ln_b)
    return y, yc


def hybrid_mixer(h, hc, w_in, w_out, hy, na, dn, rw, need_ctx):
    cuts = [HY_COLS, HY_COLS + NA_COLS, HY_COLS + NA_COLS + DN_COLS]
    hy_s, na_s, dn_s, rw_s = jnp.split(h @ w_in, cuts, axis=-1)
    hy_c, na_c, dn_c, rw_c = jnp.split(hc @ w_in, cuts, axis=-1)
    q, k, v = na_qkv(na_s, na[0], na[1])
    qc, kc, vc = na_qkv(na_c, na[0], na[1])
    y_dn, yc_dn = deltanet_mixer(dn_s, dn_c, dn[0], dn[1], dn[2], dn[3], need_ctx)
    y_rw, yc_rw = rwkv_mixer(rw_s, rw_c, rw, need_ctx)
    groups = [hyena_mixer(hy_s, *hy), na_latent(q, k, v, kc, vc, na[2]), y_dn, y_rw]
    y = jnp.concatenate([t.astype(h.dtype) for t in groups], axis=-1) @ w_out
    if not need_ctx:
        return y, None
    groups_c = [hyena_mixer(hy_c, *hy), na_context(qc, kc, vc), yc_dn, yc_rw]
    yc = jnp.concatenate([t.astype(hc.dtype) for t in groups_c], axis=-1) @ w_out
    return y, yc


def setup_inputs(seed: int = 0) -> dict:
    key = jax.random.key(seed)
    keys = iter(jax.random.split(key, 48))
    f32 = jnp.float32

    def nrm(shape, scale):
        return scale * jax.random.normal(next(keys), shape, f32)

    def unif(shape, lo, hi):
        return jax.random.uniform(next(keys), shape, f32, lo, hi)

    nl, d, g, h, hd = DEPTH, D_MODEL, GROUP, GROUP_HEADS, HEAD_DIM
    dt = jnp.exp(unif((nl, 2, h), math.log(1e-3), math.log(1e-1)))
    return {
        'x': nrm((BATCH, SEQ, d), 1.0),
        'c': nrm((BATCH, d), 1.0),
        'ctx': nrm((BATCH, CTX_LEN, d), 1.0),
        'c_ctx': nrm((d,), 1.0),
        'w_mod': nrm((nl, d, N_MOD * d), 0.5 * d ** -0.5),
        'b_mod': nrm((nl, N_MOD * d), 0.02),
        'norm_w': 1.0 + nrm((nl, 3, d), 0.02),
        'ffn_w_gu': nrm((nl, 2, d, 2 * D_FF), d ** -0.5),
        'ffn_w_down': nrm((nl, 2, D_FF, d), D_FF ** -0.5),
        'w_in': nrm((nl, d, P_TOTAL), d ** -0.5),
        'w_out': nrm((nl, d, d), d ** -0.5),
        'hy_conv': nrm((nl, HY_SHORT_W, 3 * g), HY_SHORT_W ** -0.5),
        'hy_f_w1': nrm((nl, HY_EMB, HY_FILTER_HIDDEN), HY_EMB ** -0.5),
        'hy_f_b1': nrm((nl, HY_FILTER_HIDDEN), 0.02),
        'hy_f_w2': nrm((nl, HY_FILTER_HIDDEN, HY_FILTER_HIDDEN), HY_FILTER_HIDDEN ** -0.5),
        'hy_f_b2': nrm((nl, HY_FILTER_HIDDEN), 0.02),
        'hy_f_w3': nrm((nl, HY_FILTER_HIDDEN, 2 * HY_ORDER * g), HY_FILTER_HIDDEN ** -0.5),
        'hy_f_freq': 1.0 + nrm((nl, HY_FILTER_HIDDEN), 0.02),
        'hy_bias': nrm((nl, HY_ORDER, g), 0.1),
        'na_q_norm': 1.0 + nrm((nl, hd), 0.02),
        'na_k_norm': 1.0 + nrm((nl, hd), 0.02),
        'na_rpb': nrm((nl, h, 2 * NA_WIN_ROWS - 1, 2 * NA_WIN_COLS - 1), 0.1),
        'dn_conv': nrm((nl, DN_SHORT_W, 3 * g), DN_SHORT_W ** -0.5),
        'dn_a_log': jnp.log(unif((nl, 2, h), 1.0, 16.0)),
        'dn_dt_bias': dt + jnp.log(-jnp.expm1(-dt)),
        'dn_norm': 1.0 + nrm((nl, hd), 0.02),
        'rw_mu': unif((nl, 2, RW_COLS), 0.0, 0.5),
        'rw_w0': unif((nl, 2, g), -6.5, -1.5),
        'rw_w_up': nrm((nl, 2, RW_DECAY_RANK, g), 0.5 * RW_DECAY_RANK ** -0.5),
        'rw_a0': nrm((nl, 2, g), 0.1),
        'rw_a_up': nrm((nl, 2, RW_AAA_RANK, g), 0.5 * RW_AAA_RANK ** -0.5),
        'rw_g_up': nrm((nl, RW_GATE_RANK, g), RW_GATE_RANK ** -0.5),
        'rw_k_k': 0.85 + nrm((nl, g), 0.02),
        'rw_k_a': 1.0 + nrm((nl, g), 0.02),
        'rw_r_k': nrm((nl, h, hd), 0.1),
        'rw_ln_w': 1.0 + nrm((nl, g), 0.02),
        'rw_ln_b': nrm((nl, g), 0.02),
    }


def reference(x, c, ctx, c_ctx, w_mod, b_mod, norm_w, ffn_w_gu, ffn_w_down, w_in, w_out,
              hy_conv, hy_f_w1, hy_f_b1, hy_f_w2, hy_f_b2, hy_f_w3, hy_f_freq, hy_bias,
              na_q_norm, na_k_norm, na_rpb, dn_conv, dn_a_log, dn_dt_bias, dn_norm,
              rw_mu, rw_w0, rw_w_up, rw_a0, rw_a_up, rw_g_up, rw_k_k, rw_k_a, rw_r_k, rw_ln_w, rw_ln_b):
    xc = ctx
    for l in range(DEPTH):
        need_ctx = l < DEPTH - 1
        mod = modulation(c, w_mod[l], b_mod[l])
        mod_c = modulation(c_ctx, w_mod[l], b_mod[l])[None]
        x = x + 0.5 * gate_of(mod, 0) * swiglu(adaln(x, norm_w[l, 0], mod, 0), ffn_w_gu[l, 0], ffn_w_down[l, 0])
        xc = xc + 0.5 * gate_of(mod_c, 0) * swiglu(adaln(xc, norm_w[l, 0], mod_c, 0), ffn_w_gu[l, 0], ffn_w_down[l, 0])
        hy = (hy_conv[l], hy_f_w1[l], hy_f_b1[l], hy_f_w2[l], hy_f_b2[l], hy_f_w3[l], hy_f_freq[l], hy_bias[l])
        na = (na_q_norm[l], na_k_norm[l], na_rpb[l])
        dn = (dn_conv[l], dn_a_log[l], dn_dt_bias[l], dn_norm[l])
        rw = (rw_mu[l], rw_w0[l], rw_w_up[l], rw_a0[l], rw_a_up[l], rw_g_up[l], rw_k_k[l], rw_k_a[l],
              rw_r_k[l], rw_ln_w[l], rw_ln_b[l])
        y, yc = hybrid_mixer(adaln(x, norm_w[l, 1], mod, 1), adaln(xc, norm_w[l, 1], mod_c, 1),
                             w_in[l], w_out[l], hy, na, dn, rw, need_ctx)
        x = x + gate_of(mod, 1) * y
        x = x + 0.5 * gate_of(mod, 2) * swiglu(adaln(x, norm_w[l, 2], mod, 2), ffn_w_gu[l, 1], ffn_w_down[l, 1])
        if need_ctx:
            xc = xc + gate_of(mod_c, 1) * yc
            xc = xc + 0.5 * gate_of(mod_c, 2) * swiglu(adaln(xc, norm_w[l, 2], mod_c, 2), ffn_w_gu[l, 1], ffn_w_down[l, 1])
    return x
```

```cpp
#include <hip/hip_runtime.h>
#include <hip/hip_cooperative_groups.h>
#include <cstdio>
#include <cstdint>
namespace cg = cooperative_groups;

typedef unsigned short u16;
typedef short bf16x8 __attribute__((ext_vector_type(8)));
typedef short bf16x4 __attribute__((ext_vector_type(4)));
typedef float f32x4 __attribute__((ext_vector_type(4)));
typedef unsigned u32x4 __attribute__((ext_vector_type(4)));
typedef float f32x16 __attribute__((ext_vector_type(16)));
#define DEV __device__ __forceinline__

constexpr int TL = 16384, TC = 2048, TT = 18432, DM = 1024, DFF = 2816, PS = 3584;
constexpr int NA_OFF = 768, DN_OFF = 1536, RW_OFF = 2576;
constexpr int SMEM_BYTES = 147456;
#ifndef PROBE_SCAN
#define PROBE_SCAN 0
#endif
#ifndef PROBE_MODE
#define PROBE_MODE 6
#endif
#ifndef PROBE_GEMM
#define PROBE_GEMM 0
#endif
#ifndef PROBE_SYNC
#define PROBE_SYNC 0
#endif
#ifndef PROBE_P0
#define PROBE_P0 0
#endif
#ifndef PROBE_ADALN
#define PROBE_ADALN 0
#endif
#ifndef PROBE_PREP
#define PROBE_PREP 0
#endif
#ifndef PROBE_M2
#define PROBE_M2 0
#endif

constexpr size_t OFF_WGU = 0;
constexpr size_t OFF_WDN = OFF_WGU + (size_t)2 * 5632 * 1024 * 2;
constexpr size_t OFF_WIN = OFF_WDN + (size_t)2 * 1024 * 2816 * 2;
constexpr size_t OFF_WOUT = OFF_WIN + (size_t)3584 * 1024 * 2;
constexpr size_t OFF_XC = OFF_WOUT + (size_t)1024 * 1024 * 2;
constexpr size_t OFF_H = OFF_XC + (size_t)TC * 1024 * 4;
constexpr size_t OFF_MOD = OFF_H + (size_t)TT * 1024 * 2;
constexpr size_t FILT_LAYER = ((size_t)512 * 4096 + (size_t)512 * 512) * 2;
constexpr size_t OFF_FILT = OFF_MOD + (size_t)2 * 9 * 9216 * 4;
constexpr size_t OFF_FPART = OFF_FILT + 2 * FILT_LAYER;
constexpr size_t OFF_CNT = OFF_FPART + (size_t)2 * 72 * 1024 * 4;
constexpr size_t OFF_BAR = OFF_CNT + 256;
constexpr size_t BAR_BYTES = 3456 * 4;
constexpr size_t OFF_R1 = OFF_BAR + 14080;
constexpr size_t OFF_SLAB = OFF_R1;
constexpr size_t OFF_ACT = OFF_R1;
constexpr size_t OFF_HYZ = OFF_SLAB + (size_t)TT * PS * 2;
constexpr size_t OFF_HXT = OFF_HYZ + (size_t)TT * 256 * 2;
constexpr size_t OFF_DNO = OFF_HXT + (size_t)TT * 768 * 2;
constexpr size_t OFF_RWY = OFF_DNO + (size_t)TT * 256 * 4;
constexpr size_t OFF_RWL = OFF_RWY + (size_t)TT * 256 * 4;
constexpr size_t WS_TOTAL = OFF_RWL + (size_t)TT * 1024 * 2;

struct P {
  const float* in[37];
  float* out;
  unsigned char* ws;
  size_t pad_;
};
enum { I_X = 0, I_C, I_CTX, I_CCTX, I_WMOD, I_BMOD, I_NORMW, I_WGU, I_WDOWN, I_WIN, I_WOUT, I_HYCONV, I_HYW1, I_HYB1, I_HYW2,
       I_HYB2, I_HYW3, I_HYFREQ, I_HYBIAS, I_NAQN, I_NAKN, I_NARPB, I_DNCONV, I_DNALOG, I_DNDT, I_DNNORM, I_RWMU, I_RWW0,
       I_RWWUP, I_RWA0, I_RWAUP, I_RWGUP, I_RWKK, I_RWKA, I_RWRK, I_RWLNW, I_RWLNB };

typedef const P __attribute__((address_space(4)))* PC;
DEV PC launder(PC q) { asm volatile("" : "+s"(q)); return q; }
#define LOADP() PC p = launder(pk)

DEV u16 f2bf(float f) { unsigned u = __float_as_uint(f); u += 0x7fffu + ((u >> 16) & 1u); return (u16)(u >> 16); }
DEV float bf2f(u16 h) { return __uint_as_float(((unsigned)h) << 16); }
DEV float sigmoidf_(float x) { return __builtin_amdgcn_rcpf(1.f + __expf(-x)); }
DEV float siluf_(float x) { return x * __builtin_amdgcn_rcpf(1.f + __expf(-x)); }
DEV float softplusf_(float x) { return x > 20.f ? x : log1pf(__expf(x)); }
DEV float wave_sum(float v) {
#pragma unroll
  for (int o = 32; o > 0; o >>= 1) v += __shfl_xor(v, o);
  return v;
}
DEV float allred_rows(float x) {
  auto r = __builtin_amdgcn_permlane32_swap(__float_as_uint(x), __float_as_uint(x), false, false);
  float y = __uint_as_float(r[0]) + __uint_as_float(r[1]);
  auto r2 = __builtin_amdgcn_permlane16_swap(__float_as_uint(y), __float_as_uint(y), false, false);
  return __uint_as_float(r2[0]) + __uint_as_float(r2[1]);
}
DEV float allmax_rows(float x) {
  auto r = __builtin_amdgcn_permlane32_swap(__float_as_uint(x), __float_as_uint(x), false, false);
  float y = fmaxf(__uint_as_float(r[0]), __uint_as_float(r[1]));
  auto r2 = __builtin_amdgcn_permlane16_swap(__float_as_uint(y), __float_as_uint(y), false, false);
  return fmaxf(__uint_as_float(r2[0]), __uint_as_float(r2[1]));
}
DEV void unpack8(uint4 v, float* f) {
  f[0] = __uint_as_float(v.x << 16); f[1] = __uint_as_float(v.x & 0xffff0000u);
  f[2] = __uint_as_float(v.y << 16); f[3] = __uint_as_float(v.y & 0xffff0000u);
  f[4] = __uint_as_float(v.z << 16); f[5] = __uint_as_float(v.z & 0xffff0000u);
  f[6] = __uint_as_float(v.w << 16); f[7] = __uint_as_float(v.w & 0xffff0000u);
}
DEV unsigned pack2(float a, float b) { return (unsigned)f2bf(a) | ((unsigned)f2bf(b) << 16); }

DEV int TID() { int t = threadIdx.x; asm volatile("" : "+v"(t)); return t; }
DEV int BID() { int t = blockIdx.x; asm volatile("" : "+s"(t)); return t; }
DEV int NBLK() { int t = gridDim.x; asm volatile("" : "+s"(t)); return t; }
DEV int step_tok(int b, int dir, int s, int& pos, int& n) {
  if (s < 256) { n = 256; pos = dir ? 255 - s : s; return TL + b * 256 + pos; }
  n = 2048; pos = dir ? 2047 - (s - 256) : (s - 256); return b * 2048 + pos;
}

__device__ __attribute__((always_inline)) void task_mod(PC p, int task, unsigned char* smem) {
  float* sc = (float*)smem;
  float* part = (float*)(smem + 36864);
  const int tid = TID();
  for (int i = tid; i < 9 * 1024; i += 512) {
    int r = i >> 10, k = i & 1023;
    float v = (r < 8) ? p->in[I_C][r * 1024 + k] : p->in[I_CCTX][k];
    sc[i] = siluf_(v);
  }
  __syncthreads();
  const int l = task / 72, jj = tid & 127, j = (task % 72) * 128 + jj, kp = tid >> 7;
  const float* w = p->in[I_WMOD] + (size_t)l * 1024 * 9216 + j;
  float acc[9];
#pragma unroll
  for (int r = 0; r < 9; ++r) acc[r] = 0.f;
#pragma unroll 8
  for (int k = kp * 256; k < kp * 256 + 256; ++k) {
    float wv = w[(size_t)k * 9216];
#pragma unroll
    for (int r = 0; r < 9; ++r) acc[r] = fmaf(sc[r * 1024 + k], wv, acc[r]);
  }
#pragma unroll
  for (int r = 0; r < 9; ++r) part[(kp * 9 + r) * 128 + jj] = acc[r];
  __syncthreads();
  float* mod = (float*)(p->ws + OFF_MOD);
  for (int i = tid; i < 9 * 128; i += 512) {
    int r = i >> 7, c = i & 127;
    float s = part[(0 * 9 + r) * 128 + c] + part[(1 * 9 + r) * 128 + c] + part[(2 * 9 + r) * 128 + c] + part[(3 * 9 + r) * 128 + c];
    int jg = (task % 72) * 128 + c;
    mod[(size_t)(l * 9 + r) * 9216 + jg] = s + p->in[I_BMOD][l * 9216 + jg];
  }
  __syncthreads();
}

__device__ __attribute__((always_inline)) void task_filter(PC p, int task, unsigned char* smem) {
  float* z = (float*)smem;
  float* h1 = z + 32 * 34;
  float* h2t = h1 + 32 * 64;
  const int tid = TID();
  const int l = task / 72, ck = task % 72;
  const int ty = ck >= 64, n = ty ? 256 : 2048, chunk = ty ? ck - 64 : ck;
  const float* w1 = p->in[I_HYW1] + l * 33 * 64;
  const float* b1 = p->in[I_HYB1] + l * 64;
  const float* w2 = p->in[I_HYW2] + l * 64 * 64;
  const float* b2 = p->in[I_HYB2] + l * 64;
  const float* w3 = p->in[I_HYW3] + (size_t)l * 64 * 1024;
  const float* fr = p->in[I_HYFREQ] + l * 64;
  for (int i = tid; i < 32 * 33; i += 512) {
    int li = i / 33, e = i % 33;
    int lag = chunk * 32 + li;
    float v;
    if (e == 0) v = (float)lag / (float)(n - 1);
    else {
      float ang = (6.283185307179586f * (float)lag) / (float)n;
      int jb = (e - 1) & 15;
      float band = 1e-4f + (float)jb * ((15.f - 1e-4f) / 15.f);
      float a = band * ang;
      v = (e <= 16) ? cosf(a) : -sinf(a);
    }
    z[li * 34 + e] = v;
  }
  __syncthreads();
  for (int i = tid; i < 32 * 64; i += 512) {
    int li = i >> 6, m = i & 63;
    float s = b1[m];
    for (int e = 0; e < 33; ++e) s = fmaf(z[li * 34 + e], w1[e * 64 + m], s);
    h1[li * 64 + m] = sinf(fr[m] * s);
  }
  __syncthreads();
  for (int i = tid; i < 32 * 64; i += 512) {
    int li = i >> 6, m = i & 63;
    float s = b2[m];
    for (int e = 0; e < 64; ++e) s = fmaf(h1[li * 64 + e], w2[e * 64 + m], s);
    h2t[m * 32 + li] = sinf(fr[m] * s);
  }
  __syncthreads();
  u16* filt = (u16*)(p->ws + OFF_FILT + (size_t)l * FILT_LAYER) + (ty ? (size_t)512 * 4096 : 0);
  float* fpart = (float*)(p->ws + OFF_FPART) + (size_t)(l * 72 + ck) * 1024;
  const float min_decay = -4.605170185988091f / 1.5f, max_decay = -4.605170185988091f / 0.3f;
#pragma unroll 1
  for (int half = 0; half < 2; ++half) {
    const int o = tid + half * 512;
    float acc[32];
#pragma unroll
    for (int i = 0; i < 32; ++i) acc[i] = 0.f;
#pragma unroll 1
    for (int m0 = 0; m0 < 64; m0 += 8) {
      float wv8[8];
#pragma unroll
      for (int j = 0; j < 8; ++j) wv8[j] = w3[(m0 + j) * 1024 + o];
#pragma unroll
      for (int j = 0; j < 8; ++j) {
        const float wv = wv8[j];
#pragma unroll
        for (int q = 0; q < 8; ++q) {
          float4 hv = *(const float4*)(h2t + (m0 + j) * 32 + q * 4);
          acc[q * 4 + 0] = fmaf(hv.x, wv, acc[q * 4 + 0]);
          acc[q * 4 + 1] = fmaf(hv.y, wv, acc[q * 4 + 1]);
          acc[q * 4 + 2] = fmaf(hv.z, wv, acc[q * 4 + 2]);
          acc[q * 4 + 3] = fmaf(hv.w, wv, acc[q * 4 + 3]);
        }
      }
    }
    const int dir = o >> 9, oc = o & 511;
    const float delta = fabsf(min_decay + (float)oc * ((max_decay - min_decay) / 511.f));
    float asum = 0.f;
    u16* frow = filt + (size_t)oc * (2 * n);
#pragma unroll
    for (int li = 0; li < 32; ++li) {
      int lag = chunk * 32 + li;
      float t = (float)lag / (float)(n - 1);
      float v = acc[li] * __expf(-t * delta);
      if (dir == 0) { frow[n - 1 + lag] = f2bf(v); asum += fabsf(v); }
      else if (lag >= 1) { frow[n - 1 - lag] = f2bf(v); asum += fabsf(v); }
    }
    fpart[o] = asum;
  }
  __syncthreads();
}

DEV void lds_barrier() { asm volatile("s_waitcnt lgkmcnt(0)\n\ts_barrier" ::: "memory"); }
constexpr int NCONV_TILES = 2816 + 1408 + 896 + 256;
struct ConvDesc { const float* src; u16* dst; int K, N, ndt, kt, mode; };
DEV ConvDesc conv_desc(PC p, int l, int t) {
  ConvDesc d;
  if (t < 2816) {
    int f = t / 1408, r = t % 1408;
    d.src = p->in[I_WGU] + (size_t)(l * 2 + f) * 1024 * 5632; d.K = 1024; d.N = 5632; d.dst = (u16*)(p->ws + OFF_WGU) + (size_t)f * 5632 * 1024; d.ndt = r / 16; d.kt = r % 16; d.mode = 1;
  } else if (t < 2816 + 1408) {
    t -= 2816;
    int f = t / 704, r = t % 704;
    d.src = p->in[I_WDOWN] + (size_t)(l * 2 + f) * 2816 * 1024; d.K = 2816; d.N = 1024; d.dst = (u16*)(p->ws + OFF_WDN) + (size_t)f * 1024 * 2816; d.ndt = r / 44; d.kt = r % 44; d.mode = 0;
  } else if (t < 2816 + 1408 + 896) {
    t -= 2816 + 1408;
    d.src = p->in[I_WIN] + (size_t)l * 1024 * 3472; d.K = 1024; d.N = 3472; d.dst = (u16*)(p->ws + OFF_WIN); d.ndt = t / 16; d.kt = t % 16; d.mode = 2;
  } else {
    t -= 2816 + 1408 + 896;
    d.src = p->in[I_WOUT] + (size_t)l * 1024 * 1024; d.K = 1024; d.N = 1024; d.dst = (u16*)(p->ws + OFF_WOUT); d.ndt = t / 16; d.kt = t % 16; d.mode = 0;
  }
  return d;
}
DEV void conv_load(const ConvDesc& d, float* v) {
  const int tid = TID();
  const int nn = tid & 63, nd = d.ndt * 64 + nn;
  int col;
  if (d.mode == 1) { int g = nd >> 5, r = nd & 31; col = (r < 16) ? g * 16 + r : DFF + g * 16 + (r - 16); }
  else if (d.mode == 2) col = (nd < 3472) ? nd : 0;
  else col = nd;
  const float* sp = d.src + (size_t)(d.kt * 64 + (tid >> 6)) * d.N + col;
#pragma unroll
  for (int i = 0; i < 8; ++i) v[i] = sp[(size_t)(i * 8) * d.N];
}
DEV void conv_store(const ConvDesc& d, const float* v, unsigned char* smem) {
  float* tile = (float*)smem;
  const int tid = TID();
  const int nn0 = tid & 63;
  const bool pad = (d.mode == 2) && (d.ndt * 64 + nn0 >= 3472);
#pragma unroll
  for (int i = 0; i < 8; ++i) tile[((tid >> 6) + i * 8) * 65 + nn0] = pad ? 0.f : v[i];
  lds_barrier();
  {
    int nn = tid >> 3, kc = tid & 7;
    uint4 o;
    o.x = pack2(tile[(kc * 8 + 0) * 65 + nn], tile[(kc * 8 + 1) * 65 + nn]);
    o.y = pack2(tile[(kc * 8 + 2) * 65 + nn], tile[(kc * 8 + 3) * 65 + nn]);
    o.z = pack2(tile[(kc * 8 + 4) * 65 + nn], tile[(kc * 8 + 5) * 65 + nn]);
    o.w = pack2(tile[(kc * 8 + 6) * 65 + nn], tile[(kc * 8 + 7) * 65 + nn]);
    *(uint4*)(d.dst + (size_t)(d.ndt * 64 + nn) * d.K + d.kt * 64 + kc * 8) = o;
  }
  lds_barrier();
}
__device__ __attribute__((always_inline)) void convert_all(PC p, int l, unsigned char* smem) {
  const int nb = NBLK();
  int t = BID();
  if (t >= NCONV_TILES) return;
  __syncthreads();
  float cur[8], nxt[8];
  conv_load(conv_desc(p, l, t), cur);
#pragma unroll 1
  for (; t < NCONV_TILES; t += nb) {
    const int tn = (t + nb < NCONV_TILES) ? t + nb : t;
    conv_load(conv_desc(p, l, tn), nxt);
    conv_store(conv_desc(p, l, t), cur, smem);
#pragma unroll
    for (int i = 0; i < 8; ++i) cur[i] = nxt[i];
  }
  __syncthreads();
}

__device__ __attribute__((always_inline)) void adaln_pass(PC p, int l, int sub, const float* xlat, const float* xctx, int ntok) {
  const int lane = TID() & 63, wave = TID() >> 6;
  const float* nw = p->in[I_NORMW] + (l * 3 + sub) * 1024;
  const float* mod = (const float*)(p->ws + OFF_MOD) + (size_t)l * 9 * 9216;
  u16* H = (u16*)(p->ws + OFF_H);
  const int stride = NBLK() * 8;
  for (int tok0 = BID() * 8 + wave; tok0 < ntok; tok0 += 3 * stride) {
    float4 v[3][4];
    float ss[3];
#pragma unroll
    for (int q = 0; q < 3; ++q) {
      const int tok = min(tok0 + q * stride, ntok - 1);
      const float* src = tok < TL ? xlat + (size_t)tok * 1024 : xctx + (size_t)(tok - TL) * 1024;
#pragma unroll
      for (int i = 0; i < 4; ++i) v[q][i] = *(const float4*)(src + i * 256 + lane * 4);
    }
#pragma unroll
    for (int q = 0; q < 3; ++q) {
      float a = 0.f;
#pragma unroll
      for (int i = 0; i < 4; ++i) a += v[q][i].x * v[q][i].x + v[q][i].y * v[q][i].y + v[q][i].z * v[q][i].z + v[q][i].w * v[q][i].w;
      ss[q] = a;
    }
#pragma unroll
    for (int o = 32; o > 0; o >>= 1) { ss[0] += __shfl_xor(ss[0], o); ss[1] += __shfl_xor(ss[1], o); ss[2] += __shfl_xor(ss[2], o); }
#pragma unroll
    for (int q = 0; q < 3; ++q) {
      const int tok = tok0 + q * stride;
      if (tok < ntok) {
        const int r = tok < TL ? (tok >> 11) : 8;
        const float* sh = mod + (size_t)r * 9216 + (3 * sub) * 1024;
        const float* sc = sh + 1024;
        const float rinv = rsqrtf(ss[q] * (1.f / 1024.f) + 1e-6f);
#pragma unroll
        for (int i = 0; i < 4; ++i) {
          const int c = i * 256 + lane * 4;
          float4 w4 = *(const float4*)(nw + c), s4 = *(const float4*)(sc + c), h4 = *(const float4*)(sh + c);
          float a = v[q][i].x * rinv * w4.x * (1.f + s4.x) + h4.x;
          float b2 = v[q][i].y * rinv * w4.y * (1.f + s4.y) + h4.y;
          float c2 = v[q][i].z * rinv * w4.z * (1.f + s4.z) + h4.z;
          float d = v[q][i].w * rinv * w4.w * (1.f + s4.w) + h4.w;
          uint2 o; o.x = pack2(a, b2); o.y = pack2(c2, d);
          *(uint2*)(H + (size_t)tok * 1024 + c) = o;
        }
      }
    }
  }
}

struct Epi {
  u16* outb; const float* xs_lat; const float* xs_ctx; float* xd_lat; float* xd_ctx; const float* gate; float coef;
};
template <int MODE, int BM = 256>
__device__ __attribute__((always_inline)) void gemm_phase(const u16* __restrict__ A, int lda, const u16* __restrict__ Bt, int K, int M, int N, Epi e, unsigned char* smem, int vbid) {
  constexpr int BUF = (256 + 128) * 72;
  constexpr int MI = BM / 64;
  constexpr int WM = BM / 4;
  u16* L = (u16*)smem;
  const int tid = TID(), lane = tid & 63, wave = tid >> 6, wm = wave >> 1, wn = wave & 1;
  const int nMt = M / BM, nNt = N / 128, ntiles = nMt * nNt, nk = K / 64;
  const int lrow = tid >> 3, lch = tid & 7;
  const int fr = lane & 15, fq = lane >> 4;
  const int nb_ = NBLK();
  const bool swz = (vbid >= 0) && (nb_ == 256) && (nMt % 8 == 0) && (nNt % 4 == 0);
  int bid_ = swz ? vbid : BID();
  asm volatile("" : "+s"(bid_));
  const int nPM = nMt >> 3, npatch = nPM * (nNt >> 2);
  for (int it = 0;; ++it) {
    int mt, nt;
    if (swz) {
      const int pi = it * 8 + (bid_ & 7);
      if (pi >= npatch) break;
      mt = (pi % nPM) * 8 + ((bid_ >> 3) & 7);
      nt = (pi / nPM) * 4 + (bid_ >> 6);
    } else {
      const int tile = bid_ + it * nb_;
      if (tile >= ntiles) break;
      mt = tile % nMt; nt = tile / nMt;
    }
    const int m0 = mt * BM, n0 = nt * 128;
    f32x4 acc[MI][4];
#pragma unroll
    for (int i = 0; i < MI; ++i)
#pragma unroll
      for (int j = 0; j < 4; ++j) acc[i][j] = (f32x4){0.f, 0.f, 0.f, 0.f};
    const u16* Ap = A + (size_t)(m0 + lrow) * lda + lch * 8;
    const u16* Bp = Bt + (size_t)(n0 + lrow) * K + lch * 8;
    u32x4 ra0[MI], rb0[2], ra1[MI], rb1[2];
#define G_LOAD(RA, RB, KT) do { const int ko_ = (KT) * 64; \
      _Pragma("unroll") for (int i = 0; i < MI; ++i) RA[i] = *(const u32x4*)(Ap + (size_t)(i * 64) * lda + ko_); \
      _Pragma("unroll") for (int i = 0; i < 2; ++i) RB[i] = *(const u32x4*)(Bp + (size_t)(i * 64) * K + ko_); } while (0)
#define L_STORE(RA, RB, BUFI) do { u16* W_ = L + (BUFI) * BUF; \
      _Pragma("unroll") for (int i = 0; i < MI; ++i) *(u32x4*)(W_ + (lrow + i * 64) * 72 + lch * 8) = RA[i]; \
      _Pragma("unroll") for (int i = 0; i < 2; ++i) *(u32x4*)(W_ + 256 * 72 + (lrow + i * 64) * 72 + lch * 8) = RB[i]; } while (0)
#define FRAGS(AF, BF, BUFI, KS) do { const u16* As = L + (BUFI) * BUF; const u16* Bs = As + 256 * 72; \
      _Pragma("unroll") for (int mi = 0; mi < MI; ++mi) AF[mi] = *(const bf16x8*)(As + (wm * WM + mi * 16 + fr) * 72 + (KS) * 32 + fq * 8); \
      _Pragma("unroll") for (int ni = 0; ni < 4; ++ni) BF[ni] = *(const bf16x8*)(Bs + (wn * 64 + ni * 16 + fr) * 72 + (KS) * 32 + fq * 8); } while (0)
#define MMA16(AF, BF) do { \
      _Pragma("unroll") for (int mi = 0; mi < MI; ++mi) \
        _Pragma("unroll") for (int ni = 0; ni < 4; ++ni) acc[mi][ni] = __builtin_amdgcn_mfma_f32_16x16x32_bf16(BF[ni], AF[mi], acc[mi][ni], 0, 0, 0); } while (0)
#define KSTEP(BUFI, RA, RB, NBUFI) do { \
      bf16x8 af0[MI], bf0[4], af1[MI], bf1[4]; \
      FRAGS(af0, bf0, BUFI, 0); \
      __builtin_amdgcn_sched_barrier(0); \
      FRAGS(af1, bf1, BUFI, 1); \
      MMA16(af0, bf0); \
      _Pragma("unroll") for (int q_ = 0; q_ < MI * 2; ++q_) { __builtin_amdgcn_sched_group_barrier(0x008, 2, 0); __builtin_amdgcn_sched_group_barrier(0x100, 1, 0); } \
      if (MI == 3) __builtin_amdgcn_sched_group_barrier(0x100, 1, 0); \
      __builtin_amdgcn_sched_barrier(0); \
      L_STORE(RA, RB, NBUFI); \
      MMA16(af1, bf1); \
      _Pragma("unroll") for (int q_ = 0; q_ < MI + 2; ++q_) { __builtin_amdgcn_sched_group_barrier(0x008, 2, 0); __builtin_amdgcn_sched_group_barrier(0x200, 1, 0); } \
      __builtin_amdgcn_sched_group_barrier(0x008, MI * 4 - 2 * (MI + 2), 0); \
      __builtin_amdgcn_sched_barrier(0); \
      } while (0)
    G_LOAD(ra0, rb0, 0);
    G_LOAD(ra1, rb1, 1);
    __syncthreads();
    L_STORE(ra0, rb0, 0);
    __syncthreads();
    for (int kt = 0; kt < nk; kt += 2) {
      G_LOAD(ra0, rb0, min(kt + 2, nk - 1));
      KSTEP(0, ra1, rb1, 1);
      lds_barrier();
      G_LOAD(ra1, rb1, min(kt + 3, nk - 1));
      KSTEP(1, ra0, rb0, 0);
      lds_barrier();
    }
    asm volatile("s_waitcnt vmcnt(0)" ::: "memory");
#undef FRAGS
#undef MMA16
#undef KSTEP
#undef G_LOAD
#undef L_STORE
    if (MODE == 0) {
#pragma unroll
      for (int mi = 0; mi < MI; ++mi) {
        const int tok = m0 + wm * WM + mi * 16 + fr;
#pragma unroll
        for (int np = 0; np < 2; ++np) {
          const int ffc = ((n0 + wn * 64) >> 1) + np * 16 + fq * 4;
          const f32x4 g = acc[mi][np * 2], u = acc[mi][np * 2 + 1];
          uint2 o;
          o.x = pack2(siluf_(g[0]) * u[0], siluf_(g[1]) * u[1]);
          o.y = pack2(siluf_(g[2]) * u[2], siluf_(g[3]) * u[3]);
          *(uint2*)(e.outb + (size_t)tok * DFF + ffc) = o;
        }
      }
    } else if (MODE == 1) {
#pragma unroll
      for (int mi = 0; mi < MI; ++mi) {
        const int tok = m0 + wm * WM + mi * 16 + fr;
        const bool isctx = tok >= TL;
        const int r = isctx ? 8 : (tok >> 11);
        const float* xs = isctx ? e.xs_ctx + (size_t)(tok - TL) * 1024 : e.xs_lat + (size_t)tok * 1024;
        float* xd = isctx ? e.xd_ctx + (size_t)(tok - TL) * 1024 : e.xd_lat + (size_t)tok * 1024;
        const float* g = e.gate + (size_t)r * 9216;
#pragma unroll
        for (int ni = 0; ni < 4; ++ni) {
          const int col = n0 + wn * 64 + ni * 16 + fq * 4;
          const float4 gv = *(const float4*)(g + col);
          const float4 xv = *(const float4*)(xs + col);
          float4 o;
          o.x = xv.x + gv.x * e.coef * acc[mi][ni][0];
          o.y = xv.y + gv.y * e.coef * acc[mi][ni][1];
          o.z = xv.z + gv.z * e.coef * acc[mi][ni][2];
          o.w = xv.w + gv.w * e.coef * acc[mi][ni][3];
          *(float4*)(xd + col) = o;
        }
        __builtin_amdgcn_sched_barrier(0);
      }
    } else {
#pragma unroll
      for (int mi = 0; mi < MI; ++mi) {
        const int tok = m0 + wm * WM + mi * 16 + fr;
#pragma unroll
        for (int ni = 0; ni < 4; ++ni) {
          const int col = n0 + wn * 64 + ni * 16 + fq * 4;
          uint2 o;
          o.x = pack2(acc[mi][ni][0], acc[mi][ni][1]);
          o.y = pack2(acc[mi][ni][2], acc[mi][ni][3]);
          *(uint2*)(e.outb + (size_t)tok * PS + col) = o;
        }
      }
    }
  }
}

template <int MODE>
__device__ __attribute__((always_inline)) void gemm_phase_big(const u16* __restrict__ A, int lda, const u16* __restrict__ Bt, int K, int M, int N, Epi e, unsigned char* smem) {
  constexpr int BUF = 512 * 72;
  u16* L = (u16*)smem;
  const int tid = TID(), lane = tid & 63, wave = tid >> 6, wm = wave >> 1, wn = wave & 1;
  const int nMt = M / 256, nNt = N / 256, ntiles = nMt * nNt, nk = K / 64;
  const int lrow = tid >> 3, lch = tid & 7;
  const int fr = lane & 15, fq = lane >> 4;
  const int nb_ = NBLK();
  for (int tile = BID(); tile < ntiles; tile += nb_) {
    const int mt = tile % nMt, nt = tile / nMt;
    const int m0 = mt * 256, n0 = nt * 256;
    f32x4 acc[4][8];
#pragma unroll
    for (int i = 0; i < 4; ++i)
#pragma unroll
      for (int j = 0; j < 8; ++j) acc[i][j] = (f32x4){0.f, 0.f, 0.f, 0.f};
    const u16* Ap = A + (size_t)(m0 + lrow) * lda + lch * 8;
    const u16* Bp = Bt + (size_t)(n0 + lrow) * K + lch * 8;
    u32x4 ra[4], rb[4];
#define G_LOADB(KT) do { const int ko_ = (KT) * 64; \
      _Pragma("unroll") for (int i = 0; i < 4; ++i) ra[i] = *(const u32x4*)(Ap + (size_t)(i * 64) * lda + ko_); \
      _Pragma("unroll") for (int i = 0; i < 4; ++i) rb[i] = *(const u32x4*)(Bp + (size_t)(i * 64) * K + ko_); } while (0)
#define L_STOREB(BUFI) do { u16* W_ = L + (BUFI) * BUF; \
      _Pragma("unroll") for (int i = 0; i < 4; ++i) *(u32x4*)(W_ + (lrow + i * 64) * 72 + lch * 8) = ra[i]; \
      _Pragma("unroll") for (int i = 0; i < 4; ++i) *(u32x4*)(W_ + 256 * 72 + (lrow + i * 64) * 72 + lch * 8) = rb[i]; } while (0)
    G_LOADB(0);
    __syncthreads();
    L_STOREB(0);
    G_LOADB(min(1, nk - 1));
    __syncthreads();
#define FRAGSB(KS) do { \
        _Pragma("unroll") for (int mi = 0; mi < 4; ++mi) af[mi] = *(const bf16x8*)(As + (wm * 64 + mi * 16 + fr) * 72 + (KS) * 32 + fq * 8); \
        _Pragma("unroll") for (int ni = 0; ni < 8; ++ni) bfr[ni] = *(const bf16x8*)(Bs + (wn * 128 + ni * 16 + fr) * 72 + (KS) * 32 + fq * 8); } while (0)
#define MMAB() do { \
        _Pragma("unroll") for (int ni = 0; ni < 8; ++ni) \
          _Pragma("unroll") for (int mi = 0; mi < 4; ++mi) acc[mi][ni] = __builtin_amdgcn_mfma_f32_16x16x32_bf16(bfr[ni], af[mi], acc[mi][ni], 0, 0, 0); } while (0)
    for (int kt = 0; kt < nk; ++kt) {
      const u16* As = L + (kt & 1) * BUF;
      const u16* Bs = As + 256 * 72;
      bf16x8 af[4], bfr[8];
      FRAGSB(0);
      __builtin_amdgcn_sched_barrier(0);
      MMAB();
      L_STOREB((kt + 1) & 1);
#pragma unroll
      for (int q_ = 0; q_ < 8; ++q_) { __builtin_amdgcn_sched_group_barrier(0x008, 4, 0); __builtin_amdgcn_sched_group_barrier(0x200, 1, 0); }
      __builtin_amdgcn_sched_barrier(0);
      G_LOADB(min(kt + 2, nk - 1));
      FRAGSB(1);
      __builtin_amdgcn_sched_barrier(0);
      MMAB();
      __builtin_amdgcn_sched_barrier(0);
      lds_barrier();
    }
#undef FRAGSB
#undef MMAB
    asm volatile("s_waitcnt vmcnt(0)" ::: "memory");
#undef G_LOADB
#undef L_STOREB
    if (MODE == 0) {
#pragma unroll
      for (int mi = 0; mi < 4; ++mi) {
        const int tok = m0 + wm * 64 + mi * 16 + fr;
#pragma unroll
        for (int np = 0; np < 4; ++np) {
          const int ffc = ((n0 + wn * 128) >> 1) + np * 16 + fq * 4;
          const f32x4 g = acc[mi][np * 2], u = acc[mi][np * 2 + 1];
          uint2 o;
          o.x = pack2(siluf_(g[0]) * u[0], siluf_(g[1]) * u[1]);
          o.y = pack2(siluf_(g[2]) * u[2], siluf_(g[3]) * u[3]);
          *(uint2*)(e.outb + (size_t)tok * DFF + ffc) = o;
        }
      }
    } else {
#pragma unroll
      for (int mi = 0; mi < 4; ++mi) {
        const int tok = m0 + wm * 64 + mi * 16 + fr;
#pragma unroll
        for (int ni = 0; ni < 8; ++ni) {
          const int col = n0 + wn * 128 + ni * 16 + fq * 4;
          uint2 o;
          o.x = pack2(acc[mi][ni][0], acc[mi][ni][1]);
          o.y = pack2(acc[mi][ni][2], acc[mi][ni][3]);
          *(uint2*)(e.outb + (size_t)tok * PS + col) = o;
        }
      }
    }
  }
}

__device__ __attribute__((always_inline)) void prep_task(PC p, int l, int task, unsigned char* smem) {
  float* raw = (float*)smem;
  float* sv = raw + 34 * 64;
  const int tid = TID();
  const u16* slab = (const u16*)(p->ws + OFF_SLAB);
  const int tok0 = task * 32;
  int base, n;
  if (tok0 < TL) { base = (tok0 >> 11) << 11; n = 2048; } else { base = TL + (((tok0 - TL) >> 8) << 8); n = 256; }
  const int pos0 = tok0 - base;
  for (int i = tid; i < 34 * 64; i += 512) {
    int rr = i >> 6, j = i & 63, pos = pos0 - 1 + rr;
    raw[i] = (pos >= 0 && pos < n) ? bf2f(slab[(size_t)(base + pos) * PS + RW_OFF + 768 + j]) : 0.f;
  }
  __syncthreads();
  const float* mu = p->in[I_RWMU] + l * 2 * 896;
  for (int i = tid; i < 32 * 64; i += 512) {
    int t = i >> 6, j = i & 63;
    float u = raw[(t + 1) * 64 + j], pv = raw[t * 64 + j], nx = raw[(t + 2) * 64 + j];
    float s = u + mu[768 + j] * (pv - u) + mu[896 + 768 + j] * (nx - u);
    if (j < 32) s = tanhf(s);
    sv[i] = s;
  }
  __syncthreads();
  {
    const int c = tid & 255, d = tid >> 8;
    const float* wup = p->in[I_RWWUP] + (size_t)(l * 2 + d) * 32 * 256 + c;
    const float* aup = p->in[I_RWAUP] + (size_t)(l * 2 + d) * 32 * 256 + c;
    float wu[32], au[32];
#pragma unroll
    for (int j = 0; j < 32; ++j) { wu[j] = wup[j * 256]; au[j] = aup[j * 256]; }
    u16* rwl = (u16*)(p->ws + OFF_RWL);
    const float rw_w0 = p->in[I_RWW0][(l * 2 + d) * 256 + c], rw_a0 = p->in[I_RWA0][(l * 2 + d) * 256 + c];
#pragma unroll 2
    for (int t = 0; t < 32; ++t) {
      float aw = 0.f, aa = 0.f;
#pragma unroll
      for (int q = 0; q < 8; ++q) {
        float4 x = *(const float4*)(sv + t * 64 + q * 4);
        float4 y = *(const float4*)(sv + t * 64 + 32 + q * 4);
        aw = fmaf(x.x, wu[q * 4], aw); aw = fmaf(x.y, wu[q * 4 + 1], aw); aw = fmaf(x.z, wu[q * 4 + 2], aw); aw = fmaf(x.w, wu[q * 4 + 3], aw);
        aa = fmaf(y.x, au[q * 4], aa); aa = fmaf(y.y, au[q * 4 + 1], aa); aa = fmaf(y.z, au[q * 4 + 2], aa); aa = fmaf(y.w, au[q * 4 + 3], aa);
      }
      const float zz = -(rw_w0 + aw);
      const float sp = zz > 20.f ? zz : __logf(1.f + __expf(zz));
      rwl[(size_t)(tok0 + t) * 1024 + d * 512 + c] = f2bf(__expf(-sp - 0.5f));
      rwl[(size_t)(tok0 + t) * 1024 + d * 512 + 256 + c] = f2bf(sigmoidf_(rw_a0 + aa));
    }
  }
  {
    const float* hc = p->in[I_HYCONV] + l * 3 * 768;
    u16* hxt = (u16*)(p->ws + OFF_HXT);
#pragma unroll 1
    for (int cidx = tid; cidx < 768; cidx += 512) {
      const float w0 = hc[cidx], w1 = hc[768 + cidx], w2 = hc[1536 + cidx];
      float pv = pos0 > 0 ? bf2f(slab[(size_t)(tok0 - 1) * PS + cidx]) : 0.f;
      float cur = bf2f(slab[(size_t)tok0 * PS + cidx]);
      unsigned pk[16];
#pragma unroll
      for (int t = 0; t < 32; t += 2) {
        float nx0 = (pos0 + t + 1 < n) ? bf2f(slab[(size_t)(tok0 + t + 1) * PS + cidx]) : 0.f;
        float v0 = w0 * pv + w1 * cur + w2 * nx0;
        float nx1 = (pos0 + t + 2 < n) ? bf2f(slab[(size_t)(tok0 + t + 2) * PS + cidx]) : 0.f;
        float v1 = w0 * cur + w1 * nx0 + w2 * nx1;
        pk[t >> 1] = pack2(v0, v1);
        pv = nx0; cur = nx1;
      }
      uint4* dst = (uint4*)(hxt + (size_t)cidx * TT + tok0);
      dst[0] = make_uint4(pk[0], pk[1], pk[2], pk[3]);
      dst[1] = make_uint4(pk[4], pk[5], pk[6], pk[7]);
      dst[2] = make_uint4(pk[8], pk[9], pk[10], pk[11]);
      dst[3] = make_uint4(pk[12], pk[13], pk[14], pk[15]);
    }
  }
  __syncthreads();
}

typedef float f32x2 __attribute__((ext_vector_type(2)));
DEV float quad_sum(float x) {
  x += __builtin_bit_cast(float, __builtin_amdgcn_update_dpp(0, __builtin_bit_cast(int, x), 0xB1, 0xf, 0xf, true));
  x += __builtin_bit_cast(float, __builtin_amdgcn_update_dpp(0, __builtin_bit_cast(int, x), 0x4E, 0xf, 0xf, true));
  return x;
}
constexpr int DN_STRIDE = 200, RW_STRIDE = 392, CHUNK = 16, NCHUNK = 2304 / CHUNK;
DEV void ld16(f32x2* o, const float* d) {
#pragma unroll
  for (int i = 0; i < 4; ++i) {
    float4 a = *(const float4*)(d + i * 4);
    o[2 * i] = (f32x2){a.x, a.y};
    o[2 * i + 1] = (f32x2){a.z, a.w};
  }
}
struct DnOps { f32x2 q[8], k[8]; float vv, a, be, kq; };
DEV void dn_load(DnOps& o, const float* d, int kp, int col) {
  ld16(o.q, d + kp * 16); ld16(o.k, d + 64 + kp * 16);
  o.vv = d[128 + col]; o.a = d[192]; o.be = d[193]; o.kq = d[194];
}
DEV float dn_step(f32x2* S, const DnOps& c) {
  f32x2 a1 = (f32x2){0.f, 0.f}, a2 = (f32x2){0.f, 0.f};
#pragma unroll
  for (int i = 0; i < 8; ++i) { a1 = __builtin_elementwise_fma(S[i], c.k[i], a1); a2 = __builtin_elementwise_fma(S[i], c.q[i], a2); }
  const float dk = quad_sum(a1.x + a1.y), dq = quad_sum(a2.x + a2.y);
  const float cc = c.be * (c.vv - c.a * dk);
  const f32x2 a2v = (f32x2){c.a, c.a}, c2v = (f32x2){cc, cc};
#pragma unroll
  for (int i = 0; i < 8; ++i) { S[i] = S[i] * a2v; S[i] = __builtin_elementwise_fma(c.k[i], c2v, S[i]); }
  return c.a * dq + cc * c.kq;
}
struct RwOps { f32x2 wr[8], w[8], kd[8], av[8], bv[8]; float vv, s1, s2; };
DEV void rw_load(RwOps& o, const float* d, int kp, int col) {
  ld16(o.wr, d + kp * 16); ld16(o.w, d + 64 + kp * 16); ld16(o.kd, d + 128 + kp * 16); ld16(o.av, d + 192 + kp * 16); ld16(o.bv, d + 256 + kp * 16);
  o.vv = d[320 + col]; o.s1 = d[384]; o.s2 = d[385];
}
DEV float rw_step(f32x2* S, const RwOps& c) {
  f32x2 a1 = (f32x2){0.f, 0.f}, a2 = (f32x2){0.f, 0.f};
#pragma unroll
  for (int i = 0; i < 8; ++i) { a1 = __builtin_elementwise_fma(S[i], c.av[i], a1); a2 = __builtin_elementwise_fma(S[i], c.wr[i], a2); }
  const float sa = quad_sum(a1.x + a1.y), yp = quad_sum(a2.x + a2.y);
  const f32x2 sa2 = (f32x2){sa, sa}, v2 = (f32x2){c.vv, c.vv};
#pragma unroll
  for (int i = 0; i < 8; ++i) { S[i] = S[i] * c.w[i]; S[i] = __builtin_elementwise_fma(sa2, c.bv[i], S[i]); S[i] = __builtin_elementwise_fma(v2, c.kd[i], S[i]); }
  return yp + sa * c.s1 + c.vv * c.s2;
}

DEV float wave_allsum_dpp(float x) {
  x += __builtin_bit_cast(float, __builtin_amdgcn_update_dpp(0, __builtin_bit_cast(int, x), 0xB1, 0xf, 0xf, true));
  x += __builtin_bit_cast(float, __builtin_amdgcn_update_dpp(0, __builtin_bit_cast(int, x), 0x4E, 0xf, 0xf, true));
  x += __builtin_bit_cast(float, __builtin_amdgcn_update_dpp(0, __builtin_bit_cast(int, x), 0x124, 0xf, 0xf, true));
  x += __builtin_bit_cast(float, __builtin_amdgcn_update_dpp(0, __builtin_bit_cast(int, x), 0x128, 0xf, 0xf, true));
  return allred_rows(x);
}
DEV float softplus_fast(float x) { return x > 20.f ? x : __logf(1.f + __expf(x)); }

DEV float oct_sum(float x) {
  x += __builtin_bit_cast(float, __builtin_amdgcn_update_dpp(0, __builtin_bit_cast(int, x), 0xB1, 0xf, 0xf, true));
  x += __builtin_bit_cast(float, __builtin_amdgcn_update_dpp(0, __builtin_bit_cast(int, x), 0x4E, 0xf, 0xf, true));
  x += __builtin_bit_cast(float, __builtin_amdgcn_update_dpp(0, __builtin_bit_cast(int, x), 0x141, 0xf, 0xf, true));
  return x;
}
DEV void ld8(f32x2* o, const float* d) {
#pragma unroll
  for (int i = 0; i < 2; ++i) {
    float4 a = *(const float4*)(d + i * 4);
    o[2 * i] = (f32x2){a.x, a.y};
    o[2 * i + 1] = (f32x2){a.z, a.w};
  }
}
struct RwOps8 { f32x2 wr[4], w[4], kd[4], av[4], bv[4]; float vv, s1, s2; };
DEV void rw_load8(RwOps8& o, const float* d, int kp, int row) {
  ld8(o.wr, d + kp * 8); ld8(o.w, d + 64 + kp * 8); ld8(o.kd, d + 128 + kp * 8); ld8(o.av, d + 192 + kp * 8); ld8(o.bv, d + 256 + kp * 8);
  o.vv = d[320 + row]; o.s1 = d[384]; o.s2 = d[385];
}
DEV float rw_step8(f32x2* S, const RwOps8& c) {
  f32x2 a1 = (f32x2){0.f, 0.f}, a2 = (f32x2){0.f, 0.f};
#pragma unroll
  for (int i = 0; i < 4; ++i) { a1 = __builtin_elementwise_fma(S[i], c.av[i], a1); a2 = __builtin_elementwise_fma(S[i], c.wr[i], a2); }
  const float sa = oct_sum(a1.x + a1.y), yp = oct_sum(a2.x + a2.y);
  const f32x2 sa2 = (f32x2){sa, sa}, v2 = (f32x2){c.vv, c.vv};
#pragma unroll
  for (int i = 0; i < 4; ++i) { S[i] = S[i] * c.w[i]; S[i] = __builtin_elementwise_fma(sa2, c.bv[i], S[i]); S[i] = __builtin_elementwise_fma(v2, c.kd[i], S[i]); }
  return yp + sa * c.s1 + c.vv * c.s2;
}

struct DnRaw { uint4 c[3], pv[3], nx[3]; unsigned xa, xb; float fp, fn; };
DEV void dn_prep_load(DnRaw& R, PC p, int b, int hd, int dir, int ci) {
  const int ptid = TID() - 256;
  const u16* slab = (const u16*)(p->ws + OFF_SLAB);
  const int st = (ptid >> 3) & 15, g = ptid & 7;
  int pos, n;
  const int tok = step_tok(b, dir, ci * CHUNK + st, pos, n);
  const int tp = pos > 0 ? tok - 1 : tok, tn = pos < n - 1 ? tok + 1 : tok;
  R.fp = pos > 0 ? 1.f : 0.f; R.fn = pos < n - 1 ? 1.f : 0.f;
#pragma unroll
  for (int v3 = 0; v3 < 3; ++v3) {
    const int col = DN_OFF + v3 * 256 + hd * 64 + g * 8;
    R.c[v3] = *(const uint4*)(slab + (size_t)tok * PS + col);
    R.pv[v3] = *(const uint4*)(slab + (size_t)tp * PS + col);
    R.nx[v3] = *(const uint4*)(slab + (size_t)tn * PS + col);
  }
  int pos2, n2;
  const int tok2 = step_tok(b, dir, ci * CHUNK + (ptid & 15), pos2, n2);
  R.xb = slab[(size_t)tok2 * PS + DN_OFF + 1024 + dir * 8 + hd];
  R.xa = slab[(size_t)tok2 * PS + DN_OFF + 1024 + dir * 8 + 4 + hd];
}
DEV void dn_prep_compute(const DnRaw& R, float* dst, const float* cw, float Aexp, float dtb) {
  const int ptid = TID() - 256;
  if (ptid < 128) {
    const int st = ptid >> 3, g = ptid & 7;
    float res[3][8];
    float ssq = 0.f, ssk = 0.f, qk = 0.f;
#pragma unroll
    for (int v3 = 0; v3 < 3; ++v3) {
      float cur[8], pv[8], nx[8];
      unpack8(R.c[v3], cur); unpack8(R.pv[v3], pv); unpack8(R.nx[v3], nx);
      const float* c0 = cw + v3 * 64 + g * 8;
#pragma unroll
      for (int e = 0; e < 8; ++e) res[v3][e] = siluf_(c0[e] * R.fp * pv[e] + c0[192 + e] * cur[e] + c0[384 + e] * R.fn * nx[e]);
    }
#pragma unroll
    for (int e = 0; e < 8; ++e) { ssq += res[0][e] * res[0][e]; ssk += res[1][e] * res[1][e]; qk += res[0][e] * res[1][e]; }
    ssq += __shfl_xor(ssq, 1); ssq += __shfl_xor(ssq, 2); ssq += __shfl_xor(ssq, 4);
    ssk += __shfl_xor(ssk, 1); ssk += __shfl_xor(ssk, 2); ssk += __shfl_xor(ssk, 4);
    qk += __shfl_xor(qk, 1); qk += __shfl_xor(qk, 2); qk += __shfl_xor(qk, 4);
    const float scq = rsqrtf(ssq + 1e-6f) * 0.125f, sck = rsqrtf(ssk + 1e-6f);
    float* d = dst + st * DN_STRIDE + g * 8;
    *(float4*)d = make_float4(res[0][0] * scq, res[0][1] * scq, res[0][2] * scq, res[0][3] * scq);
    *(float4*)(d + 4) = make_float4(res[0][4] * scq, res[0][5] * scq, res[0][6] * scq, res[0][7] * scq);
    *(float4*)(d + 64) = make_float4(res[1][0] * sck, res[1][1] * sck, res[1][2] * sck, res[1][3] * sck);
    *(float4*)(d + 68) = make_float4(res[1][4] * sck, res[1][5] * sck, res[1][6] * sck, res[1][7] * sck);
    *(float4*)(d + 128) = make_float4(res[2][0], res[2][1], res[2][2], res[2][3]);
    *(float4*)(d + 132) = make_float4(res[2][4], res[2][5], res[2][6], res[2][7]);
    if (g == 0) dst[st * DN_STRIDE + 194] = qk * scq * sck;
  } else if (ptid < 128 + CHUNK) {
    const int st = ptid - 128;
    const float g = -Aexp * softplus_fast(bf2f((u16)R.xa) + dtb);
    dst[st * DN_STRIDE + 192] = __expf(g);
    dst[st * DN_STRIDE + 193] = sigmoidf_(bf2f((u16)R.xb));
  }
}

__device__ __attribute__((always_inline)) void dn_scan_unit(PC p, int l, int unit, unsigned char* smem, const int MODE = 7) {
  const int b = unit >> 3, hd = (unit >> 1) & 3, dir = unit & 1;
  float* buf = (float*)smem;
  float* cw = buf + 2 * CHUNK * DN_STRIDE + 64;
  const int tid = TID(), wave = tid >> 6, lane = tid & 63;
  __syncthreads();
  for (int i = tid; i < 576; i += 512) {
    int tap = i / 192, rem = i % 192, v3 = rem >> 6, d = rem & 63;
    cw[i] = p->in[I_DNCONV][(l * 3 + tap) * 768 + v3 * 256 + hd * 64 + d];
  }
  const float Aexp = __expf(p->in[I_DNALOG][l * 8 + dir * 4 + hd]);
  const float dtb = p->in[I_DNDT][l * 8 + dir * 4 + hd];
  u16* dno = (u16*)(p->ws + OFF_DNO) + (size_t)dir * TT * 256;
  __syncthreads();
  f32x2 S[8];
#pragma unroll
  for (int j = 0; j < 8; ++j) S[j] = (f32x2){0.f, 0.f};
  const int kp = lane & 3, col = (wave & 3) * 16 + (lane >> 2);
  DnRaw R0, R1;
  if (wave >= 4) {
    dn_prep_load(R0, p, b, hd, dir, 0); dn_prep_compute(R0, buf, cw, Aexp, dtb);
    dn_prep_load(R0, p, b, hd, dir, 1); dn_prep_load(R1, p, b, hd, dir, 2);
  }
  __syncthreads();
#define DN_SCAN_CHUNK(CI) do { \
      const float* bb = buf + ((CI) & 1) * CHUNK * DN_STRIDE; \
      int pos, n; \
      const int tok0 = step_tok(b, dir, (CI) * CHUNK, pos, n); \
      const int tstep = dir ? -1 : 1; \
      u16* op = dno + (size_t)tok0 * 256 + hd * 64 + col; \
      DnOps A, B; \
      dn_load(A, bb, kp, col); \
      _Pragma("unroll 1") for (int st = 0; st < CHUNK; st += 2) { \
        dn_load(B, bb + (st + 1) * DN_STRIDE, kp, col); \
        const float o0 = dn_step(S, A); \
        if ((MODE & 1) && kp == 0) op[(ptrdiff_t)(st * tstep) * 256] = f2bf(o0); sink += o0; \
        dn_load(A, bb + (st + 2) * DN_STRIDE, kp, col); \
        const float o1 = dn_step(S, B); \
        if ((MODE & 1) && kp == 0) op[(ptrdiff_t)((st + 1) * tstep) * 256] = f2bf(o1); sink += o1; \
      } } while (0)
  float sink = 0.f;
  if (wave >= 4 && !(MODE & 2)) {
#pragma unroll 1
    for (int ci = 0; ci < NCHUNK; ci += 2) { lds_barrier(); lds_barrier(); }
  } else if (wave < 4 && !(MODE & 4)) {
#pragma unroll 1
    for (int ci = 0; ci < NCHUNK; ci += 2) { lds_barrier(); lds_barrier(); }
  } else if (wave >= 4) {
#pragma unroll 1
    for (int ci = 0; ci < NCHUNK; ci += 2) {
      dn_prep_compute(R0, buf + CHUNK * DN_STRIDE, cw, Aexp, dtb);
      dn_prep_load(R0, p, b, hd, dir, min(ci + 3, NCHUNK - 1));
      lds_barrier();
      if (ci + 2 < NCHUNK) dn_prep_compute(R1, buf, cw, Aexp, dtb);
      dn_prep_load(R1, p, b, hd, dir, min(ci + 4, NCHUNK - 1));
      lds_barrier();
    }
  } else {
#pragma unroll 1
    for (int ci = 0; ci < NCHUNK; ci += 2) {
      DN_SCAN_CHUNK(ci);
      lds_barrier();
      DN_SCAN_CHUNK(ci + 1);
      lds_barrier();
    }
    if (!(MODE & 1) && sink == 12345.678f) dno[col] = f2bf(sink);
  }
  asm volatile("s_waitcnt vmcnt(0)" ::: "memory");
  __syncthreads();
}

struct RwRaw { unsigned u[3][6]; unsigned wl[4], al[4]; unsigned vmask; };
DEV void rw_prep_load(RwRaw& R, PC p, int b, int hd, int dir, int ci, int pw) {
  const int lane = TID() & 63;
  const u16* slab = (const u16*)(p->ws + OFF_SLAB);
  const u16* rwl = (const u16*)(p->ws + OFF_RWL);
  const int ch = hd * 64 + lane;
  int pos0, n;
  const int tokc = step_tok(b, dir, ci * CHUNK, pos0, n);
  const int base = tokc - pos0;
  const int plo = dir ? pos0 - (pw * 4 + 3) : pos0 + pw * 4;
  unsigned vm = 0;
#pragma unroll
  for (int i = 0; i < 6; ++i) {
    const int pos = plo - 1 + i;
    const int posc = min(max(pos, 0), n - 1);
    vm |= (pos == posc ? 1u : 0u) << i;
#pragma unroll
    for (int sg = 0; sg < 3; ++sg) R.u[sg][i] = slab[(size_t)(base + posc) * PS + RW_OFF + sg * 256 + ch];
  }
  R.vmask = vm;
#pragma unroll
  for (int q = 0; q < 4; ++q) {
    const int pos = dir ? pos0 - (pw * 4 + q) : pos0 + pw * 4 + q;
    R.wl[q] = rwl[(size_t)(base + pos) * 1024 + dir * 512 + ch];
    R.al[q] = rwl[(size_t)(base + pos) * 1024 + dir * 512 + 256 + ch];
  }
}
struct RwConst { float m0[3], m1[3], kk_w, ka_w, w0, a0; };
DEV void rw_const_load(RwConst& C, PC p, int l, int hd, int dir) {
  const int lane = TID() & 63;
  const int ch = hd * 64 + lane;
  const float* mu = p->in[I_RWMU] + l * 2 * 896;
  C.kk_w = p->in[I_RWKK][l * 256 + ch]; C.ka_w = p->in[I_RWKA][l * 256 + ch];
  C.w0 = p->in[I_RWW0][(l * 2 + dir) * 256 + ch]; C.a0 = p->in[I_RWA0][(l * 2 + dir) * 256 + ch];
#pragma unroll
  for (int sg = 0; sg < 3; ++sg) { C.m0[sg] = mu[sg * 256 + ch]; C.m1[sg] = mu[896 + sg * 256 + ch]; }
}
DEV void rw_prep_compute(const RwRaw& R, const RwConst& C, int dir, float* dst, int pw) {
  const int lane = TID() & 63;
  const float kk_w = C.kk_w, ka_w = C.ka_w, w0 = C.w0, a0 = C.a0;
  float m0[3], m1[3];
#pragma unroll
  for (int sg = 0; sg < 3; ++sg) { m0[sg] = C.m0[sg]; m1[sg] = C.m1[sg]; }
  float uf[3][6];
#pragma unroll
  for (int sg = 0; sg < 3; ++sg)
#pragma unroll
    for (int i = 0; i < 6; ++i) uf[sg][i] = ((R.vmask >> i) & 1u) ? __uint_as_float(R.u[sg][i] << 16) : 0.f;
#pragma unroll
  for (int q = 0; q < 4; ++q) {
    const int st = pw * 4 + q;
    const int ic = dir ? 4 - q : 1 + q;
    float ts[3];
#pragma unroll
    for (int sg = 0; sg < 3; ++sg) {
      const float u = uf[sg][ic], pv = uf[sg][ic - 1], nx = uf[sg][ic + 1];
      ts[sg] = u + m0[sg] * (pv - u) + m1[sg] * (nx - u);
    }
    const float r = ts[0], k = ts[1], v = ts[2];
    const float kr = k * kk_w;
    const float w = __expf(-__uint_as_float(R.wl[q] << 16));
    const float a = __uint_as_float(R.al[q] << 16);
    const float kd = k * (1.f + (a - 1.f) * ka_w);
    const float ss = wave_allsum_dpp(kr * kr), t1 = wave_allsum_dpp(kr * a * r), t2 = wave_allsum_dpp(kd * r);
    const float rn = rsqrtf(ss + 1e-6f);
    const float kk = kr * rn;
    float* d = dst + st * RW_STRIDE;
    d[lane] = w * r; d[64 + lane] = w; d[128 + lane] = kd; d[192 + lane] = -kk; d[256 + lane] = kk * a; d[320 + lane] = v;
    if (lane == 0) { d[384] = t1 * rn; d[385] = t2; }
  }
}

__device__ __attribute__((always_inline)) void rw_scan_unit(PC p, int l, int hunit, unsigned char* smem, const int MODE = 7) {
  const int unit = hunit >> 1, half = hunit & 1;
  const int b = unit >> 3, hd = (unit >> 1) & 3, dir = unit & 1;
  float* buf = (float*)smem;
  const int tid = TID(), wave = tid >> 6, lane = tid & 63;
  u16* rwy = (u16*)(p->ws + OFF_RWY) + (size_t)dir * TT * 256;
  __syncthreads();
  f32x2 S[8];
#pragma unroll
  for (int j = 0; j < 8; ++j) S[j] = (f32x2){0.f, 0.f};
  const bool is_scan = wave < 4;
  const bool is_prep = wave >= 4;
  const int pw = wave & 3;
  const int kp = lane & 7, col = half * 32 + (wave & 3) * 8 + (lane >> 3);
  RwRaw R0, R1;
  RwConst C;
  rw_const_load(C, p, l, hd, dir);
  if (is_prep) {
    rw_prep_load(R0, p, b, hd, dir, 0, pw); rw_prep_compute(R0, C, dir, buf, pw);
    rw_prep_load(R0, p, b, hd, dir, 1, pw); rw_prep_load(R1, p, b, hd, dir, 2, pw);
  }
  __syncthreads();
#define RW_SCAN_CHUNK(CI) do { \
      const float* bb = buf + ((CI) & 1) * CHUNK * RW_STRIDE; \
      int pos, n; \
      const int tok0 = step_tok(b, dir, (CI) * CHUNK, pos, n); \
      const int tstep = dir ? -1 : 1; \
      u16* op = rwy + (size_t)tok0 * 256 + hd * 64 + col; \
      RwOps8 A, B; \
      rw_load8(A, bb, kp, col); \
      _Pragma("unroll 1") for (int st = 0; st < CHUNK; st += 2) { \
        rw_load8(B, bb + (st + 1) * RW_STRIDE, kp, col); \
        const float y0 = rw_step8(S, A); \
        if ((MODE & 1) && kp == 0) op[(ptrdiff_t)(st * tstep) * 256] = f2bf(y0); sink += y0; \
        rw_load8(A, bb + (st + 2) * RW_STRIDE, kp, col); \
        const float y1 = rw_step8(S, B); \
        if ((MODE & 1) && kp == 0) op[(ptrdiff_t)((st + 1) * tstep) * 256] = f2bf(y1); sink += y1; \
      } } while (0)
  float sink = 0.f;
  if ((is_prep && !(MODE & 2)) || (is_scan && !(MODE & 4))) {
#pragma unroll 1
    for (int ci = 0; ci < NCHUNK; ci += 2) { lds_barrier(); lds_barrier(); }
  } else if (is_prep) {
#pragma unroll 1
    for (int ci = 0; ci < NCHUNK; ci += 2) {
      rw_prep_compute(R0, C, dir, buf + CHUNK * RW_STRIDE, pw);
      rw_prep_load(R0, p, b, hd, dir, min(ci + 3, NCHUNK - 1), pw);
      lds_barrier();
      if (ci + 2 < NCHUNK) rw_prep_compute(R1, C, dir, buf, pw);
      rw_prep_load(R1, p, b, hd, dir, min(ci + 4, NCHUNK - 1), pw);
      lds_barrier();
    }
  } else if (is_scan) {
#pragma unroll 1
    for (int ci = 0; ci < NCHUNK; ci += 2) {
      RW_SCAN_CHUNK(ci);
      lds_barrier();
      RW_SCAN_CHUNK(ci + 1);
      lds_barrier();
    }
    if (!(MODE & 1) && sink == 12345.678f) rwy[col] = f2bf(sink);
  } else {
#pragma unroll 1
    for (int ci = 0; ci < NCHUNK; ci += 2) { lds_barrier(); lds_barrier(); }
  }
  asm volatile("s_waitcnt vmcnt(0)" ::: "memory");
  __syncthreads();
}

constexpr int USTR = 2248;
__device__ __attribute__((always_inline)) void hyena_task(PC p, int l, int order, int task, unsigned char* smem) {
  const int tid = TID(), wave = tid >> 6, lane = tid & 63;
  const int ty = task >> 8, ch = task & 255, n = ty ? 256 : 2048;
  const int oc = order * 256 + ch;
  u16* F = (u16*)smem;
  u16* Ts = F + 4096 * 8;
  u16* Us = Ts + 4096;
  const int seq0 = ty ? TL : 0;
  __syncthreads();
  {
    const u16* filt = (const u16*)(p->ws + OFF_FILT + (size_t)l * FILT_LAYER) + (ty ? (size_t)512 * 4096 : 0) + (size_t)oc * (2 * n);
    for (int i = tid * 8; i < 2 * n; i += 512 * 8) *(uint4*)(Ts + i) = *(const uint4*)(filt + i);
    const u16* Usrc = (const u16*)(p->ws + (order == 0 ? OFF_HXT : OFF_HYZ)) + (size_t)ch * TT + seq0;
    const int nch = (n + 192) / 8;
    for (int idx = tid; idx < 8 * nch; idx += 512) {
      const int b = idx / nch, c8 = idx % nch, s = c8 * 8 - 96;
      uint4 v = make_uint4(0, 0, 0, 0);
      if (s >= 0 && s < n) v = *(const uint4*)(Usrc + (size_t)b * n + s);
      *(uint4*)(Us + b * USTR + c8 * 8) = v;
    }
  }
  __syncthreads();
  for (int E = tid; E < 2 * n; E += 512) {
    unsigned w[4];
#pragma unroll
    for (int q = 0; q < 4; ++q) {
      const int x0 = E - 2 * q, x1 = E - 2 * q - 1;
      const unsigned lo = (x0 >= 0 && x0 <= 2 * n - 2) ? Ts[x0] : 0u;
      const unsigned hi = (x1 >= 0 && x1 <= 2 * n - 2) ? Ts[x1] : 0u;
      w[q] = lo | (hi << 16);
    }
    *(uint4*)(F + E * 8) = make_uint4(w[0], w[1], w[2], w[3]);
  }
  float asum = 0.f;
  {
    const float* fp = (const float*)(p->ws + OFF_FPART) + (size_t)(l * 72 + (ty ? 64 : 0)) * 1024 + oc;
    const int nck = ty ? 8 : 64;
    for (int c = 0; c < nck; ++c) asum += fp[c * 1024] + fp[c * 1024 + 512];
  }
  const float inv = 1.f / asum;
  __syncthreads();
  const int ntile = n >> 7;
  if (wave < ntile) {
    const bool two = (wave + 8) < ntile;
    f32x16 acc0, acc1;
#pragma unroll
    for (int i = 0; i < 16; ++i) { acc0[i] = 0.f; acc1[i] = 0.f; }
    const int m = lane & 31, kh = lane >> 5, dl = m >> 3, bb = m & 7;
    const u16* Bp = Us + bb * USTR + 8 * kh + 32 * dl;
    const int T0 = wave * 128;
    const int nsteps = (n + 96) / 16;
    const u16* Ap = F + (size_t)(T0 + 96 + n - 1 + m - 8 * kh) * 8;
#pragma unroll 2
    for (int st = 0; st < nsteps; ++st) {
      const bf16x8 bfrag = *(const bf16x8*)(Bp + st * 16);
      const bf16x8 a0 = *(const bf16x8*)(Ap - st * 128);
      acc0 = __builtin_amdgcn_mfma_f32_32x32x16_bf16(a0, bfrag, acc0, 0, 0, 0);
      if (two) {
        const bf16x8 a1 = *(const bf16x8*)(Ap - st * 128 + 1024 * 8);
        acc1 = __builtin_amdgcn_mfma_f32_32x32x16_bf16(a1, bfrag, acc1, 0, 0, 0);
      }
    }
    const float bias = p->in[I_HYBIAS][l * 512 + oc];
    const u16* gsrc = (const u16*)(p->ws + OFF_HXT) + (size_t)((order == 0 ? 256 : 512) + ch) * TT;
    const u16* usrc = (const u16*)(p->ws + (order == 0 ? OFF_HXT : OFF_HYZ)) + (size_t)ch * TT;
#pragma unroll
    for (int tsel = 0; tsel < 2; ++tsel) {
      if (tsel == 1 && !two) break;
      const int Tb = T0 + tsel * 1024;
#pragma unroll
      for (int rq = 0; rq < 4; ++rq) {
        const int t = Tb + 32 * dl + 8 * rq + 4 * kh;
        const size_t tok = (size_t)seq0 + (size_t)bb * n + t;
        const uint2 gx = *(const uint2*)(gsrc + tok);
        const uint2 ux = *(const uint2*)(usrc + tok);
        const float g[4] = {__uint_as_float(gx.x << 16), __uint_as_float(gx.x & 0xffff0000u), __uint_as_float(gx.y << 16), __uint_as_float(gx.y & 0xffff0000u)};
        const float u[4] = {__uint_as_float(ux.x << 16), __uint_as_float(ux.x & 0xffff0000u), __uint_as_float(ux.y << 16), __uint_as_float(ux.y & 0xffff0000u)};
        float o[4];
#pragma unroll
        for (int e = 0; e < 4; ++e) {
          const float y = (tsel == 0 ? acc0[rq * 4 + e] : acc1[rq * 4 + e]) * inv;
          o[e] = g[e] * (y + u[e] * bias);
        }
        if (order == 0) {
          uint2 ov; ov.x = pack2(o[0], o[1]); ov.y = pack2(o[2], o[3]);
          *(uint2*)((u16*)(p->ws + OFF_HYZ) + (size_t)ch * TT + tok) = ov;
        } else {
          u16* cat = (u16*)(p->ws + OFF_H);
#pragma unroll
          for (int e = 0; e < 4; ++e) cat[(tok + e) * 1024 + ch] = f2bf(o[e]);
        }
      }
    }
  }
}

__device__ __attribute__((always_inline)) void na_task(PC p, int l, int task, unsigned char* smem) {
  u16* Qs = (u16*)smem;
  u16* Ks = Qs + 128 * 72;
  u16* Vt = Ks + 64 * 72;
  float* rpbs = (float*)(Vt + 64 * 72);
  const int tid = TID(), wave = tid >> 6, lane = tid & 63;
  const int grp = wave >> 2, w4 = wave & 3;
  const u16* slab = (const u16*)(p->ws + OFF_SLAB);
  int b, hd, r0 = 0, u0 = 0, nloc = 0, qbase0, qbase1;
  const bool local = task < 512;
  if (local) {
    b = task >> 6; hd = (task >> 4) & 3; r0 = (task & 15) * 2;
    u0 = min(max(r0 - 4, 0), 24);
    nloc = min(max(r0 + 1 - 4, 0), 24) + 8 - u0;
    qbase0 = b * 2048 + r0 * 64; qbase1 = qbase0 + 64;
  } else {
    const int t2 = task - 512; b = t2 >> 3; hd = (t2 >> 1) & 3;
    qbase0 = TL + b * 256 + (t2 & 1) * 128; qbase1 = qbase0 + 64;
  }
  const int nchunks = nloc + 4;
  const int r = r0 + grp;
  const int rs = min(max(r - 4, 0), 24);
  const int qtok0 = grp ? qbase1 : qbase0;
  const float* qn = p->in[I_NAQN] + l * 64;
  const float* kn = p->in[I_NAKN] + l * 64;
  __syncthreads();
  {
    const int q = tid >> 2, dq = tid & 3;
    const int qt = (q < 64 ? qbase0 : qbase1) + (q & 63);
    float v[16];
    unpack8(*(const uint4*)(slab + (size_t)qt * PS + NA_OFF + hd * 64 + dq * 16), v);
    unpack8(*(const uint4*)(slab + (size_t)qt * PS + NA_OFF + hd * 64 + dq * 16 + 8), v + 8);
    float ss = 0.f;
#pragma unroll
    for (int e = 0; e < 16; ++e) ss += v[e] * v[e];
    ss += __shfl_xor(ss, 1); ss += __shfl_xor(ss, 2);
    const float rinv = rsqrtf(ss * (1.f / 64.f) + 1e-6f);
    uint4 o0, o1;
    o0.x = pack2(v[0] * rinv * qn[dq * 16 + 0], v[1] * rinv * qn[dq * 16 + 1]);
    o0.y = pack2(v[2] * rinv * qn[dq * 16 + 2], v[3] * rinv * qn[dq * 16 + 3]);
    o0.z = pack2(v[4] * rinv * qn[dq * 16 + 4], v[5] * rinv * qn[dq * 16 + 5]);
    o0.w = pack2(v[6] * rinv * qn[dq * 16 + 6], v[7] * rinv * qn[dq * 16 + 7]);
    o1.x = pack2(v[8] * rinv * qn[dq * 16 + 8], v[9] * rinv * qn[dq * 16 + 9]);
    o1.y = pack2(v[10] * rinv * qn[dq * 16 + 10], v[11] * rinv * qn[dq * 16 + 11]);
    o1.z = pack2(v[12] * rinv * qn[dq * 16 + 12], v[13] * rinv * qn[dq * 16 + 13]);
    o1.w = pack2(v[14] * rinv * qn[dq * 16 + 14], v[15] * rinv * qn[dq * 16 + 15]);
    *(uint4*)(Qs + q * 72 + dq * 16) = o0;
    *(uint4*)(Qs + q * 72 + dq * 16 + 8) = o1;
    for (int i = tid; i < 15 * 31; i += 512) rpbs[i] = p->in[I_NARPB][(size_t)(l * 4 + hd) * 15 * 31 + i];
  }
  const int fr = lane & 15, fq = lane >> 4;
  const int qc = w4 * 16 + fr;
  const int cs = min(max(qc - 8, 0), 48);
  float m = -1e30f, lsum = 0.f;
  f32x4 o[4];
#pragma unroll
  for (int i = 0; i < 4; ++i) o[i] = (f32x4){0.f, 0.f, 0.f, 0.f};
  bf16x8 bq[2];
  uint4 kraw, vraw;
  const int skey = tid >> 3, sdc = tid & 7;
#define NA_KTOK(CI) (((CI) < nloc) ? b * 2048 + (u0 + (CI)) * 64 : TL + b * 256 + ((CI) - nloc) * 64)
  {
    const int kt0 = NA_KTOK(0);
    kraw = *(const uint4*)(slab + (size_t)(kt0 + skey) * PS + NA_OFF + 256 + hd * 64 + sdc * 8);
    vraw = *(const uint4*)(slab + (size_t)(kt0 + skey) * PS + NA_OFF + 512 + hd * 64 + sdc * 8);
  }
#pragma unroll 1
  for (int ci = 0; ci < nchunks; ++ci) {
    __syncthreads();
    const bool lc = ci < nloc;
    const int rr = u0 + ci;
    const bool active = !lc || (rr >= rs && rr < rs + 8);
    {
      const int key = skey, dc = sdc;
      float v[8];
      unpack8(kraw, v);
      float ss = 0.f;
#pragma unroll
      for (int e = 0; e < 8; ++e) ss += v[e] * v[e];
      ss += __shfl_xor(ss, 1); ss += __shfl_xor(ss, 2); ss += __shfl_xor(ss, 4);
      const float rinv = rsqrtf(ss * (1.f / 64.f) + 1e-6f);
      uint4 ov;
      ov.x = pack2(v[0] * rinv * kn[dc * 8 + 0], v[1] * rinv * kn[dc * 8 + 1]);
      ov.y = pack2(v[2] * rinv * kn[dc * 8 + 2], v[3] * rinv * kn[dc * 8 + 3]);
      ov.z = pack2(v[4] * rinv * kn[dc * 8 + 4], v[5] * rinv * kn[dc * 8 + 5]);
      ov.w = pack2(v[6] * rinv * kn[dc * 8 + 6], v[7] * rinv * kn[dc * 8 + 7]);
      *(uint4*)(Ks + key * 72 + dc * 8) = ov;
      const unsigned w4[4] = {vraw.x, vraw.y, vraw.z, vraw.w};
#pragma unroll
      for (int e = 0; e < 4; ++e) {
        Vt[(dc * 8 + 2 * e) * 72 + key] = (u16)(w4[e] & 0xffffu);
        Vt[(dc * 8 + 2 * e + 1) * 72 + key] = (u16)(w4[e] >> 16);
      }
    }
    __syncthreads();
    if (ci + 1 < nchunks) {
      const int kt1 = NA_KTOK(ci + 1);
      kraw = *(const uint4*)(slab + (size_t)(kt1 + skey) * PS + NA_OFF + 256 + hd * 64 + sdc * 8);
      vraw = *(const uint4*)(slab + (size_t)(kt1 + skey) * PS + NA_OFF + 512 + hd * 64 + sdc * 8);
    }
    if (ci == 0) {
      bq[0] = *(const bf16x8*)(Qs + (grp * 64 + w4 * 16 + fr) * 72 + fq * 8);
      bq[1] = *(const bf16x8*)(Qs + (grp * 64 + w4 * 16 + fr) * 72 + 32 + fq * 8);
    }
    if (active) {
      f32x4 s[4];
#pragma unroll
      for (int mt = 0; mt < 4; ++mt) {
        s[mt] = (f32x4){0.f, 0.f, 0.f, 0.f};
#pragma unroll
        for (int ks = 0; ks < 2; ++ks) {
          bf16x8 a = *(const bf16x8*)(Ks + (mt * 16 + fr) * 72 + ks * 32 + fq * 8);
          s[mt] = __builtin_amdgcn_mfma_f32_16x16x32_bf16(a, bq[ks], s[mt], 0, 0, 0);
        }
      }
      float cmax = -1e30f;
#pragma unroll
      for (int mt = 0; mt < 4; ++mt)
#pragma unroll
        for (int j = 0; j < 4; ++j) {
          float v = s[mt][j] * 0.125f;
          if (lc) {
            const int kc = mt * 16 + fq * 4 + j;
            const bool ok = (kc >= cs) && (kc < cs + 16);
            int dcol = min(max(kc - qc, -15), 15);
            v = ok ? v + rpbs[(rr - r + 7) * 31 + dcol + 15] : -1e30f;
          }
          s[mt][j] = v;
          cmax = fmaxf(cmax, v);
        }
      cmax = allmax_rows(cmax);
      const float mnew = fmaxf(m, cmax);
      const float alpha = __expf(m - mnew);
      m = mnew;
      float ps = 0.f;
#pragma unroll
      for (int mt = 0; mt < 4; ++mt)
#pragma unroll
        for (int j = 0; j < 4; ++j) { float pp = __expf(s[mt][j] - mnew); s[mt][j] = pp; ps += pp; }
      lsum = lsum * alpha + ps;
#pragma unroll
      for (int dt = 0; dt < 4; ++dt) o[dt] *= alpha;
      bf16x8 pb[2];
#pragma unroll
      for (int h2 = 0; h2 < 2; ++h2) {
#pragma unroll
        for (int e = 0; e < 4; ++e) {
          pb[h2][e] = (short)f2bf(s[2 * h2][e]);
          pb[h2][4 + e] = (short)f2bf(s[2 * h2 + 1][e]);
        }
      }
#pragma unroll
      for (int dt = 0; dt < 4; ++dt)
#pragma unroll
        for (int h2 = 0; h2 < 2; ++h2) {
          bf16x4 va = *(const bf16x4*)(Vt + (dt * 16 + fr) * 72 + (2 * h2) * 16 + fq * 4);
          bf16x4 vb = *(const bf16x4*)(Vt + (dt * 16 + fr) * 72 + (2 * h2 + 1) * 16 + fq * 4);
          bf16x8 a = __builtin_shufflevector(va, vb, 0, 1, 2, 3, 4, 5, 6, 7);
          o[dt] = __builtin_amdgcn_mfma_f32_16x16x32_bf16(a, pb[h2], o[dt], 0, 0, 0);
        }
    }
  }
  {
    lsum = allred_rows(lsum);
    const float inv = 1.f / lsum;
    u16* cat = (u16*)(p->ws + OFF_H);
    const int tok = qtok0 + w4 * 16 + fr;
#pragma unroll
    for (int dt = 0; dt < 4; ++dt) {
      uint2 ov;
      ov.x = pack2(o[dt][0] * inv, o[dt][1] * inv);
      ov.y = pack2(o[dt][2] * inv, o[dt][3] * inv);
      *(uint2*)(cat + (size_t)tok * 1024 + 256 + hd * 64 + dt * 16 + fq * 4) = ov;
    }
  }
}

DEV void combine_token(PC p, int l, int tok, const float* g, const u16* slab, const u16* rwl, const u16* dno, const u16* rwy, u16* cat, const float* mu, int c4) {
    int base, n;
    if (tok < TL) { base = (tok >> 11) << 11; n = 2048; } else { base = TL + (((tok - TL) >> 8) << 8); n = 256; }
    const int pos = tok - base;
    {
      float4 ov;
      {
        const uint2 f0 = *(const uint2*)(dno + (size_t)tok * 256 + c4), f1 = *(const uint2*)(dno + (size_t)TT * 256 + (size_t)tok * 256 + c4);
        ov.x = __uint_as_float(f0.x << 16) + __uint_as_float(f1.x << 16);
        ov.y = __uint_as_float(f0.x & 0xffff0000u) + __uint_as_float(f1.x & 0xffff0000u);
        ov.z = __uint_as_float(f0.y << 16) + __uint_as_float(f1.y << 16);
        ov.w = __uint_as_float(f0.y & 0xffff0000u) + __uint_as_float(f1.y & 0xffff0000u);
      }
      float ss = ov.x * ov.x + ov.y * ov.y + ov.z * ov.z + ov.w * ov.w;
      ss += __shfl_xor(ss, 1); ss += __shfl_xor(ss, 2); ss += __shfl_xor(ss, 4); ss += __shfl_xor(ss, 8);
      const float rinv = rsqrtf(ss * (1.f / 64.f) + 1e-6f);
      const float* nw = p->in[I_DNNORM] + l * 64 + (c4 & 63);
      uint2 zz = *(const uint2*)(slab + (size_t)tok * PS + DN_OFF + 768 + c4);
      float z0 = __uint_as_float(zz.x << 16), z1 = __uint_as_float(zz.x & 0xffff0000u), z2 = __uint_as_float(zz.y << 16), z3 = __uint_as_float(zz.y & 0xffff0000u);
      uint2 o2;
      o2.x = pack2(ov.x * rinv * nw[0] * siluf_(z0), ov.y * rinv * nw[1] * siluf_(z1));
      o2.y = pack2(ov.z * rinv * nw[2] * siluf_(z2), ov.w * rinv * nw[3] * siluf_(z3));
      *(uint2*)(cat + (size_t)tok * 1024 + 512 + c4) = o2;
    }
    {
      float ts[3][4];
#pragma unroll
      for (int sgi = 0; sgi < 3; ++sgi) {
        const int col = RW_OFF + sgi * 256 + c4;
        uint2 cu = *(const uint2*)(slab + (size_t)tok * PS + col);
        uint2 pu = pos > 0 ? *(const uint2*)(slab + (size_t)(tok - 1) * PS + col) : make_uint2(0, 0);
        uint2 nu = pos < n - 1 ? *(const uint2*)(slab + (size_t)(tok + 1) * PS + col) : make_uint2(0, 0);
        float uc[4] = {__uint_as_float(cu.x << 16), __uint_as_float(cu.x & 0xffff0000u), __uint_as_float(cu.y << 16), __uint_as_float(cu.y & 0xffff0000u)};
        float up[4] = {__uint_as_float(pu.x << 16), __uint_as_float(pu.x & 0xffff0000u), __uint_as_float(pu.y << 16), __uint_as_float(pu.y & 0xffff0000u)};
        float un[4] = {__uint_as_float(nu.x << 16), __uint_as_float(nu.x & 0xffff0000u), __uint_as_float(nu.y << 16), __uint_as_float(nu.y & 0xffff0000u)};
#pragma unroll
        for (int e = 0; e < 4; ++e) ts[sgi][e] = uc[e] + mu[sgi * 256 + c4 + e] * (up[e] - uc[e]) + mu[896 + sgi * 256 + c4 + e] * (un[e] - uc[e]);
      }
      float4 yv;
      {
        const uint2 f0 = *(const uint2*)(rwy + (size_t)tok * 256 + c4), f1 = *(const uint2*)(rwy + (size_t)TT * 256 + (size_t)tok * 256 + c4);
        yv.x = __uint_as_float(f0.x << 16) + __uint_as_float(f1.x << 16);
        yv.y = __uint_as_float(f0.x & 0xffff0000u) + __uint_as_float(f1.x & 0xffff0000u);
        yv.z = __uint_as_float(f0.y << 16) + __uint_as_float(f1.y << 16);
        yv.w = __uint_as_float(f0.y & 0xffff0000u) + __uint_as_float(f1.y & 0xffff0000u);
      }
      float y[4] = {yv.x, yv.y, yv.z, yv.w};
      float sm = y[0] + y[1] + y[2] + y[3];
      sm += __shfl_xor(sm, 1); sm += __shfl_xor(sm, 2); sm += __shfl_xor(sm, 4); sm += __shfl_xor(sm, 8);
      const float mean = sm * (1.f / 64.f);
      float sq = 0.f;
#pragma unroll
      for (int e = 0; e < 4; ++e) sq += (y[e] - mean) * (y[e] - mean);
      sq += __shfl_xor(sq, 1); sq += __shfl_xor(sq, 2); sq += __shfl_xor(sq, 4); sq += __shfl_xor(sq, 8);
      const float rstd = rsqrtf(sq * (1.f / 64.f) + 64e-5f);
      uint2 al0 = *(const uint2*)(rwl + (size_t)tok * 1024 + 256 + c4);
      uint2 al1 = *(const uint2*)(rwl + (size_t)tok * 1024 + 512 + 256 + c4);
      float a0l[4] = {__uint_as_float(al0.x << 16), __uint_as_float(al0.x & 0xffff0000u), __uint_as_float(al0.y << 16), __uint_as_float(al0.y & 0xffff0000u)};
      float a1l[4] = {__uint_as_float(al1.x << 16), __uint_as_float(al1.x & 0xffff0000u), __uint_as_float(al1.y << 16), __uint_as_float(al1.y & 0xffff0000u)};
      float bs = 0.f;
#pragma unroll
      for (int e = 0; e < 4; ++e) {
        const int ch = c4 + e;
        const float a0 = a0l[e];
        const float a1 = a1l[e];
        const float ka = p->in[I_RWKA][l * 256 + ch];
        const float ksum = ts[1][e] * (2.f + (a0 + a1 - 2.f) * ka);
        bs += ts[0][e] * ksum * p->in[I_RWRK][l * 256 + ch];
      }
      bs += __shfl_xor(bs, 1); bs += __shfl_xor(bs, 2); bs += __shfl_xor(bs, 4); bs += __shfl_xor(bs, 8);
      float outv[4];
#pragma unroll
      for (int e = 0; e < 4; ++e) {
        const int ch = c4 + e;
        const float yn = (y[e] - mean) * rstd * p->in[I_RWLNW][l * 256 + ch] + p->in[I_RWLNB][l * 256 + ch];
        outv[e] = (yn + bs * ts[2][e]) * g[e];
      }
      uint2 o2; o2.x = pack2(outv[0], outv[1]); o2.y = pack2(outv[2], outv[3]);
      *(uint2*)(cat + (size_t)tok * 1024 + 768 + c4) = o2;
    }
}

__device__ __attribute__((always_inline)) void combine_pass(PC p, int l, int ntok, unsigned char* smem) {
  const int tid = TID(), wave = tid >> 6, lane = tid & 63;
  float* sg = (float*)smem + wave * 192;
  const u16* slab = (const u16*)(p->ws + OFF_SLAB);
  const u16* rwl = (const u16*)(p->ws + OFF_RWL);
  const u16* dno = (const u16*)(p->ws + OFF_DNO);
  const u16* rwy = (const u16*)(p->ws + OFF_RWY);
  u16* cat = (u16*)(p->ws + OFF_H);
  const float* mu = p->in[I_RWMU] + l * 2 * 896;
  const float* gup = p->in[I_RWGUP] + (size_t)l * 64 * 256;
  const int c4 = lane * 4;
  __syncthreads();
  for (int tok0 = (BID() * 8 + wave) * 3; tok0 < ntok; tok0 += NBLK() * 8 * 3) {
#pragma unroll
    for (int tt = 0; tt < 3; ++tt) {
      const int tok = min(tok0 + tt, ntok - 1);
      int base, n;
      if (tok < TL) { base = (tok >> 11) << 11; n = 2048; } else { base = TL + (((tok - TL) >> 8) << 8); n = 256; }
      const int pos = tok - base;
      const int col = RW_OFF + 832 + lane;
      float u = bf2f(slab[(size_t)tok * PS + col]);
      float pv = pos > 0 ? bf2f(slab[(size_t)(tok - 1) * PS + col]) : 0.f;
      float nx = pos < n - 1 ? bf2f(slab[(size_t)(tok + 1) * PS + col]) : 0.f;
      float sv = u + mu[832 + lane] * (pv - u) + mu[896 + 832 + lane] * (nx - u);
      sg[tt * 64 + lane] = sigmoidf_(sv);
    }
    float g[3][4];
#pragma unroll
    for (int tt = 0; tt < 3; ++tt)
#pragma unroll
      for (int e = 0; e < 4; ++e) g[tt][e] = 0.f;
#pragma unroll 4
    for (int j = 0; j < 64; ++j) {
      const float4 gw = *(const float4*)(gup + j * 256 + c4);
#pragma unroll
      for (int tt = 0; tt < 3; ++tt) {
        const float sj = sg[tt * 64 + j];
        g[tt][0] = fmaf(sj, gw.x, g[tt][0]); g[tt][1] = fmaf(sj, gw.y, g[tt][1]); g[tt][2] = fmaf(sj, gw.z, g[tt][2]); g[tt][3] = fmaf(sj, gw.w, g[tt][3]);
      }
    }
#pragma unroll
    for (int tt = 0; tt < 3; ++tt)
      if (tok0 + tt < ntok) combine_token(p, l, tok0 + tt, g[tt], slab, rwl, dno, rwy, cat, mu, c4);
  }
}

#ifndef XB_ALL_RELEASE
#define XB_ALL_RELEASE 0
#endif
#define XB_TMO      128
#define XB_XCNT(j)  (256  + 64 * (j))
#define XB_XSUB(j)  (1280 + 64 * (j))
#define XB_XGEN(j)  (2304 + 64 * (j))
#define XB_TOP      3328
#define XB_TOPGEN   3392
#define XB_SPIN_CAP (1u << 18)
#define LAS __attribute__((address_space(3)))
DEV unsigned xb_ld(unsigned* p) { return __hip_atomic_load(p, __ATOMIC_RELAXED, __HIP_MEMORY_SCOPE_AGENT); }
DEV unsigned xb_add(unsigned* p, unsigned v) { return __hip_atomic_fetch_add(p, v, __ATOMIC_RELAXED, __HIP_MEMORY_SCOPE_AGENT); }
DEV unsigned xb_xcc_id() { return (unsigned)__builtin_amdgcn_s_getreg((3 << 11) | 20) & 0xFu; }
#define XB_SPIN(cond, bar) do { unsigned _sp = 0; while (cond) { __builtin_amdgcn_s_sleep(1); \
    if ((++_sp & 255u) == 0u) { if (xb_ld(&(bar)[XB_TMO])) break; if (_sp > XB_SPIN_CAP) { atomicAdd(&(bar)[XB_TMO], 1u); break; } } } } while (0)
struct XcdBarrier { unsigned* bar; unsigned x; volatile LAS unsigned* st; };
DEV XcdBarrier xcd_barrier_post(unsigned* bar, volatile LAS unsigned* st) {
  XcdBarrier b; b.bar = bar; b.x = xb_xcc_id(); b.st = st;
  if (threadIdx.x == 0) (void)xb_add(&bar[XB_XCNT(b.x)], 1u);
  return b;
}
DEV void xcd_barrier_complete(unsigned* bar, unsigned x, unsigned& nloc, unsigned& nx) {
  const unsigned G = gridDim.x * gridDim.y * gridDim.z;
  unsigned sum, cnt, mine, sp = 0u;
  for (;;) {
    sum = 0u; cnt = 0u; mine = 0u;
#pragma unroll
    for (unsigned j = 0; j < 16; ++j) { const unsigned c = xb_ld(&bar[XB_XCNT(j)]); sum += c; cnt += (c > 0u) ? 1u : 0u; mine = (j == x) ? c : mine; }
    if (sum == G) break;
    __builtin_amdgcn_s_sleep(1);
    if ((++sp & 255u) == 0u) { if (xb_ld(&bar[XB_TMO])) break; if (sp > XB_SPIN_CAP) { atomicAdd(&bar[XB_TMO], 1u); break; } }
  }
  nloc = mine > 0u ? mine : 1u; nx = cnt > 0u ? cnt : 1u;
}
DEV void xcd_barrier(const XcdBarrier& b) {
  asm volatile("s_waitcnt vmcnt(0)" ::: "memory");
  __syncthreads();
  if (threadIdx.x == 0) {
    unsigned* bar = b.bar;
    __builtin_amdgcn_s_waitcnt(0);
#if XB_ALL_RELEASE
    __builtin_amdgcn_fence(__ATOMIC_RELEASE, "agent");
    asm volatile("s_waitcnt vmcnt(0)" ::: "memory");
#endif
    unsigned nloc = b.st[0], nx = b.st[1];
    if (nloc == 0u) { xcd_barrier_complete(bar, b.x, nloc, nx); b.st[0] = nloc; b.st[1] = nx; }
    const unsigned old = xb_add(&bar[XB_XSUB(b.x)], 1u);
    const unsigned gen = old / nloc;
    if (old + 1u == (gen + 1u) * nloc) {
      __builtin_amdgcn_fence(__ATOMIC_RELEASE, "agent");
      asm volatile("s_waitcnt vmcnt(0)" ::: "memory");
      const unsigned og = xb_add(&bar[XB_TOP], 1u);
      const unsigned tg = og / nx;
      if (og + 1u == (tg + 1u) * nx) xb_add(&bar[XB_TOPGEN], 1u);
      else XB_SPIN(xb_ld(&bar[XB_TOPGEN]) == tg, bar);
      __builtin_amdgcn_fence(__ATOMIC_ACQUIRE, "agent");
      xb_add(&bar[XB_XGEN(b.x)], 1u);
      asm volatile("s_waitcnt vmcnt(0)" ::: "memory");
    } else {
      XB_SPIN(xb_ld(&bar[XB_XGEN(b.x)]) == gen, bar);
      __builtin_amdgcn_fence(__ATOMIC_ACQUIRE, "agent");
      asm volatile("s_waitcnt vmcnt(0)" ::: "memory");
    }
  }
  __syncthreads();
}

DEV void ctr_barrier(unsigned* ctr, unsigned& epoch) {
  asm volatile("s_waitcnt vmcnt(0)" ::: "memory");
  __syncthreads();
  if (threadIdx.x == 0) {
    __builtin_amdgcn_fence(__ATOMIC_RELEASE, "agent");
    asm volatile("s_waitcnt vmcnt(0)" ::: "memory");
    epoch += 1;
    const unsigned target = epoch * gridDim.x;
    (void)xb_add(ctr, 1u);
    unsigned sp = 0;
    while (xb_ld(ctr) < target) { __builtin_amdgcn_s_sleep(1); if (++sp > (1u << 24)) break; }
    __builtin_amdgcn_fence(__ATOMIC_ACQUIRE, "agent");
    asm volatile("s_waitcnt vmcnt(0)" ::: "memory");
  }
  __syncthreads();
}
#ifndef USE_CTR_BARRIER
#define USE_CTR_BARRIER 0
#endif
#if USE_CTR_BARRIER
#define GBAR() ctr_barrier((unsigned*)(launder(pk)->ws + OFF_BAR), gb_epoch)
#else
#define GBAR() xcd_barrier(xb)
#endif

__global__ void __launch_bounds__(512) fwd_megakernel(P p_unused) {
  cg::grid_group grid = cg::this_grid();
  PC pk = (PC)__builtin_amdgcn_kernarg_segment_ptr();
  __shared__ __attribute__((aligned(16))) unsigned char smem[SMEM_BYTES];
  __shared__ int s_task;
  __shared__ uint4 xb_words;
  if (threadIdx.x == 0) xb_words = make_uint4(0u, 0u, 0u, 0u);
  __syncthreads();
  const XcdBarrier xb = xcd_barrier_post((unsigned*)(launder(pk)->ws + OFF_BAR), (volatile LAS unsigned*)&xb_words);
  unsigned gb_epoch = 0;
  __shared__ int s_vbid;
  if (threadIdx.x == 0) s_vbid = (int)xb_add((unsigned*)(launder(pk)->ws + OFF_CNT) + 16 + xb.x, 1u) * 8 + (int)xb.x;
  const int tid = TID();
  const int nb = NBLK(), bid = BID();

  {
    LOADP();
    for (int rep = 0; rep <= PROBE_P0; ++rep) {
      for (int t = bid; t < 144 + 144; t += nb) {
        if (t < 144) task_mod(p, t, smem);
        else task_filter(p, t - 144, smem);
      }
      convert_all(p, 0, smem);
    }
  }
  grid.sync();
  int vbid;
  {
    unsigned* bar = (unsigned*)(launder(pk)->ws + OFF_BAR);
    bool ok = (gridDim.x == 256);
    for (int j = 0; j < 16; ++j) { const unsigned c = xb_ld(&bar[XB_XCNT(j)]); ok = ok && (c == (j < 8 ? 32u : 0u)); }
    vbid = ok ? s_vbid : -1;
    vbid = __builtin_amdgcn_readfirstlane(vbid);
  }

#pragma unroll 1
  for (int l = 0; l < 2; ++l) {
    const bool need_ctx = (l == 0);
    {
      LOADP();
      if (l == 1) convert_all(p, 1, smem);
      for (int rep = 0; rep <= PROBE_ADALN; ++rep) adaln_pass(p, l, 0, (l == 0) ? p->in[I_X] : p->out, (l == 0) ? p->in[I_CTX] : (const float*)(p->ws + OFF_XC), TT);
    }
    GBAR();
    {
      LOADP();
      Epi e{}; e.outb = (u16*)(p->ws + OFF_ACT);
      for (int rep = 0; rep <= PROBE_GEMM; ++rep) gemm_phase_big<0>((const u16*)(p->ws + OFF_H), 1024, (const u16*)(p->ws + OFF_WGU), 1024, TT, 5632, e, smem);
    }
    GBAR();
    {
      LOADP();
      float* xc = (float*)(p->ws + OFF_XC);
      Epi e{}; e.xs_lat = (l == 0) ? p->in[I_X] : p->out; e.xs_ctx = (l == 0) ? p->in[I_CTX] : xc; e.xd_lat = p->out; e.xd_ctx = xc;
      e.gate = (const float*)(p->ws + OFF_MOD) + (size_t)l * 9 * 9216 + 2 * 1024; e.coef = 0.5f;
      gemm_phase<1, 192>((const u16*)(p->ws + OFF_ACT), DFF, (const u16*)(p->ws + OFF_WDN), DFF, TT, 1024, e, smem, vbid);
    }
    GBAR();
    {
      LOADP();
      for (int rep = 0; rep <= PROBE_ADALN; ++rep) adaln_pass(p, l, 1, p->out, (const float*)(p->ws + OFF_XC), TT);
    }
    GBAR();
    {
      LOADP();
      Epi e{}; e.outb = (u16*)(p->ws + OFF_SLAB);
      for (int rep = 0; rep <= PROBE_GEMM; ++rep) gemm_phase_big<2>((const u16*)(p->ws + OFF_H), 1024, (const u16*)(p->ws + OFF_WIN), 1024, TT, PS, e, smem);
    }
    GBAR();
    {
      LOADP();
      for (int rep = 0; rep <= PROBE_PREP; ++rep) for (int t = bid; t < TT / 32; t += nb) prep_task(p, l, t, smem);
    }
    GBAR();
    if (bid < 64) { LOADP(); dn_scan_unit(p, l, bid, smem); }
    else if (bid < 192) { LOADP(); rw_scan_unit(p, l, bid - 64, smem); }
    {
      const int n_hy = need_ctx ? 512 : 256;
      const int n_na = need_ctx ? 512 + 64 : 512;
      const int ntask = n_hy + n_na;
      while (true) {
        LOADP();
        __syncthreads();
        if (tid == 0) s_task = atomicAdd((int*)(p->ws + OFF_CNT) + l * 4, 1);
        __syncthreads();
        const int t = s_task;
        if (t >= ntask) break;
        if (t < n_hy) hyena_task(p, l, 0, t, smem);
        else na_task(p, l, t - n_hy, smem);
      }
    }
    GBAR();
#if PROBE_SCAN
    for (int rep = 0; rep < PROBE_SCAN; ++rep) {
      if (bid < 64) { if (!(PROBE_MODE & 8)) { LOADP(); dn_scan_unit(p, l, bid, smem, PROBE_MODE & 6); } }
      else if (bid < 192) { if (!(PROBE_MODE & 16)) { LOADP(); rw_scan_unit(p, l, bid - 64, smem, PROBE_MODE & 6); } }
      GBAR();
    }
#endif
    for (int rep = 0; rep <= PROBE_M2; ++rep) {
    {
      LOADP();
      const int n_hy = need_ctx ? 512 : 256;
      for (int t = bid; t < n_hy; t += nb) hyena_task(p, l, 1, t, smem);
    }
    {
      LOADP();
      combine_pass(p, l, need_ctx ? TT : TL, smem);
    }
    }
    GBAR();
    {
      LOADP();
      float* xc = (float*)(p->ws + OFF_XC);
      Epi e{}; e.xs_lat = p->out; e.xs_ctx = xc; e.xd_lat = p->out; e.xd_ctx = xc;
      e.gate = (const float*)(p->ws + OFF_MOD) + (size_t)l * 9 * 9216 + 5 * 1024; e.coef = 1.0f;
      if (need_ctx) gemm_phase<1, 192>((const u16*)(p->ws + OFF_H), 1024, (const u16*)(p->ws + OFF_WOUT), 1024, TT, 1024, e, smem, vbid);
      else gemm_phase<1, 256>((const u16*)(p->ws + OFF_H), 1024, (const u16*)(p->ws + OFF_WOUT), 1024, TL, 1024, e, smem, vbid);
    }
    GBAR();
    {
      LOADP();
      for (int rep = 0; rep <= PROBE_ADALN; ++rep) adaln_pass(p, l, 2, p->out, (const float*)(p->ws + OFF_XC), need_ctx ? TT : TL);
    }
    GBAR();
    {
      LOADP();
      Epi e{}; e.outb = (u16*)(p->ws + OFF_ACT);
      for (int rep = 0; rep <= PROBE_GEMM; ++rep) gemm_phase_big<0>((const u16*)(p->ws + OFF_H), 1024, (const u16*)(p->ws + OFF_WGU) + (size_t)5632 * 1024, 1024, need_ctx ? TT : TL, 5632, e, smem);
    }
    GBAR();
    {
      LOADP();
      float* xc = (float*)(p->ws + OFF_XC);
      Epi e{}; e.xs_lat = p->out; e.xs_ctx = xc; e.xd_lat = p->out; e.xd_ctx = xc;
      e.gate = (const float*)(p->ws + OFF_MOD) + (size_t)l * 9 * 9216 + 8 * 1024; e.coef = 0.5f;
      if (need_ctx) gemm_phase<1, 192>((const u16*)(p->ws + OFF_ACT), DFF, (const u16*)(p->ws + OFF_WDN) + (size_t)1024 * DFF, DFF, TT, 1024, e, smem, vbid);
      else gemm_phase<1, 256>((const u16*)(p->ws + OFF_ACT), DFF, (const u16*)(p->ws + OFF_WDN) + (size_t)1024 * DFF, DFF, TL, 1024, e, smem, vbid);
    }
    GBAR();
    for (int rep = 0; rep < PROBE_SYNC; ++rep) GBAR();
  }
}

extern "C" void kernel_launch(void* const* d_in, const int* in_sizes, int n_in, void* d_out, int out_size, void* d_ws, size_t ws_size,
                              hipStream_t stream) {
  P p{};
  for (int i = 0; i < 37; ++i) p.in[i] = (const float*)d_in[i];
  p.out = (float*)d_out;
  p.ws = (unsigned char*)d_ws;
  p.pad_ = 0;
  static int grid_blocks = 0;
  if (!grid_blocks) {
    int dev = 0, cus = 0, per_cu = 0;
    hipGetDevice(&dev);
    hipDeviceGetAttribute(&cus, hipDeviceAttributeMultiprocessorCount, dev);
    hipOccupancyMaxActiveBlocksPerMultiprocessor(&per_cu, fwd_megakernel, 512, 0);
    if (per_cu < 1) per_cu = 1;
    grid_blocks = cus;
    if (ws_size < WS_TOTAL) fprintf(stderr, "workspace too small: %zu < %zu\n", ws_size, (size_t)WS_TOTAL);
  }
  hipMemsetAsync((unsigned char*)d_ws + OFF_CNT, 0, 256 + 14080, stream);
  void* args[] = {&p};
  hipError_t e = hipLaunchCooperativeKernel((void*)fwd_megakernel, dim3(grid_blocks), dim3(512), args, 0, stream);
  if (e != hipSuccess) fprintf(stderr, "cooperative launch failed: %s (grid %d)\n", hipGetErrorString(e), grid_blocks);
}
```

```cpp
#include <hip/hip_runtime.h>
#include <hip/hip_cooperative_groups.h>
#include <cstdio>
#include <cstdint>
namespace cg = cooperative_groups;

typedef unsigned short u16;
typedef short bf16x8 __attribute__((ext_vector_type(8)));
typedef short bf16x4 __attribute__((ext_vector_type(4)));
typedef float f32x4 __attribute__((ext_vector_type(4)));
typedef unsigned u32x4 __attribute__((ext_vector_type(4)));
typedef float f32x16 __attribute__((ext_vector_type(16)));
#define DEV __device__ __forceinline__

constexpr int TL = 16384, TC = 2048, TT = 18432, DM = 1024, DFF = 2816, PS = 3584;
constexpr int NA_OFF = 768, DN_OFF = 1536, RW_OFF = 2576;
constexpr int SMEM_BYTES = 147456;
#ifndef PROBE_SCAN
#define PROBE_SCAN 0
#endif
#ifndef PROBE_MODE
#define PROBE_MODE 6
#endif
#ifndef PROBE_GEMM
#define PROBE_GEMM 0
#endif
#ifndef PROBE_SYNC
#define PROBE_SYNC 0
#endif
#ifndef PROBE_P0
#define PROBE_P0 0
#endif
#ifndef PROBE_ADALN
#define PROBE_ADALN 0
#endif
#ifndef PROBE_PREP
#define PROBE_PREP 0
#endif
#ifndef PROBE_M2
#define PROBE_M2 0
#endif

constexpr size_t OFF_WGU = 0;
constexpr size_t OFF_WDN = OFF_WGU + (size_t)2 * 5632 * 1024 * 2;
constexpr size_t OFF_WIN = OFF_WDN + (size_t)2 * 1024 * 2816 * 2;
constexpr size_t OFF_WOUT = OFF_WIN + (size_t)3584 * 1024 * 2;
constexpr size_t OFF_XC = OFF_WOUT + (size_t)1024 * 1024 * 2;
constexpr size_t OFF_H = OFF_XC + (size_t)TC * 1024 * 4;
constexpr size_t OFF_MOD = OFF_H + (size_t)TT * 1024 * 2;
constexpr size_t FILT_LAYER = ((size_t)512 * 4096 + (size_t)512 * 512) * 2;
constexpr size_t OFF_FILT = OFF_MOD + (size_t)2 * 9 * 9216 * 4;
constexpr size_t OFF_FPART = OFF_FILT + 2 * FILT_LAYER;
constexpr size_t OFF_CNT = OFF_FPART + (size_t)2 * 72 * 1024 * 4;
constexpr size_t OFF_BAR = OFF_CNT + 256;
constexpr size_t BAR_BYTES = 3456 * 4;
constexpr size_t OFF_R1 = OFF_BAR + 14080;
constexpr size_t OFF_SLAB = OFF_R1;
constexpr size_t OFF_ACT = OFF_R1;
constexpr size_t OFF_HYZ = OFF_SLAB + (size_t)TT * PS * 2;
constexpr size_t OFF_HXT = OFF_HYZ + (size_t)TT * 256 * 2;
constexpr size_t OFF_DNO = OFF_HXT + (size_t)TT * 768 * 2;
constexpr size_t OFF_RWY = OFF_DNO + (size_t)TT * 256 * 4;
constexpr size_t OFF_RWL = OFF_RWY + (size_t)TT * 256 * 4;
constexpr size_t WS_TOTAL = OFF_RWL + (size_t)TT * 1024 * 2;

struct P {
  const float* in[37];
  float* out;
  unsigned char* ws;
  size_t pad_;
};
enum { I_X = 0, I_C, I_CTX, I_CCTX, I_WMOD, I_BMOD, I_NORMW, I_WGU, I_WDOWN, I_WIN, I_WOUT, I_HYCONV, I_HYW1, I_HYB1, I_HYW2,
       I_HYB2, I_HYW3, I_HYFREQ, I_HYBIAS, I_NAQN, I_NAKN, I_NARPB, I_DNCONV, I_DNALOG, I_DNDT, I_DNNORM, I_RWMU, I_RWW0,
       I_RWWUP, I_RWA0, I_RWAUP, I_RWGUP, I_RWKK, I_RWKA, I_RWRK, I_RWLNW, I_RWLNB };

typedef const P __attribute__((address_space(4)))* PC;
DEV PC launder(PC q) { asm volatile("" : "+s"(q)); return q; }
#define LOADP() PC p = launder(pk)

DEV u16 f2bf(float f) { unsigned u = __float_as_uint(f); u += 0x7fffu + ((u >> 16) & 1u); return (u16)(u >> 16); }
DEV float bf2f(u16 h) { return __uint_as_float(((unsigned)h) << 16); }
DEV float sigmoidf_(float x) { return __builtin_amdgcn_rcpf(1.f + __expf(-x)); }
DEV float siluf_(float x) { return x * __builtin_amdgcn_rcpf(1.f + __expf(-x)); }
DEV float softplusf_(float x) { return x > 20.f ? x : log1pf(__expf(x)); }
DEV float wave_sum(float v) {
#pragma unroll
  for (int o = 32; o > 0; o >>= 1) v += __shfl_xor(v, o);
  return v;
}
DEV float allred_rows(float x) {
  auto r = __builtin_amdgcn_permlane32_swap(__float_as_uint(x), __float_as_uint(x), false, false);
  float y = __uint_as_float(r[0]) + __uint_as_float(r[1]);
  auto r2 = __builtin_amdgcn_permlane16_swap(__float_as_uint(y), __float_as_uint(y), false, false);
  return __uint_as_float(r2[0]) + __uint_as_float(r2[1]);
}
DEV float allmax_rows(float x) {
  auto r = __builtin_amdgcn_permlane32_swap(__float_as_uint(x), __float_as_uint(x), false, false);
  float y = fmaxf(__uint_as_float(r[0]), __uint_as_float(r[1]));
  auto r2 = __builtin_amdgcn_permlane16_swap(__float_as_uint(y), __float_as_uint(y), false, false);
  return fmaxf(__uint_as_float(r2[0]), __uint_as_float(r2[1]));
}
DEV void unpack8(uint4 v, float* f) {
  f[0] = __uint_as_float(v.x << 16); f[1] = __uint_as_float(v.x & 0xffff0000u);
  f[2] = __uint_as_float(v.y << 16); f[3] = __uint_as_float(v.y & 0xffff0000u);
  f[4] = __uint_as_float(v.z << 16); f[5] = __uint_as_float(v.z & 0xffff0000u);
  f[6] = __uint_as_float(v.w << 16); f[7] = __uint_as_float(v.w & 0xffff0000u);
}
DEV unsigned pack2(float a, float b) { return (unsigned)f2bf(a) | ((unsigned)f2bf(b) << 16); }

DEV int TID() { int t = threadIdx.x; asm volatile("" : "+v"(t)); return t; }
DEV int BID() { int t = blockIdx.x; asm volatile("" : "+s"(t)); return t; }
DEV int NBLK() { int t = gridDim.x; asm volatile("" : "+s"(t)); return t; }
DEV int step_tok(int b, int dir, int s, int& pos, int& n) {
  if (s < 256) { n = 256; pos = dir ? 255 - s : s; return TL + b * 256 + pos; }
  n = 2048; pos = dir ? 2047 - (s - 256) : (s - 256); return b * 2048 + pos;
}

__device__ __attribute__((always_inline)) void task_mod(PC p, int task, unsigned char* smem) {
  float* sc = (float*)smem;
  float* part = (float*)(smem + 36864);
  const int tid = TID();
  for (int i = tid; i < 9 * 1024; i += 512) {
    int r = i >> 10, k = i & 1023;
    float v = (r < 8) ? p->in[I_C][r * 1024 + k] : p->in[I_CCTX][k];
    sc[i] = siluf_(v);
  }
  __syncthreads();
  const int l = task / 72, jj = tid & 127, j = (task % 72) * 128 + jj, kp = tid >> 7;
  const float* w = p->in[I_WMOD] + (size_t)l * 1024 * 9216 + j;
  float acc[9];
#pragma unroll
  for (int r = 0; r < 9; ++r) acc[r] = 0.f;
#pragma unroll 8
  for (int k = kp * 256; k < kp * 256 + 256; ++k) {
    float wv = w[(size_t)k * 9216];
#pragma unroll
    for (int r = 0; r < 9; ++r) acc[r] = fmaf(sc[r * 1024 + k], wv, acc[r]);
  }
#pragma unroll
  for (int r = 0; r < 9; ++r) part[(kp * 9 + r) * 128 + jj] = acc[r];
  __syncthreads();
  float* mod = (float*)(p->ws + OFF_MOD);
  for (int i = tid; i < 9 * 128; i += 512) {
    int r = i >> 7, c = i & 127;
    float s = part[(0 * 9 + r) * 128 + c] + part[(1 * 9 + r) * 128 + c] + part[(2 * 9 + r) * 128 + c] + part[(3 * 9 + r) * 128 + c];
    int jg = (task % 72) * 128 + c;
    mod[(size_t)(l * 9 + r) * 9216 + jg] = s + p->in[I_BMOD][l * 9216 + jg];
  }
  __syncthreads();
}

__device__ __attribute__((always_inline)) void task_filter(PC p, int task, unsigned char* smem) {
  float* z = (float*)smem;
  float* h1 = z + 32 * 34;
  float* h2t = h1 + 32 * 64;
  const int tid = TID();
  const int l = task / 72, ck = task % 72;
  const int ty = ck >= 64, n = ty ? 256 : 2048, chunk = ty ? ck - 64 : ck;
  const float* w1 = p->in[I_HYW1] + l * 33 * 64;
  const float* b1 = p->in[I_HYB1] + l * 64;
  const float* w2 = p->in[I_HYW2] + l * 64 * 64;
  const float* b2 = p->in[I_HYB2] + l * 64;
  const float* w3 = p->in[I_HYW3] + (size_t)l * 64 * 1024;
  const float* fr = p->in[I_HYFREQ] + l * 64;
  for (int i = tid; i < 32 * 33; i += 512) {
    int li = i / 33, e = i % 33;
    int lag = chunk * 32 + li;
    float v;
    if (e == 0) v = (float)lag / (float)(n - 1);
    else {
      float ang = (6.283185307179586f * (float)lag) / (float)n;
      int jb = (e - 1) & 15;
      float band = 1e-4f + (float)jb * ((15.f - 1e-4f) / 15.f);
      float a = band * ang;
      v = (e <= 16) ? cosf(a) : -sinf(a);
    }
    z[li * 34 + e] = v;
  }
  __syncthreads();
  for (int i = tid; i < 32 * 64; i += 512) {
    int li = i >> 6, m = i & 63;
    float s = b1[m];
    for (int e = 0; e < 33; ++e) s = fmaf(z[li * 34 + e], w1[e * 64 + m], s);
    h1[li * 64 + m] = sinf(fr[m] * s);
  }
  __syncthreads();
  for (int i = tid; i < 32 * 64; i += 512) {
    int li = i >> 6, m = i & 63;
    float s = b2[m];
    for (int e = 0; e < 64; ++e) s = fmaf(h1[li * 64 + e], w2[e * 64 + m], s);
    h2t[m * 32 + li] = sinf(fr[m] * s);
  }
  __syncthreads();
  u16* filt = (u16*)(p->ws + OFF_FILT + (size_t)l * FILT_LAYER) + (ty ? (size_t)512 * 4096 : 0);
  float* fpart = (float*)(p->ws + OFF_FPART) + (size_t)(l * 72 + ck) * 1024;
  const float min_decay = -4.605170185988091f / 1.5f, max_decay = -4.605170185988091f / 0.3f;
#pragma unroll 1
  for (int half = 0; half < 2; ++half) {
    const int o = tid + half * 512;
    float acc[32];
#pragma unroll
    for (int i = 0; i < 32; ++i) acc[i] = 0.f;
#pragma unroll 1
    for (int m0 = 0; m0 < 64; m0 += 8) {
      float wv8[8];
#pragma unroll
      for (int j = 0; j < 8; ++j) wv8[j] = w3[(m0 + j) * 1024 + o];
#pragma unroll
      for (int j = 0; j < 8; ++j) {
        const float wv = wv8[j];
#pragma unroll
        for (int q = 0; q < 8; ++q) {
          float4 hv = *(const float4*)(h2t + (m0 + j) * 32 + q * 4);
          acc[q * 4 + 0] = fmaf(hv.x, wv, acc[q * 4 + 0]);
          acc[q * 4 + 1] = fmaf(hv.y, wv, acc[q * 4 + 1]);
          acc[q * 4 + 2] = fmaf(hv.z, wv, acc[q * 4 + 2]);
          acc[q * 4 + 3] = fmaf(hv.w, wv, acc[q * 4 + 3]);
        }
      }
    }
    const int dir = o >> 9, oc = o & 511;
    const float delta = fabsf(min_decay + (float)oc * ((max_decay - min_decay) / 511.f));
    float asum = 0.f;
    u16* frow = filt + (size_t)oc * (2 * n);
#pragma unroll
    for (int li = 0; li < 32; ++li) {
      int lag = chunk * 32 + li;
      float t = (float)lag / (float)(n - 1);
      float v = acc[li] * __expf(-t * delta);
      if (dir == 0) { frow[n - 1 + lag] = f2bf(v); asum += fabsf(v); }
      else if (lag >= 1) { frow[n - 1 - lag] = f2bf(v); asum += fabsf(v); }
    }
    fpart[o] = asum;
  }
  __syncthreads();
}

DEV void lds_barrier() { asm volatile("s_waitcnt lgkmcnt(0)\n\ts_barrier" ::: "memory"); }
constexpr int NCONV_TILES = 2816 + 1408 + 896 + 256;
struct ConvDesc { const float* src; u16* dst; int K, N, ndt, kt, mode; };
DEV ConvDesc conv_desc(PC p, int l, int t) {
  ConvDesc d;
  if (t < 2816) {
    int f = t / 1408, r = t % 1408;
    d.src = p->in[I_WGU] + (size_t)(l * 2 + f) * 1024 * 5632; d.K = 1024; d.N = 5632; d.dst = (u16*)(p->ws + OFF_WGU) + (size_t)f * 5632 * 1024; d.ndt = r / 16; d.kt = r % 16; d.mode = 1;
  } else if (t < 2816 + 1408) {
    t -= 2816;
    int f = t / 704, r = t % 704;
    d.src = p->in[I_WDOWN] + (size_t)(l * 2 + f) * 2816 * 1024; d.K = 2816; d.N = 1024; d.dst = (u16*)(p->ws + OFF_WDN) + (size_t)f * 1024 * 2816; d.ndt = r / 44; d.kt = r % 44; d.mode = 0;
  } else if (t < 2816 + 1408 + 896) {
    t -= 2816 + 1408;
    d.src = p->in[I_WIN] + (size_t)l * 1024 * 3472; d.K = 1024; d.N = 3472; d.dst = (u16*)(p->ws + OFF_WIN); d.ndt = t / 16; d.kt = t % 16; d.mode = 2;
  } else {
    t -= 2816 + 1408 + 896;
    d.src = p->in[I_WOUT] + (size_t)l * 1024 * 1024; d.K = 1024; d.N = 1024; d.dst = (u16*)(p->ws + OFF_WOUT); d.ndt = t / 16; d.kt = t % 16; d.mode = 0;
  }
  return d;
}
DEV void conv_load(const ConvDesc& d, float* v) {
  const int tid = TID();
  const int nn = tid & 63, nd = d.ndt * 64 + nn;
  int col;
  if (d.mode == 1) { int g = nd >> 5, r = nd & 31; col = (r < 16) ? g * 16 + r : DFF + g * 16 + (r - 16); }
  else if (d.mode == 2) col = (nd < 3472) ? nd : 0;
  else col = nd;
  const float* sp = d.src + (size_t)(d.kt * 64 + (tid >> 6)) * d.N + col;
#pragma unroll
  for (int i = 0; i < 8; ++i) v[i] = sp[(size_t)(i * 8) * d.N];
}
DEV void conv_store(const ConvDesc& d, const float* v, unsigned char* smem) {
  float* tile = (float*)smem;
  const int tid = TID();
  const int nn0 = tid & 63;
  const bool pad = (d.mode == 2) && (d.ndt * 64 + nn0 >= 3472);
#pragma unroll
  for (int i = 0; i < 8; ++i) tile[((tid >> 6) + i * 8) * 65 + nn0] = pad ? 0.f : v[i];
  lds_barrier();
  {
    int nn = tid >> 3, kc = tid & 7;
    uint4 o;
    o.x = pack2(tile[(kc * 8 + 0) * 65 + nn], tile[(kc * 8 + 1) * 65 + nn]);
    o.y = pack2(tile[(kc * 8 + 2) * 65 + nn], tile[(kc * 8 + 3) * 65 + nn]);
    o.z = pack2(tile[(kc * 8 + 4) * 65 + nn], tile[(kc * 8 + 5) * 65 + nn]);
    o.w = pack2(tile[(kc * 8 + 6) * 65 + nn], tile[(kc * 8 + 7) * 65 + nn]);
    *(uint4*)(d.dst + (size_t)(d.ndt * 64 + nn) * d.K + d.kt * 64 + kc * 8) = o;
  }
  lds_barrier();
}
__device__ __attribute__((always_inline)) void convert_all(PC p, int l, unsigned char* smem) {
  const int nb = NBLK();
  int t = BID();
  if (t >= NCONV_TILES) return;
  __syncthreads();
  float cur[8], nxt[8];
  conv_load(conv_desc(p, l, t), cur);
#pragma unroll 1
  for (; t < NCONV_TILES; t += nb) {
    const int tn = (t + nb < NCONV_TILES) ? t + nb : t;
    conv_load(conv_desc(p, l, tn), nxt);
    conv_store(conv_desc(p, l, t), cur, smem);
#pragma unroll
    for (int i = 0; i < 8; ++i) cur[i] = nxt[i];
  }
  __syncthreads();
}

__device__ __attribute__((always_inline)) void adaln_pass(PC p, int l, int sub, const float* xlat, const float* xctx, int ntok) {
  const int lane = TID() & 63, wave = TID() >> 6;
  const float* nw = p->in[I_NORMW] + (l * 3 + sub) * 1024;
  const float* mod = (const float*)(p->ws + OFF_MOD) + (size_t)l * 9 * 9216;
  u16* H = (u16*)(p->ws + OFF_H);
  for (int tok = BID() * 8 + wave; tok < ntok; tok += NBLK() * 8) {
    const float* src = tok < TL ? xlat + (size_t)tok * 1024 : xctx + (size_t)(tok - TL) * 1024;
    const int r = tok < TL ? (tok >> 11) : 8;
    const float* sh = mod + (size_t)r * 9216 + (3 * sub) * 1024;
    const float* sc = sh + 1024;
    float4 v[4];
    float ss = 0.f;
#pragma unroll
    for (int i = 0; i < 4; ++i) {
      v[i] = *(const float4*)(src + i * 256 + lane * 4);
      ss += v[i].x * v[i].x + v[i].y * v[i].y + v[i].z * v[i].z + v[i].w * v[i].w;
    }
    ss = wave_sum(ss);
    const float rinv = rsqrtf(ss * (1.f / 1024.f) + 1e-6f);
#pragma unroll
    for (int i = 0; i < 4; ++i) {
      const int c = i * 256 + lane * 4;
      float4 w4 = *(const float4*)(nw + c), s4 = *(const float4*)(sc + c), h4 = *(const float4*)(sh + c);
      float a = v[i].x * rinv * w4.x * (1.f + s4.x) + h4.x;
      float b = v[i].y * rinv * w4.y * (1.f + s4.y) + h4.y;
      float c2 = v[i].z * rinv * w4.z * (1.f + s4.z) + h4.z;
      float d = v[i].w * rinv * w4.w * (1.f + s4.w) + h4.w;
      uint2 o; o.x = pack2(a, b); o.y = pack2(c2, d);
      *(uint2*)(H + (size_t)tok * 1024 + c) = o;
    }
  }
}

struct Epi {
  u16* outb; const float* xs_lat; const float* xs_ctx; float* xd_lat; float* xd_ctx; const float* gate; float coef;
};
template <int MODE, int BM = 256>
__device__ __attribute__((always_inline)) void gemm_phase(const u16* __restrict__ A, int lda, const u16* __restrict__ Bt, int K, int M, int N, Epi e, unsigned char* smem, int vbid) {
  constexpr int BUF = (256 + 128) * 72;
  constexpr int MI = BM / 64;
  constexpr int WM = BM / 4;
  u16* L = (u16*)smem;
  const int tid = TID(), lane = tid & 63, wave = tid >> 6, wm = wave >> 1, wn = wave & 1;
  const int nMt = M / BM, nNt = N / 128, ntiles = nMt * nNt, nk = K / 64;
  const int lrow = tid >> 3, lch = tid & 7;
  const int fr = lane & 15, fq = lane >> 4;
  const int nb_ = NBLK();
  const bool swz = (vbid >= 0) && (nb_ == 256) && (nMt % 8 == 0) && (nNt % 4 == 0);
  int bid_ = swz ? vbid : BID();
  asm volatile("" : "+s"(bid_));
  const int nPM = nMt >> 3, npatch = nPM * (nNt >> 2);
  for (int it = 0;; ++it) {
    int mt, nt;
    if (swz) {
      const int pi = it * 8 + (bid_ & 7);
      if (pi >= npatch) break;
      mt = (pi % nPM) * 8 + ((bid_ >> 3) & 7);
      nt = (pi / nPM) * 4 + (bid_ >> 6);
    } else {
      const int tile = bid_ + it * nb_;
      if (tile >= ntiles) break;
      mt = tile % nMt; nt = tile / nMt;
    }
    const int m0 = mt * BM, n0 = nt * 128;
    f32x4 acc[MI][4];
#pragma unroll
    for (int i = 0; i < MI; ++i)
#pragma unroll
      for (int j = 0; j < 4; ++j) acc[i][j] = (f32x4){0.f, 0.f, 0.f, 0.f};
    const u16* Ap = A + (size_t)(m0 + lrow) * lda + lch * 8;
    const u16* Bp = Bt + (size_t)(n0 + lrow) * K + lch * 8;
    u32x4 ra0[MI], rb0[2], ra1[MI], rb1[2];
#define G_LOAD(RA, RB, KT) do { const int ko_ = (KT) * 64; \
      _Pragma("unroll") for (int i = 0; i < MI; ++i) RA[i] = *(const u32x4*)(Ap + (size_t)(i * 64) * lda + ko_); \
      _Pragma("unroll") for (int i = 0; i < 2; ++i) RB[i] = *(const u32x4*)(Bp + (size_t)(i * 64) * K + ko_); } while (0)
#define L_STORE(RA, RB, BUFI) do { u16* W_ = L + (BUFI) * BUF; \
      _Pragma("unroll") for (int i = 0; i < MI; ++i) *(u32x4*)(W_ + (lrow + i * 64) * 72 + lch * 8) = RA[i]; \
      _Pragma("unroll") for (int i = 0; i < 2; ++i) *(u32x4*)(W_ + 256 * 72 + (lrow + i * 64) * 72 + lch * 8) = RB[i]; } while (0)
#define FRAGS(AF, BF, BUFI, KS) do { const u16* As = L + (BUFI) * BUF; const u16* Bs = As + 256 * 72; \
      _Pragma("unroll") for (int mi = 0; mi < MI; ++mi) AF[mi] = *(const bf16x8*)(As + (wm * WM + mi * 16 + fr) * 72 + (KS) * 32 + fq * 8); \
      _Pragma("unroll") for (int ni = 0; ni < 4; ++ni) BF[ni] = *(const bf16x8*)(Bs + (wn * 64 + ni * 16 + fr) * 72 + (KS) * 32 + fq * 8); } while (0)
#define MMA16(AF, BF) do { \
      _Pragma("unroll") for (int mi = 0; mi < MI; ++mi) \
        _Pragma("unroll") for (int ni = 0; ni < 4; ++ni) acc[mi][ni] = __builtin_amdgcn_mfma_f32_16x16x32_bf16(BF[ni], AF[mi], acc[mi][ni], 0, 0, 0); } while (0)
#define KSTEP(BUFI, RA, RB, NBUFI) do { \
      bf16x8 af0[MI], bf0[4], af1[MI], bf1[4]; \
      FRAGS(af0, bf0, BUFI, 0); \
      __builtin_amdgcn_sched_barrier(0); \
      FRAGS(af1, bf1, BUFI, 1); \
      MMA16(af0, bf0); \
      _Pragma("unroll") for (int q_ = 0; q_ < MI * 2; ++q_) { __builtin_amdgcn_sched_group_barrier(0x008, 2, 0); __builtin_amdgcn_sched_group_barrier(0x100, 1, 0); } \
      if (MI == 3) __builtin_amdgcn_sched_group_barrier(0x100, 1, 0); \
      __builtin_amdgcn_sched_barrier(0); \
      L_STORE(RA, RB, NBUFI); \
      MMA16(af1, bf1); \
      _Pragma("unroll") for (int q_ = 0; q_ < MI + 2; ++q_) { __builtin_amdgcn_sched_group_barrier(0x008, 2, 0); __builtin_amdgcn_sched_group_barrier(0x200, 1, 0); } \
      __builtin_amdgcn_sched_group_barrier(0x008, MI * 4 - 2 * (MI + 2), 0); \
      __builtin_amdgcn_sched_barrier(0); \
      } while (0)
    G_LOAD(ra0, rb0, 0);
    G_LOAD(ra1, rb1, 1);
    __syncthreads();
    L_STORE(ra0, rb0, 0);
    __syncthreads();
    for (int kt = 0; kt < nk; kt += 2) {
      G_LOAD(ra0, rb0, min(kt + 2, nk - 1));
      KSTEP(0, ra1, rb1, 1);
      lds_barrier();
      G_LOAD(ra1, rb1, min(kt + 3, nk - 1));
      KSTEP(1, ra0, rb0, 0);
      lds_barrier();
    }
    asm volatile("s_waitcnt vmcnt(0)" ::: "memory");
#undef FRAGS
#undef MMA16
#undef KSTEP
#undef G_LOAD
#undef L_STORE
    if (MODE == 0) {
#pragma unroll
      for (int mi = 0; mi < MI; ++mi) {
        const int tok = m0 + wm * WM + mi * 16 + fr;
#pragma unroll
        for (int np = 0; np < 2; ++np) {
          const int ffc = ((n0 + wn * 64) >> 1) + np * 16 + fq * 4;
          const f32x4 g = acc[mi][np * 2], u = acc[mi][np * 2 + 1];
          uint2 o;
          o.x = pack2(siluf_(g[0]) * u[0], siluf_(g[1]) * u[1]);
          o.y = pack2(siluf_(g[2]) * u[2], siluf_(g[3]) * u[3]);
          *(uint2*)(e.outb + (size_t)tok * DFF + ffc) = o;
        }
      }
    } else if (MODE == 1) {
#pragma unroll
      for (int mi = 0; mi < MI; ++mi) {
        const int tok = m0 + wm * WM + mi * 16 + fr;
        const bool isctx = tok >= TL;
        const int r = isctx ? 8 : (tok >> 11);
        const float* xs = isctx ? e.xs_ctx + (size_t)(tok - TL) * 1024 : e.xs_lat + (size_t)tok * 1024;
        float* xd = isctx ? e.xd_ctx + (size_t)(tok - TL) * 1024 : e.xd_lat + (size_t)tok * 1024;
        const float* g = e.gate + (size_t)r * 9216;
#pragma unroll
        for (int ni = 0; ni < 4; ++ni) {
          const int col = n0 + wn * 64 + ni * 16 + fq * 4;
          const float4 gv = *(const float4*)(g + col);
          const float4 xv = *(const float4*)(xs + col);
          float4 o;
          o.x = xv.x + gv.x * e.coef * acc[mi][ni][0];
          o.y = xv.y + gv.y * e.coef * acc[mi][ni][1];
          o.z = xv.z + gv.z * e.coef * acc[mi][ni][2];
          o.w = xv.w + gv.w * e.coef * acc[mi][ni][3];
          *(float4*)(xd + col) = o;
        }
        __builtin_amdgcn_sched_barrier(0);
      }
    } else {
#pragma unroll
      for (int mi = 0; mi < MI; ++mi) {
        const int tok = m0 + wm * WM + mi * 16 + fr;
#pragma unroll
        for (int ni = 0; ni < 4; ++ni) {
          const int col = n0 + wn * 64 + ni * 16 + fq * 4;
          uint2 o;
          o.x = pack2(acc[mi][ni][0], acc[mi][ni][1]);
          o.y = pack2(acc[mi][ni][2], acc[mi][ni][3]);
          *(uint2*)(e.outb + (size_t)tok * PS + col) = o;
        }
      }
    }
  }
}

template <int MODE>
__device__ __attribute__((always_inline)) void gemm_phase_big(const u16* __restrict__ A, int lda, const u16* __restrict__ Bt, int K, int M, int N, Epi e, unsigned char* smem) {
  constexpr int BUF = 512 * 72;
  u16* L = (u16*)smem;
  const int tid = TID(), lane = tid & 63, wave = tid >> 6, wm = wave >> 1, wn = wave & 1;
  const int nMt = M / 256, nNt = N / 256, ntiles = nMt * nNt, nk = K / 64;
  const int lrow = tid >> 3, lch = tid & 7;
  const int fr = lane & 15, fq = lane >> 4;
  const int nb_ = NBLK();
  for (int tile = BID(); tile < ntiles; tile += nb_) {
    const int mt = tile % nMt, nt = tile / nMt;
    const int m0 = mt * 256, n0 = nt * 256;
    f32x4 acc[4][8];
#pragma unroll
    for (int i = 0; i < 4; ++i)
#pragma unroll
      for (int j = 0; j < 8; ++j) acc[i][j] = (f32x4){0.f, 0.f, 0.f, 0.f};
    const u16* Ap = A + (size_t)(m0 + lrow) * lda + lch * 8;
    const u16* Bp = Bt + (size_t)(n0 + lrow) * K + lch * 8;
    u32x4 ra[4], rb[4];
#define G_LOADB(KT) do { const int ko_ = (KT) * 64; \
      _Pragma("unroll") for (int i = 0; i < 4; ++i) ra[i] = *(const u32x4*)(Ap + (size_t)(i * 64) * lda + ko_); \
      _Pragma("unroll") for (int i = 0; i < 4; ++i) rb[i] = *(const u32x4*)(Bp + (size_t)(i * 64) * K + ko_); } while (0)
#define L_STOREB(BUFI) do { u16* W_ = L + (BUFI) * BUF; \
      _Pragma("unroll") for (int i = 0; i < 4; ++i) *(u32x4*)(W_ + (lrow + i * 64) * 72 + lch * 8) = ra[i]; \
      _Pragma("unroll") for (int i = 0; i < 4; ++i) *(u32x4*)(W_ + 256 * 72 + (lrow + i * 64) * 72 + lch * 8) = rb[i]; } while (0)
    G_LOADB(0);
    __syncthreads();
    L_STOREB(0);
    G_LOADB(min(1, nk - 1));
    __syncthreads();
#define FRAGSB(KS) do { \
        _Pragma("unroll") for (int mi = 0; mi < 4; ++mi) af[mi] = *(const bf16x8*)(As + (wm * 64 + mi * 16 + fr) * 72 + (KS) * 32 + fq * 8); \
        _Pragma("unroll") for (int ni = 0; ni < 8; ++ni) bfr[ni] = *(const bf16x8*)(Bs + (wn * 128 + ni * 16 + fr) * 72 + (KS) * 32 + fq * 8); } while (0)
#define MMAB() do { \
        _Pragma("unroll") for (int ni = 0; ni < 8; ++ni) \
          _Pragma("unroll") for (int mi = 0; mi < 4; ++mi) acc[mi][ni] = __builtin_amdgcn_mfma_f32_16x16x32_bf16(bfr[ni], af[mi], acc[mi][ni], 0, 0, 0); } while (0)
    for (int kt = 0; kt < nk; ++kt) {
      const u16* As = L + (kt & 1) * BUF;
      const u16* Bs = As + 256 * 72;
      bf16x8 af[4], bfr[8];
      FRAGSB(0);
      __builtin_amdgcn_sched_barrier(0);
      MMAB();
      L_STOREB((kt + 1) & 1);
#pragma unroll
      for (int q_ = 0; q_ < 8; ++q_) { __builtin_amdgcn_sched_group_barrier(0x008, 4, 0); __builtin_amdgcn_sched_group_barrier(0x200, 1, 0); }
      __builtin_amdgcn_sched_barrier(0);
      G_LOADB(min(kt + 2, nk - 1));
      FRAGSB(1);
      __builtin_amdgcn_sched_barrier(0);
      MMAB();
      __builtin_amdgcn_sched_barrier(0);
      lds_barrier();
    }
#undef FRAGSB
#undef MMAB
    asm volatile("s_waitcnt vmcnt(0)" ::: "memory");
#undef G_LOADB
#undef L_STOREB
    if (MODE == 0) {
#pragma unroll
      for (int mi = 0; mi < 4; ++mi) {
        const int tok = m0 + wm * 64 + mi * 16 + fr;
#pragma unroll
        for (int np = 0; np < 4; ++np) {
          const int ffc = ((n0 + wn * 128) >> 1) + np * 16 + fq * 4;
          const f32x4 g = acc[mi][np * 2], u = acc[mi][np * 2 + 1];
          uint2 o;
          o.x = pack2(siluf_(g[0]) * u[0], siluf_(g[1]) * u[1]);
          o.y = pack2(siluf_(g[2]) * u[2], siluf_(g[3]) * u[3]);
          *(uint2*)(e.outb + (size_t)tok * DFF + ffc) = o;
        }
      }
    } else if (MODE == 1) {
#pragma unroll
      for (int mi = 0; mi < 4; ++mi) {
        const int tok = m0 + wm * 64 + mi * 16 + fr;
        const bool isctx = tok >= TL;
        const int r = isctx ? 8 : (tok >> 11);
        const float* xs = isctx ? e.xs_ctx + (size_t)(tok - TL) * 1024 : e.xs_lat + (size_t)tok * 1024;
        float* xd = isctx ? e.xd_ctx + (size_t)(tok - TL) * 1024 : e.xd_lat + (size_t)tok * 1024;
        const float* g = e.gate + (size_t)r * 9216;
#pragma unroll
        for (int ni = 0; ni < 8; ++ni) {
          const int col = n0 + wn * 128 + ni * 16 + fq * 4;
          const float4 gv = *(const float4*)(g + col);
          const float4 xv = *(const float4*)(xs + col);
          float4 o;
          o.x = xv.x + gv.x * e.coef * acc[mi][ni][0];
          o.y = xv.y + gv.y * e.coef * acc[mi][ni][1];
          o.z = xv.z + gv.z * e.coef * acc[mi][ni][2];
          o.w = xv.w + gv.w * e.coef * acc[mi][ni][3];
          *(float4*)(xd + col) = o;
        }
        __builtin_amdgcn_sched_barrier(0);
      }
    } else {
#pragma unroll
      for (int mi = 0; mi < 4; ++mi) {
        const int tok = m0 + wm * 64 + mi * 16 + fr;
#pragma unroll
        for (int ni = 0; ni < 8; ++ni) {
          const int col = n0 + wn * 128 + ni * 16 + fq * 4;
          uint2 o;
          o.x = pack2(acc[mi][ni][0], acc[mi][ni][1]);
          o.y = pack2(acc[mi][ni][2], acc[mi][ni][3]);
          *(uint2*)(e.outb + (size_t)tok * PS + col) = o;
        }
      }
    }
  }
}

__device__ __attribute__((always_inline)) void prep_task(PC p, int l, int task, unsigned char* smem) {
  float* raw = (float*)smem;
  float* sv = raw + 34 * 64;
  const int tid = TID();
  const u16* slab = (const u16*)(p->ws + OFF_SLAB);
  const int tok0 = task * 32;
  int base, n;
  if (tok0 < TL) { base = (tok0 >> 11) << 11; n = 2048; } else { base = TL + (((tok0 - TL) >> 8) << 8); n = 256; }
  const int pos0 = tok0 - base;
  for (int i = tid; i < 34 * 64; i += 512) {
    int rr = i >> 6, j = i & 63, pos = pos0 - 1 + rr;
    raw[i] = (pos >= 0 && pos < n) ? bf2f(slab[(size_t)(base + pos) * PS + RW_OFF + 768 + j]) : 0.f;
  }
  __syncthreads();
  const float* mu = p->in[I_RWMU] + l * 2 * 896;
  for (int i = tid; i < 32 * 64; i += 512) {
    int t = i >> 6, j = i & 63;
    float u = raw[(t + 1) * 64 + j], pv = raw[t * 64 + j], nx = raw[(t + 2) * 64 + j];
    float s = u + mu[768 + j] * (pv - u) + mu[896 + 768 + j] * (nx - u);
    if (j < 32) s = tanhf(s);
    sv[i] = s;
  }
  __syncthreads();
  {
    const int c = tid & 255, d = tid >> 8;
    const float* wup = p->in[I_RWWUP] + (size_t)(l * 2 + d) * 32 * 256 + c;
    const float* aup = p->in[I_RWAUP] + (size_t)(l * 2 + d) * 32 * 256 + c;
    float wu[32], au[32];
#pragma unroll
    for (int j = 0; j < 32; ++j) { wu[j] = wup[j * 256]; au[j] = aup[j * 256]; }
    u16* rwl = (u16*)(p->ws + OFF_RWL);
    const float rw_w0 = p->in[I_RWW0][(l * 2 + d) * 256 + c], rw_a0 = p->in[I_RWA0][(l * 2 + d) * 256 + c];
#pragma unroll 2
    for (int t = 0; t < 32; ++t) {
      float aw = 0.f, aa = 0.f;
#pragma unroll
      for (int q = 0; q < 8; ++q) {
        float4 x = *(const float4*)(sv + t * 64 + q * 4);
        float4 y = *(const float4*)(sv + t * 64 + 32 + q * 4);
        aw = fmaf(x.x, wu[q * 4], aw); aw = fmaf(x.y, wu[q * 4 + 1], aw); aw = fmaf(x.z, wu[q * 4 + 2], aw); aw = fmaf(x.w, wu[q * 4 + 3], aw);
        aa = fmaf(y.x, au[q * 4], aa); aa = fmaf(y.y, au[q * 4 + 1], aa); aa = fmaf(y.z, au[q * 4 + 2], aa); aa = fmaf(y.w, au[q * 4 + 3], aa);
      }
      const float zz = -(rw_w0 + aw);
      const float sp = zz > 20.f ? zz : __logf(1.f + __expf(zz));
      rwl[(size_t)(tok0 + t) * 1024 + d * 512 + c] = f2bf(__expf(-sp - 0.5f));
      rwl[(size_t)(tok0 + t) * 1024 + d * 512 + 256 + c] = f2bf(sigmoidf_(rw_a0 + aa));
    }
  }
  {
    const float* hc = p->in[I_HYCONV] + l * 3 * 768;
    u16* hxt = (u16*)(p->ws + OFF_HXT);
#pragma unroll 1
    for (int cidx = tid; cidx < 768; cidx += 512) {
      const float w0 = hc[cidx], w1 = hc[768 + cidx], w2 = hc[1536 + cidx];
      float pv = pos0 > 0 ? bf2f(slab[(size_t)(tok0 - 1) * PS + cidx]) : 0.f;
      float cur = bf2f(slab[(size_t)tok0 * PS + cidx]);
      unsigned pk[16];
#pragma unroll
      for (int t = 0; t < 32; t += 2) {
        float nx0 = (pos0 + t + 1 < n) ? bf2f(slab[(size_t)(tok0 + t + 1) * PS + cidx]) : 0.f;
        float v0 = w0 * pv + w1 * cur + w2 * nx0;
        float nx1 = (pos0 + t + 2 < n) ? bf2f(slab[(size_t)(tok0 + t + 2) * PS + cidx]) : 0.f;
        float v1 = w0 * cur + w1 * nx0 + w2 * nx1;
        pk[t >> 1] = pack2(v0, v1);
        pv = nx0; cur = nx1;
      }
      uint4* dst = (uint4*)(hxt + (size_t)cidx * TT + tok0);
      dst[0] = make_uint4(pk[0], pk[1], pk[2], pk[3]);
      dst[1] = make_uint4(pk[4], pk[5], pk[6], pk[7]);
      dst[2] = make_uint4(pk[8], pk[9], pk[10], pk[11]);
      dst[3] = make_uint4(pk[12], pk[13], pk[14], pk[15]);
    }
  }
  __syncthreads();
}

typedef float f32x2 __attribute__((ext_vector_type(2)));
DEV float quad_sum(float x) {
  x += __builtin_bit_cast(float, __builtin_amdgcn_update_dpp(0, __builtin_bit_cast(int, x), 0xB1, 0xf, 0xf, true));
  x += __builtin_bit_cast(float, __builtin_amdgcn_update_dpp(0, __builtin_bit_cast(int, x), 0x4E, 0xf, 0xf, true));
  return x;
}
constexpr int DN_STRIDE = 200, RW_STRIDE = 392, CHUNK = 16, NCHUNK = 2304 / CHUNK;
DEV void ld16(f32x2* o, const float* d) {
#pragma unroll
  for (int i = 0; i < 4; ++i) {
    float4 a = *(const float4*)(d + i * 4);
    o[2 * i] = (f32x2){a.x, a.y};
    o[2 * i + 1] = (f32x2){a.z, a.w};
  }
}
struct DnOps { f32x2 q[8], k[8]; float vv, a, be, kq; };
DEV void dn_load(DnOps& o, const float* d, int kp, int col) {
  ld16(o.q, d + kp * 16); ld16(o.k, d + 64 + kp * 16);
  o.vv = d[128 + col]; o.a = d[192]; o.be = d[193]; o.kq = d[194];
}
DEV float dn_step(f32x2* S, const DnOps& c) {
  f32x2 a1 = (f32x2){0.f, 0.f}, a2 = (f32x2){0.f, 0.f};
#pragma unroll
  for (int i = 0; i < 8; ++i) { a1 = __builtin_elementwise_fma(S[i], c.k[i], a1); a2 = __builtin_elementwise_fma(S[i], c.q[i], a2); }
  const float dk = quad_sum(a1.x + a1.y), dq = quad_sum(a2.x + a2.y);
  const float cc = c.be * (c.vv - c.a * dk);
  const f32x2 a2v = (f32x2){c.a, c.a}, c2v = (f32x2){cc, cc};
#pragma unroll
  for (int i = 0; i < 8; ++i) { S[i] = S[i] * a2v; S[i] = __builtin_elementwise_fma(c.k[i], c2v, S[i]); }
  return c.a * dq + cc * c.kq;
}
struct RwOps { f32x2 wr[8], w[8], kd[8], av[8], bv[8]; float vv, s1, s2; };
DEV void rw_load(RwOps& o, const float* d, int kp, int col) {
  ld16(o.wr, d + kp * 16); ld16(o.w, d + 64 + kp * 16); ld16(o.kd, d + 128 + kp * 16); ld16(o.av, d + 192 + kp * 16); ld16(o.bv, d + 256 + kp * 16);
  o.vv = d[320 + col]; o.s1 = d[384]; o.s2 = d[385];
}
DEV float rw_step(f32x2* S, const RwOps& c) {
  f32x2 a1 = (f32x2){0.f, 0.f}, a2 = (f32x2){0.f, 0.f};
#pragma unroll
  for (int i = 0; i < 8; ++i) { a1 = __builtin_elementwise_fma(S[i], c.av[i], a1); a2 = __builtin_elementwise_fma(S[i], c.wr[i], a2); }
  const float sa = quad_sum(a1.x + a1.y), yp = quad_sum(a2.x + a2.y);
  const f32x2 sa2 = (f32x2){sa, sa}, v2 = (f32x2){c.vv, c.vv};
#pragma unroll
  for (int i = 0; i < 8; ++i) { S[i] = S[i] * c.w[i]; S[i] = __builtin_elementwise_fma(sa2, c.bv[i], S[i]); S[i] = __builtin_elementwise_fma(v2, c.kd[i], S[i]); }
  return yp + sa * c.s1 + c.vv * c.s2;
}

DEV float wave_allsum_dpp(float x) {
  x += __builtin_bit_cast(float, __builtin_amdgcn_update_dpp(0, __builtin_bit_cast(int, x), 0xB1, 0xf, 0xf, true));
  x += __builtin_bit_cast(float, __builtin_amdgcn_update_dpp(0, __builtin_bit_cast(int, x), 0x4E, 0xf, 0xf, true));
  x += __builtin_bit_cast(float, __builtin_amdgcn_update_dpp(0, __builtin_bit_cast(int, x), 0x124, 0xf, 0xf, true));
  x += __builtin_bit_cast(float, __builtin_amdgcn_update_dpp(0, __builtin_bit_cast(int, x), 0x128, 0xf, 0xf, true));
  return allred_rows(x);
}
DEV float softplus_fast(float x) { return x > 20.f ? x : __logf(1.f + __expf(x)); }

DEV float oct_sum(float x) {
  x += __builtin_bit_cast(float, __builtin_amdgcn_update_dpp(0, __builtin_bit_cast(int, x), 0xB1, 0xf, 0xf, true));
  x += __builtin_bit_cast(float, __builtin_amdgcn_update_dpp(0, __builtin_bit_cast(int, x), 0x4E, 0xf, 0xf, true));
  x += __builtin_bit_cast(float, __builtin_amdgcn_update_dpp(0, __builtin_bit_cast(int, x), 0x141, 0xf, 0xf, true));
  return x;
}
DEV void ld8(f32x2* o, const float* d) {
#pragma unroll
  for (int i = 0; i < 2; ++i) {
    float4 a = *(const float4*)(d + i * 4);
    o[2 * i] = (f32x2){a.x, a.y};
    o[2 * i + 1] = (f32x2){a.z, a.w};
  }
}
struct RwOps8 { f32x2 wr[4], w[4], kd[4], av[4], bv[4]; float vv, s1, s2; };
DEV void rw_load8(RwOps8& o, const float* d, int kp, int row) {
  ld8(o.wr, d + kp * 8); ld8(o.w, d + 64 + kp * 8); ld8(o.kd, d + 128 + kp * 8); ld8(o.av, d + 192 + kp * 8); ld8(o.bv, d + 256 + kp * 8);
  o.vv = d[320 + row]; o.s1 = d[384]; o.s2 = d[385];
}
DEV float rw_step8(f32x2* S, const RwOps8& c) {
  f32x2 a1 = (f32x2){0.f, 0.f}, a2 = (f32x2){0.f, 0.f};
#pragma unroll
  for (int i = 0; i < 4; ++i) { a1 = __builtin_elementwise_fma(S[i], c.av[i], a1); a2 = __builtin_elementwise_fma(S[i], c.wr[i], a2); }
  const float sa = oct_sum(a1.x + a1.y), yp = oct_sum(a2.x + a2.y);
  const f32x2 sa2 = (f32x2){sa, sa}, v2 = (f32x2){c.vv, c.vv};
#pragma unroll
  for (int i = 0; i < 4; ++i) { S[i] = S[i] * c.w[i]; S[i] = __builtin_elementwise_fma(sa2, c.bv[i], S[i]); S[i] = __builtin_elementwise_fma(v2, c.kd[i], S[i]); }
  return yp + sa * c.s1 + c.vv * c.s2;
}

struct DnRaw { uint4 c[3], pv[3], nx[3]; unsigned xa, xb; float fp, fn; };
DEV void dn_prep_load(DnRaw& R, PC p, int b, int hd, int dir, int ci) {
  const int ptid = TID() - 256;
  const u16* slab = (const u16*)(p->ws + OFF_SLAB);
  const int st = (ptid >> 3) & 15, g = ptid & 7;
  int pos, n;
  const int tok = step_tok(b, dir, ci * CHUNK + st, pos, n);
  const int tp = pos > 0 ? tok - 1 : tok, tn = pos < n - 1 ? tok + 1 : tok;
  R.fp = pos > 0 ? 1.f : 0.f; R.fn = pos < n - 1 ? 1.f : 0.f;
#pragma unroll
  for (int v3 = 0; v3 < 3; ++v3) {
    const int col = DN_OFF + v3 * 256 + hd * 64 + g * 8;
    R.c[v3] = *(const uint4*)(slab + (size_t)tok * PS + col);
    R.pv[v3] = *(const uint4*)(slab + (size_t)tp * PS + col);
    R.nx[v3] = *(const uint4*)(slab + (size_t)tn * PS + col);
  }
  int pos2, n2;
  const int tok2 = step_tok(b, dir, ci * CHUNK + (ptid & 15), pos2, n2);
  R.xb = slab[(size_t)tok2 * PS + DN_OFF + 1024 + dir * 8 + hd];
  R.xa = slab[(size_t)tok2 * PS + DN_OFF + 1024 + dir * 8 + 4 + hd];
}
DEV void dn_prep_compute(const DnRaw& R, float* dst, const float* cw, float Aexp, float dtb) {
  const int ptid = TID() - 256;
  if (ptid < 128) {
    const int st = ptid >> 3, g = ptid & 7;
    float res[3][8];
    float ssq = 0.f, ssk = 0.f, qk = 0.f;
#pragma unroll
    for (int v3 = 0; v3 < 3; ++v3) {
      float cur[8], pv[8], nx[8];
      unpack8(R.c[v3], cur); unpack8(R.pv[v3], pv); unpack8(R.nx[v3], nx);
      const float* c0 = cw + v3 * 64 + g * 8;
#pragma unroll
      for (int e = 0; e < 8; ++e) res[v3][e] = siluf_(c0[e] * R.fp * pv[e] + c0[192 + e] * cur[e] + c0[384 + e] * R.fn * nx[e]);
    }
#pragma unroll
    for (int e = 0; e < 8; ++e) { ssq += res[0][e] * res[0][e]; ssk += res[1][e] * res[1][e]; qk += res[0][e] * res[1][e]; }
    ssq += __shfl_xor(ssq, 1); ssq += __shfl_xor(ssq, 2); ssq += __shfl_xor(ssq, 4);
    ssk += __shfl_xor(ssk, 1); ssk += __shfl_xor(ssk, 2); ssk += __shfl_xor(ssk, 4);
    qk += __shfl_xor(qk, 1); qk += __shfl_xor(qk, 2); qk += __shfl_xor(qk, 4);
    const float scq = rsqrtf(ssq + 1e-6f) * 0.125f, sck = rsqrtf(ssk + 1e-6f);
    float* d = dst + st * DN_STRIDE + g * 8;
    *(float4*)d = make_float4(res[0][0] * scq, res[0][1] * scq, res[0][2] * scq, res[0][3] * scq);
    *(float4*)(d + 4) = make_float4(res[0][4] * scq, res[0][5] * scq, res[0][6] * scq, res[0][7] * scq);
    *(float4*)(d + 64) = make_float4(res[1][0] * sck, res[1][1] * sck, res[1][2] * sck, res[1][3] * sck);
    *(float4*)(d + 68) = make_float4(res[1][4] * sck, res[1][5] * sck, res[1][6] * sck, res[1][7] * sck);
    *(float4*)(d + 128) = make_float4(res[2][0], res[2][1], res[2][2], res[2][3]);
    *(float4*)(d + 132) = make_float4(res[2][4], res[2][5], res[2][6], res[2][7]);
    if (g == 0) dst[st * DN_STRIDE + 194] = qk * scq * sck;
  } else if (ptid < 128 + CHUNK) {
    const int st = ptid - 128;
    const float g = -Aexp * softplus_fast(bf2f((u16)R.xa) + dtb);
    dst[st * DN_STRIDE + 192] = __expf(g);
    dst[st * DN_STRIDE + 193] = sigmoidf_(bf2f((u16)R.xb));
  }
}

__device__ __attribute__((always_inline)) void dn_scan_unit(PC p, int l, int unit, unsigned char* smem, const int MODE = 7) {
  const int b = unit >> 3, hd = (unit >> 1) & 3, dir = unit & 1;
  float* buf = (float*)smem;
  float* cw = buf + 2 * CHUNK * DN_STRIDE + 64;
  const int tid = TID(), wave = tid >> 6, lane = tid & 63;
  __syncthreads();
  for (int i = tid; i < 576; i += 512) {
    int tap = i / 192, rem = i % 192, v3 = rem >> 6, d = rem & 63;
    cw[i] = p->in[I_DNCONV][(l * 3 + tap) * 768 + v3 * 256 + hd * 64 + d];
  }
  const float Aexp = __expf(p->in[I_DNALOG][l * 8 + dir * 4 + hd]);
  const float dtb = p->in[I_DNDT][l * 8 + dir * 4 + hd];
  u16* dno = (u16*)(p->ws + OFF_DNO) + (size_t)dir * TT * 256;
  __syncthreads();
  f32x2 S[8];
#pragma unroll
  for (int j = 0; j < 8; ++j) S[j] = (f32x2){0.f, 0.f};
  const int kp = lane & 3, col = (wave & 3) * 16 + (lane >> 2);
  DnRaw R0, R1;
  if (wave >= 4) {
    dn_prep_load(R0, p, b, hd, dir, 0); dn_prep_compute(R0, buf, cw, Aexp, dtb);
    dn_prep_load(R0, p, b, hd, dir, 1); dn_prep_load(R1, p, b, hd, dir, 2);
  }
  __syncthreads();
#define DN_SCAN_CHUNK(CI) do { \
      const float* bb = buf + ((CI) & 1) * CHUNK * DN_STRIDE; \
      int pos, n; \
      const int tok0 = step_tok(b, dir, (CI) * CHUNK, pos, n); \
      const int tstep = dir ? -1 : 1; \
      u16* op = dno + (size_t)tok0 * 256 + hd * 64 + col; \
      DnOps A, B; \
      dn_load(A, bb, kp, col); \
      _Pragma("unroll 1") for (int st = 0; st < CHUNK; st += 2) { \
        dn_load(B, bb + (st + 1) * DN_STRIDE, kp, col); \
        const float o0 = dn_step(S, A); \
        if ((MODE & 1) && kp == 0) op[(ptrdiff_t)(st * tstep) * 256] = f2bf(o0); sink += o0; \
        dn_load(A, bb + (st + 2) * DN_STRIDE, kp, col); \
        const float o1 = dn_step(S, B); \
        if ((MODE & 1) && kp == 0) op[(ptrdiff_t)((st + 1) * tstep) * 256] = f2bf(o1); sink += o1; \
      } } while (0)
  float sink = 0.f;
  if (wave >= 4 && !(MODE & 2)) {
#pragma unroll 1
    for (int ci = 0; ci < NCHUNK; ci += 2) { lds_barrier(); lds_barrier(); }
  } else if (wave < 4 && !(MODE & 4)) {
#pragma unroll 1
    for (int ci = 0; ci < NCHUNK; ci += 2) { lds_barrier(); lds_barrier(); }
  } else if (wave >= 4) {
#pragma unroll 1
    for (int ci = 0; ci < NCHUNK; ci += 2) {
      dn_prep_compute(R0, buf + CHUNK * DN_STRIDE, cw, Aexp, dtb);
      dn_prep_load(R0, p, b, hd, dir, min(ci + 3, NCHUNK - 1));
      lds_barrier();
      if (ci + 2 < NCHUNK) dn_prep_compute(R1, buf, cw, Aexp, dtb);
      dn_prep_load(R1, p, b, hd, dir, min(ci + 4, NCHUNK - 1));
      lds_barrier();
    }
  } else {
#pragma unroll 1
    for (int ci = 0; ci < NCHUNK; ci += 2) {
      DN_SCAN_CHUNK(ci);
      lds_barrier();
      DN_SCAN_CHUNK(ci + 1);
      lds_barrier();
    }
    if (!(MODE & 1) && sink == 12345.678f) dno[col] = f2bf(sink);
  }
  asm volatile("s_waitcnt vmcnt(0)" ::: "memory");
  __syncthreads();
}

struct RwRaw { unsigned u[3][6]; unsigned wl[4], al[4]; unsigned vmask; };
DEV void rw_prep_load(RwRaw& R, PC p, int b, int hd, int dir, int ci, int pw) {
  const int lane = TID() & 63;
  const u16* slab = (const u16*)(p->ws + OFF_SLAB);
  const u16* rwl = (const u16*)(p->ws + OFF_RWL);
  const int ch = hd * 64 + lane;
  int pos0, n;
  const int tokc = step_tok(b, dir, ci * CHUNK, pos0, n);
  const int base = tokc - pos0;
  const int plo = dir ? pos0 - (pw * 4 + 3) : pos0 + pw * 4;
  unsigned vm = 0;
#pragma unroll
  for (int i = 0; i < 6; ++i) {
    const int pos = plo - 1 + i;
    const int posc = min(max(pos, 0), n - 1);
    vm |= (pos == posc ? 1u : 0u) << i;
#pragma unroll
    for (int sg = 0; sg < 3; ++sg) R.u[sg][i] = slab[(size_t)(base + posc) * PS + RW_OFF + sg * 256 + ch];
  }
  R.vmask = vm;
#pragma unroll
  for (int q = 0; q < 4; ++q) {
    const int pos = dir ? pos0 - (pw * 4 + q) : pos0 + pw * 4 + q;
    R.wl[q] = rwl[(size_t)(base + pos) * 1024 + dir * 512 + ch];
    R.al[q] = rwl[(size_t)(base + pos) * 1024 + dir * 512 + 256 + ch];
  }
}
struct RwConst { float m0[3], m1[3], kk_w, ka_w, w0, a0; };
DEV void rw_const_load(RwConst& C, PC p, int l, int hd, int dir) {
  const int lane = TID() & 63;
  const int ch = hd * 64 + lane;
  const float* mu = p->in[I_RWMU] + l * 2 * 896;
  C.kk_w = p->in[I_RWKK][l * 256 + ch]; C.ka_w = p->in[I_RWKA][l * 256 + ch];
  C.w0 = p->in[I_RWW0][(l * 2 + dir) * 256 + ch]; C.a0 = p->in[I_RWA0][(l * 2 + dir) * 256 + ch];
#pragma unroll
  for (int sg = 0; sg < 3; ++sg) { C.m0[sg] = mu[sg * 256 + ch]; C.m1[sg] = mu[896 + sg * 256 + ch]; }
}
DEV void rw_prep_compute(const RwRaw& R, const RwConst& C, int dir, float* dst, int pw) {
  const int lane = TID() & 63;
  const float kk_w = C.kk_w, ka_w = C.ka_w, w0 = C.w0, a0 = C.a0;
  float m0[3], m1[3];
#pragma unroll
  for (int sg = 0; sg < 3; ++sg) { m0[sg] = C.m0[sg]; m1[sg] = C.m1[sg]; }
  float uf[3][6];
#pragma unroll
  for (int sg = 0; sg < 3; ++sg)
#pragma unroll
    for (int i = 0; i < 6; ++i) uf[sg][i] = ((R.vmask >> i) & 1u) ? __uint_as_float(R.u[sg][i] << 16) : 0.f;
#pragma unroll
  for (int q = 0; q < 4; ++q) {
    const int st = pw * 4 + q;
    const int ic = dir ? 4 - q : 1 + q;
    float ts[3];
#pragma unroll
    for (int sg = 0; sg < 3; ++sg) {
      const float u = uf[sg][ic], pv = uf[sg][ic - 1], nx = uf[sg][ic + 1];
      ts[sg] = u + m0[sg] * (pv - u) + m1[sg] * (nx - u);
    }
    const float r = ts[0], k = ts[1], v = ts[2];
    const float kr = k * kk_w;
    const float w = __expf(-__uint_as_float(R.wl[q] << 16));
    const float a = __uint_as_float(R.al[q] << 16);
    const float kd = k * (1.f + (a - 1.f) * ka_w);
    const float ss = wave_allsum_dpp(kr * kr), t1 = wave_allsum_dpp(kr * a * r), t2 = wave_allsum_dpp(kd * r);
    const float rn = rsqrtf(ss + 1e-6f);
    const float kk = kr * rn;
    float* d = dst + st * RW_STRIDE;
    d[lane] = w * r; d[64 + lane] = w; d[128 + lane] = kd; d[192 + lane] = -kk; d[256 + lane] = kk * a; d[320 + lane] = v;
    if (lane == 0) { d[384] = t1 * rn; d[385] = t2; }
  }
}

__device__ __attribute__((always_inline)) void rw_scan_unit(PC p, int l, int hunit, unsigned char* smem, const int MODE = 7) {
  const int unit = hunit >> 1, half = hunit & 1;
  const int b = unit >> 3, hd = (unit >> 1) & 3, dir = unit & 1;
  float* buf = (float*)smem;
  const int tid = TID(), wave = tid >> 6, lane = tid & 63;
  u16* rwy = (u16*)(p->ws + OFF_RWY) + (size_t)dir * TT * 256;
  __syncthreads();
  f32x2 S[8];
#pragma unroll
  for (int j = 0; j < 8; ++j) S[j] = (f32x2){0.f, 0.f};
  const bool is_scan = wave < 4;
  const bool is_prep = wave >= 4;
  const int pw = wave & 3;
  const int kp = lane & 7, col = half * 32 + (wave & 3) * 8 + (lane >> 3);
  RwRaw R0, R1;
  RwConst C;
  rw_const_load(C, p, l, hd, dir);
  if (is_prep) {
    rw_prep_load(R0, p, b, hd, dir, 0, pw); rw_prep_compute(R0, C, dir, buf, pw);
    rw_prep_load(R0, p, b, hd, dir, 1, pw); rw_prep_load(R1, p, b, hd, dir, 2, pw);
  }
  __syncthreads();
#define RW_SCAN_CHUNK(CI) do { \
      const float* bb = buf + ((CI) & 1) * CHUNK * RW_STRIDE; \
      int pos, n; \
      const int tok0 = step_tok(b, dir, (CI) * CHUNK, pos, n); \
      const int tstep = dir ? -1 : 1; \
      u16* op = rwy + (size_t)tok0 * 256 + hd * 64 + col; \
      RwOps8 A, B; \
      rw_load8(A, bb, kp, col); \
      _Pragma("unroll 1") for (int st = 0; st < CHUNK; st += 2) { \
        rw_load8(B, bb + (st + 1) * RW_STRIDE, kp, col); \
        const float y0 = rw_step8(S, A); \
        if ((MODE & 1) && kp == 0) op[(ptrdiff_t)(st * tstep) * 256] = f2bf(y0); sink += y0; \
        rw_load8(A, bb + (st + 2) * RW_STRIDE, kp, col); \
        const float y1 = rw_step8(S, B); \
        if ((MODE & 1) && kp == 0) op[(ptrdiff_t)((st + 1) * tstep) * 256] = f2bf(y1); sink += y1; \
      } } while (0)
  float sink = 0.f;
  if ((is_prep && !(MODE & 2)) || (is_scan && !(MODE & 4))) {
#pragma unroll 1
    for (int ci = 0; ci < NCHUNK; ci += 2) { lds_barrier(); lds_barrier(); }
  } else if (is_prep) {
#pragma unroll 1
    for (int ci = 0; ci < NCHUNK; ci += 2) {
      rw_prep_compute(R0, C, dir, buf + CHUNK * RW_STRIDE, pw);
      rw_prep_load(R0, p, b, hd, dir, min(ci + 3, NCHUNK - 1), pw);
      lds_barrier();
      if (ci + 2 < NCHUNK) rw_prep_compute(R1, C, dir, buf, pw);
      rw_prep_load(R1, p, b, hd, dir, min(ci + 4, NCHUNK - 1), pw);
      lds_barrier();
    }
  } else if (is_scan) {
#pragma unroll 1
    for (int ci = 0; ci < NCHUNK; ci += 2) {
      RW_SCAN_CHUNK(ci);
      lds_barrier();
      RW_SCAN_CHUNK(ci + 1);
      lds_barrier();
    }
    if (!(MODE & 1) && sink == 12345.678f) rwy[col] = f2bf(sink);
  } else {
#pragma unroll 1
    for (int ci = 0; ci < NCHUNK; ci += 2) { lds_barrier(); lds_barrier(); }
  }
  asm volatile("s_waitcnt vmcnt(0)" ::: "memory");
  __syncthreads();
}

constexpr int USTR = 2248;
__device__ __attribute__((always_inline)) void hyena_task(PC p, int l, int order, int task, unsigned char* smem) {
  const int tid = TID(), wave = tid >> 6, lane = tid & 63;
  const int ty = task >> 8, ch = task & 255, n = ty ? 256 : 2048;
  const int oc = order * 256 + ch;
  u16* F = (u16*)smem;
  u16* Ts = F + 4096 * 8;
  u16* Us = Ts + 4096;
  const int seq0 = ty ? TL : 0;
  __syncthreads();
  {
    const u16* filt = (const u16*)(p->ws + OFF_FILT + (size_t)l * FILT_LAYER) + (ty ? (size_t)512 * 4096 : 0) + (size_t)oc * (2 * n);
    for (int i = tid * 8; i < 2 * n; i += 512 * 8) *(uint4*)(Ts + i) = *(const uint4*)(filt + i);
    const u16* Usrc = (const u16*)(p->ws + (order == 0 ? OFF_HXT : OFF_HYZ)) + (size_t)ch * TT + seq0;
    const int nch = (n + 192) / 8;
    for (int idx = tid; idx < 8 * nch; idx += 512) {
      const int b = idx / nch, c8 = idx % nch, s = c8 * 8 - 96;
      uint4 v = make_uint4(0, 0, 0, 0);
      if (s >= 0 && s < n) v = *(const uint4*)(Usrc + (size_t)b * n + s);
      *(uint4*)(Us + b * USTR + c8 * 8) = v;
    }
  }
  __syncthreads();
  for (int E = tid; E < 2 * n; E += 512) {
    unsigned w[4];
#pragma unroll
    for (int q = 0; q < 4; ++q) {
      const int x0 = E - 2 * q, x1 = E - 2 * q - 1;
      const unsigned lo = (x0 >= 0 && x0 <= 2 * n - 2) ? Ts[x0] : 0u;
      const unsigned hi = (x1 >= 0 && x1 <= 2 * n - 2) ? Ts[x1] : 0u;
      w[q] = lo | (hi << 16);
    }
    *(uint4*)(F + E * 8) = make_uint4(w[0], w[1], w[2], w[3]);
  }
  float asum = 0.f;
  {
    const float* fp = (const float*)(p->ws + OFF_FPART) + (size_t)(l * 72 + (ty ? 64 : 0)) * 1024 + oc;
    const int nck = ty ? 8 : 64;
    for (int c = 0; c < nck; ++c) asum += fp[c * 1024] + fp[c * 1024 + 512];
  }
  const float inv = 1.f / asum;
  __syncthreads();
  const int ntile = n >> 7;
  if (wave < ntile) {
    const bool two = (wave + 8) < ntile;
    f32x16 acc0, acc1;
#pragma unroll
    for (int i = 0; i < 16; ++i) { acc0[i] = 0.f; acc1[i] = 0.f; }
    const int m = lane & 31, kh = lane >> 5, dl = m >> 3, bb = m & 7;
    const u16* Bp = Us + bb * USTR + 8 * kh + 32 * dl;
    const int T0 = wave * 128;
    const int nsteps = (n + 96) / 16;
    const u16* Ap = F + (size_t)(T0 + 96 + n - 1 + m - 8 * kh) * 8;
#pragma unroll 2
    for (int st = 0; st < nsteps; ++st) {
      const bf16x8 bfrag = *(const bf16x8*)(Bp + st * 16);
      const bf16x8 a0 = *(const bf16x8*)(Ap - st * 128);
      acc0 = __builtin_amdgcn_mfma_f32_32x32x16_bf16(a0, bfrag, acc0, 0, 0, 0);
      if (two) {
        const bf16x8 a1 = *(const bf16x8*)(Ap - st * 128 + 1024 * 8);
        acc1 = __builtin_amdgcn_mfma_f32_32x32x16_bf16(a1, bfrag, acc1, 0, 0, 0);
      }
    }
    const float bias = p->in[I_HYBIAS][l * 512 + oc];
    const u16* gsrc = (const u16*)(p->ws + OFF_HXT) + (size_t)((order == 0 ? 256 : 512) + ch) * TT;
    const u16* usrc = (const u16*)(p->ws + (order == 0 ? OFF_HXT : OFF_HYZ)) + (size_t)ch * TT;
#pragma unroll
    for (int tsel = 0; tsel < 2; ++tsel) {
      if (tsel == 1 && !two) break;
      const int Tb = T0 + tsel * 1024;
#pragma unroll
      for (int rq = 0; rq < 4; ++rq) {
        const int t = Tb + 32 * dl + 8 * rq + 4 * kh;
        const size_t tok = (size_t)seq0 + (size_t)bb * n + t;
        const uint2 gx = *(const uint2*)(gsrc + tok);
        const uint2 ux = *(const uint2*)(usrc + tok);
        const float g[4] = {__uint_as_float(gx.x << 16), __uint_as_float(gx.x & 0xffff0000u), __uint_as_float(gx.y << 16), __uint_as_float(gx.y & 0xffff0000u)};
        const float u[4] = {__uint_as_float(ux.x << 16), __uint_as_float(ux.x & 0xffff0000u), __uint_as_float(ux.y << 16), __uint_as_float(ux.y & 0xffff0000u)};
        float o[4];
#pragma unroll
        for (int e = 0; e < 4; ++e) {
          const float y = (tsel == 0 ? acc0[rq * 4 + e] : acc1[rq * 4 + e]) * inv;
          o[e] = g[e] * (y + u[e] * bias);
        }
        if (order == 0) {
          uint2 ov; ov.x = pack2(o[0], o[1]); ov.y = pack2(o[2], o[3]);
          *(uint2*)((u16*)(p->ws + OFF_HYZ) + (size_t)ch * TT + tok) = ov;
        } else {
          u16* cat = (u16*)(p->ws + OFF_H);
#pragma unroll
          for (int e = 0; e < 4; ++e) cat[(tok + e) * 1024 + ch] = f2bf(o[e]);
        }
      }
    }
  }
}

__device__ __attribute__((always_inline)) void na_task(PC p, int l, int task, unsigned char* smem) {
  u16* Qs = (u16*)smem;
  u16* Ks = Qs + 128 * 72;
  u16* Vt = Ks + 64 * 72;
  float* rpbs = (float*)(Vt + 64 * 72);
  const int tid = TID(), wave = tid >> 6, lane = tid & 63;
  const int grp = wave >> 2, w4 = wave & 3;
  const u16* slab = (const u16*)(p->ws + OFF_SLAB);
  int b, hd, r0 = 0, u0 = 0, nloc = 0, qbase0, qbase1;
  const bool local = task < 512;
  if (local) {
    b = task >> 6; hd = (task >> 4) & 3; r0 = (task & 15) * 2;
    u0 = min(max(r0 - 4, 0), 24);
    nloc = min(max(r0 + 1 - 4, 0), 24) + 8 - u0;
    qbase0 = b * 2048 + r0 * 64; qbase1 = qbase0 + 64;
  } else {
    const int t2 = task - 512; b = t2 >> 3; hd = (t2 >> 1) & 3;
    qbase0 = TL + b * 256 + (t2 & 1) * 128; qbase1 = qbase0 + 64;
  }
  const int nchunks = nloc + 4;
  const int r = r0 + grp;
  const int rs = min(max(r - 4, 0), 24);
  const int qtok0 = grp ? qbase1 : qbase0;
  const float* qn = p->in[I_NAQN] + l * 64;
  const float* kn = p->in[I_NAKN] + l * 64;
  __syncthreads();
  {
    const int q = tid >> 2, dq = tid & 3;
    const int qt = (q < 64 ? qbase0 : qbase1) + (q & 63);
    float v[16];
    unpack8(*(const uint4*)(slab + (size_t)qt * PS + NA_OFF + hd * 64 + dq * 16), v);
    unpack8(*(const uint4*)(slab + (size_t)qt * PS + NA_OFF + hd * 64 + dq * 16 + 8), v + 8);
    float ss = 0.f;
#pragma unroll
    for (int e = 0; e < 16; ++e) ss += v[e] * v[e];
    ss += __shfl_xor(ss, 1); ss += __shfl_xor(ss, 2);
    const float rinv = rsqrtf(ss * (1.f / 64.f) + 1e-6f);
    uint4 o0, o1;
    o0.x = pack2(v[0] * rinv * qn[dq * 16 + 0], v[1] * rinv * qn[dq * 16 + 1]);
    o0.y = pack2(v[2] * rinv * qn[dq * 16 + 2], v[3] * rinv * qn[dq * 16 + 3]);
    o0.z = pack2(v[4] * rinv * qn[dq * 16 + 4], v[5] * rinv * qn[dq * 16 + 5]);
    o0.w = pack2(v[6] * rinv * qn[dq * 16 + 6], v[7] * rinv * qn[dq * 16 + 7]);
    o1.x = pack2(v[8] * rinv * qn[dq * 16 + 8], v[9] * rinv * qn[dq * 16 + 9]);
    o1.y = pack2(v[10] * rinv * qn[dq * 16 + 10], v[11] * rinv * qn[dq * 16 + 11]);
    o1.z = pack2(v[12] * rinv * qn[dq * 16 + 12], v[13] * rinv * qn[dq * 16 + 13]);
    o1.w = pack2(v[14] * rinv * qn[dq * 16 + 14], v[15] * rinv * qn[dq * 16 + 15]);
    *(uint4*)(Qs + q * 72 + dq * 16) = o0;
    *(uint4*)(Qs + q * 72 + dq * 16 + 8) = o1;
    for (int i = tid; i < 15 * 31; i += 512) rpbs[i] = p->in[I_NARPB][(size_t)(l * 4 + hd) * 15 * 31 + i];
  }
  const int fr = lane & 15, fq = lane >> 4;
  const int qc = w4 * 16 + fr;
  const int cs = min(max(qc - 8, 0), 48);
  float m = -1e30f, lsum = 0.f;
  f32x4 o[4];
#pragma unroll
  for (int i = 0; i < 4; ++i) o[i] = (f32x4){0.f, 0.f, 0.f, 0.f};
  bf16x8 bq[2];
  uint4 kraw, vraw;
  const int skey = tid >> 3, sdc = tid & 7;
#define NA_KTOK(CI) (((CI) < nloc) ? b * 2048 + (u0 + (CI)) * 64 : TL + b * 256 + ((CI) - nloc) * 64)
  {
    const int kt0 = NA_KTOK(0);
    kraw = *(const uint4*)(slab + (size_t)(kt0 + skey) * PS + NA_OFF + 256 + hd * 64 + sdc * 8);
    vraw = *(const uint4*)(slab + (size_t)(kt0 + skey) * PS + NA_OFF + 512 + hd * 64 + sdc * 8);
  }
#pragma unroll 1
  for (int ci = 0; ci < nchunks; ++ci) {
    __syncthreads();
    const bool lc = ci < nloc;
    const int rr = u0 + ci;
    const bool active = !lc || (rr >= rs && rr < rs + 8);
    {
      const int key = skey, dc = sdc;
      float v[8];
      unpack8(kraw, v);
      float ss = 0.f;
#pragma unroll
      for (int e = 0; e < 8; ++e) ss += v[e] * v[e];
      ss += __shfl_xor(ss, 1); ss += __shfl_xor(ss, 2); ss += __shfl_xor(ss, 4);
      const float rinv = rsqrtf(ss * (1.f / 64.f) + 1e-6f);
      uint4 ov;
      ov.x = pack2(v[0] * rinv * kn[dc * 8 + 0], v[1] * rinv * kn[dc * 8 + 1]);
      ov.y = pack2(v[2] * rinv * kn[dc * 8 + 2], v[3] * rinv * kn[dc * 8 + 3]);
      ov.z = pack2(v[4] * rinv * kn[dc * 8 + 4], v[5] * rinv * kn[dc * 8 + 5]);
      ov.w = pack2(v[6] * rinv * kn[dc * 8 + 6], v[7] * rinv * kn[dc * 8 + 7]);
      *(uint4*)(Ks + key * 72 + dc * 8) = ov;
      const unsigned w4[4] = {vraw.x, vraw.y, vraw.z, vraw.w};
#pragma unroll
      for (int e = 0; e < 4; ++e) {
        Vt[(dc * 8 + 2 * e) * 72 + key] = (u16)(w4[e] & 0xffffu);
        Vt[(dc * 8 + 2 * e + 1) * 72 + key] = (u16)(w4[e] >> 16);
      }
    }
    __syncthreads();
    if (ci + 1 < nchunks) {
      const int kt1 = NA_KTOK(ci + 1);
      kraw = *(const uint4*)(slab + (size_t)(kt1 + skey) * PS + NA_OFF + 256 + hd * 64 + sdc * 8);
      vraw = *(const uint4*)(slab + (size_t)(kt1 + skey) * PS + NA_OFF + 512 + hd * 64 + sdc * 8);
    }
    if (ci == 0) {
      bq[0] = *(const bf16x8*)(Qs + (grp * 64 + w4 * 16 + fr) * 72 + fq * 8);
      bq[1] = *(const bf16x8*)(Qs + (grp * 64 + w4 * 16 + fr) * 72 + 32 + fq * 8);
    }
    if (active) {
      f32x4 s[4];
#pragma unroll
      for (int mt = 0; mt < 4; ++mt) {
        s[mt] = (f32x4){0.f, 0.f, 0.f, 0.f};
#pragma unroll
        for (int ks = 0; ks < 2; ++ks) {
          bf16x8 a = *(const bf16x8*)(Ks + (mt * 16 + fr) * 72 + ks * 32 + fq * 8);
          s[mt] = __builtin_amdgcn_mfma_f32_16x16x32_bf16(a, bq[ks], s[mt], 0, 0, 0);
        }
      }
      float cmax = -1e30f;
#pragma unroll
      for (int mt = 0; mt < 4; ++mt)
#pragma unroll
        for (int j = 0; j < 4; ++j) {
          float v = s[mt][j] * 0.125f;
          if (lc) {
            const int kc = mt * 16 + fq * 4 + j;
            const bool ok = (kc >= cs) && (kc < cs + 16);
            int dcol = min(max(kc - qc, -15), 15);
            v = ok ? v + rpbs[(rr - r + 7) * 31 + dcol + 15] : -1e30f;
          }
          s[mt][j] = v;
          cmax = fmaxf(cmax, v);
        }
      cmax = allmax_rows(cmax);
      const float mnew = fmaxf(m, cmax);
      const float alpha = __expf(m - mnew);
      m = mnew;
      float ps = 0.f;
#pragma unroll
      for (int mt = 0; mt < 4; ++mt)
#pragma unroll
        for (int j = 0; j < 4; ++j) { float pp = __expf(s[mt][j] - mnew); s[mt][j] = pp; ps += pp; }
      lsum = lsum * alpha + ps;
#pragma unroll
      for (int dt = 0; dt < 4; ++dt) o[dt] *= alpha;
      bf16x8 pb[2];
#pragma unroll
      for (int h2 = 0; h2 < 2; ++h2) {
#pragma unroll
        for (int e = 0; e < 4; ++e) {
          pb[h2][e] = (short)f2bf(s[2 * h2][e]);
          pb[h2][4 + e] = (short)f2bf(s[2 * h2 + 1][e]);
        }
      }
#pragma unroll
      for (int dt = 0; dt < 4; ++dt)
#pragma unroll
        for (int h2 = 0; h2 < 2; ++h2) {
          bf16x4 va = *(const bf16x4*)(Vt + (dt * 16 + fr) * 72 + (2 * h2) * 16 + fq * 4);
          bf16x4 vb = *(const bf16x4*)(Vt + (dt * 16 + fr) * 72 + (2 * h2 + 1) * 16 + fq * 4);
          bf16x8 a = __builtin_shufflevector(va, vb, 0, 1, 2, 3, 4, 5, 6, 7);
          o[dt] = __builtin_amdgcn_mfma_f32_16x16x32_bf16(a, pb[h2], o[dt], 0, 0, 0);
        }
    }
  }
  {
    lsum = allred_rows(lsum);
    const float inv = 1.f / lsum;
    u16* cat = (u16*)(p->ws + OFF_H);
    const int tok = qtok0 + w4 * 16 + fr;
#pragma unroll
    for (int dt = 0; dt < 4; ++dt) {
      uint2 ov;
      ov.x = pack2(o[dt][0] * inv, o[dt][1] * inv);
      ov.y = pack2(o[dt][2] * inv, o[dt][3] * inv);
      *(uint2*)(cat + (size_t)tok * 1024 + 256 + hd * 64 + dt * 16 + fq * 4) = ov;
    }
  }
}

DEV void combine_token(PC p, int l, int tok, const float* g, const u16* slab, const u16* rwl, const u16* dno, const u16* rwy, u16* cat, const float* mu, int c4) {
    int base, n;
    if (tok < TL) { base = (tok >> 11) << 11; n = 2048; } else { base = TL + (((tok - TL) >> 8) << 8); n = 256; }
    const int pos = tok - base;
    {
      float4 ov;
      {
        const uint2 f0 = *(const uint2*)(dno + (size_t)tok * 256 + c4), f1 = *(const uint2*)(dno + (size_t)TT * 256 + (size_t)tok * 256 + c4);
        ov.x = __uint_as_float(f0.x << 16) + __uint_as_float(f1.x << 16);
        ov.y = __uint_as_float(f0.x & 0xffff0000u) + __uint_as_float(f1.x & 0xffff0000u);
        ov.z = __uint_as_float(f0.y << 16) + __uint_as_float(f1.y << 16);
        ov.w = __uint_as_float(f0.y & 0xffff0000u) + __uint_as_float(f1.y & 0xffff0000u);
      }
      float ss = ov.x * ov.x + ov.y * ov.y + ov.z * ov.z + ov.w * ov.w;
      ss += __shfl_xor(ss, 1); ss += __shfl_xor(ss, 2); ss += __shfl_xor(ss, 4); ss += __shfl_xor(ss, 8);
      const float rinv = rsqrtf(ss * (1.f / 64.f) + 1e-6f);
      const float* nw = p->in[I_DNNORM] + l * 64 + (c4 & 63);
      uint2 zz = *(const uint2*)(slab + (size_t)tok * PS + DN_OFF + 768 + c4);
      float z0 = __uint_as_float(zz.x << 16), z1 = __uint_as_float(zz.x & 0xffff0000u), z2 = __uint_as_float(zz.y << 16), z3 = __uint_as_float(zz.y & 0xffff0000u);
      uint2 o2;
      o2.x = pack2(ov.x * rinv * nw[0] * siluf_(z0), ov.y * rinv * nw[1] * siluf_(z1));
      o2.y = pack2(ov.z * rinv * nw[2] * siluf_(z2), ov.w * rinv * nw[3] * siluf_(z3));
      *(uint2*)(cat + (size_t)tok * 1024 + 512 + c4) = o2;
    }
    {
      float ts[3][4];
#pragma unroll
      for (int sgi = 0; sgi < 3; ++sgi) {
        const int col = RW_OFF + sgi * 256 + c4;
        uint2 cu = *(const uint2*)(slab + (size_t)tok * PS + col);
        uint2 pu = pos > 0 ? *(const uint2*)(slab + (size_t)(tok - 1) * PS + col) : make_uint2(0, 0);
        uint2 nu = pos < n - 1 ? *(const uint2*)(slab + (size_t)(tok + 1) * PS + col) : make_uint2(0, 0);
        float uc[4] = {__uint_as_float(cu.x << 16), __uint_as_float(cu.x & 0xffff0000u), __uint_as_float(cu.y << 16), __uint_as_float(cu.y & 0xffff0000u)};
        float up[4] = {__uint_as_float(pu.x << 16), __uint_as_float(pu.x & 0xffff0000u), __uint_as_float(pu.y << 16), __uint_as_float(pu.y & 0xffff0000u)};
        float un[4] = {__uint_as_float(nu.x << 16), __uint_as_float(nu.x & 0xffff0000u), __uint_as_float(nu.y << 16), __uint_as_float(nu.y & 0xffff0000u)};
#pragma unroll
        for (int e = 0; e < 4; ++e) ts[sgi][e] = uc[e] + mu[sgi * 256 + c4 + e] * (up[e] - uc[e]) + mu[896 + sgi * 256 + c4 + e] * (un[e] - uc[e]);
      }
      float4 yv;
      {
        const uint2 f0 = *(const uint2*)(rwy + (size_t)tok * 256 + c4), f1 = *(const uint2*)(rwy + (size_t)TT * 256 + (size_t)tok * 256 + c4);
        yv.x = __uint_as_float(f0.x << 16) + __uint_as_float(f1.x << 16);
        yv.y = __uint_as_float(f0.x & 0xffff0000u) + __uint_as_float(f1.x & 0xffff0000u);
        yv.z = __uint_as_float(f0.y << 16) + __uint_as_float(f1.y << 16);
        yv.w = __uint_as_float(f0.y & 0xffff0000u) + __uint_as_float(f1.y & 0xffff0000u);
      }
      float y[4] = {yv.x, yv.y, yv.z, yv.w};
      float sm = y[0] + y[1] + y[2] + y[3];
      sm += __shfl_xor(sm, 1); sm += __shfl_xor(sm, 2); sm += __shfl_xor(sm, 4); sm += __shfl_xor(sm, 8);
      const float mean = sm * (1.f / 64.f);
      float sq = 0.f;
#pragma unroll
      for (int e = 0; e < 4; ++e) sq += (y[e] - mean) * (y[e] - mean);
      sq += __shfl_xor(sq, 1); sq += __shfl_xor(sq, 2); sq += __shfl_xor(sq, 4); sq += __shfl_xor(sq, 8);
      const float rstd = rsqrtf(sq * (1.f / 64.f) + 64e-5f);
      uint2 al0 = *(const uint2*)(rwl + (size_t)tok * 1024 + 256 + c4);
      uint2 al1 = *(const uint2*)(rwl + (size_t)tok * 1024 + 512 + 256 + c4);
      float a0l[4] = {__uint_as_float(al0.x << 16), __uint_as_float(al0.x & 0xffff0000u), __uint_as_float(al0.y << 16), __uint_as_float(al0.y & 0xffff0000u)};
      float a1l[4] = {__uint_as_float(al1.x << 16), __uint_as_float(al1.x & 0xffff0000u), __uint_as_float(al1.y << 16), __uint_as_float(al1.y & 0xffff0000u)};
      float bs = 0.f;
#pragma unroll
      for (int e = 0; e < 4; ++e) {
        const int ch = c4 + e;
        const float a0 = a0l[e];
        const float a1 = a1l[e];
        const float ka = p->in[I_RWKA][l * 256 + ch];
        const float ksum = ts[1][e] * (2.f + (a0 + a1 - 2.f) * ka);
        bs += ts[0][e] * ksum * p->in[I_RWRK][l * 256 + ch];
      }
      bs += __shfl_xor(bs, 1); bs += __shfl_xor(bs, 2); bs += __shfl_xor(bs, 4); bs += __shfl_xor(bs, 8);
      float outv[4];
#pragma unroll
      for (int e = 0; e < 4; ++e) {
        const int ch = c4 + e;
        const float yn = (y[e] - mean) * rstd * p->in[I_RWLNW][l * 256 + ch] + p->in[I_RWLNB][l * 256 + ch];
        outv[e] = (yn + bs * ts[2][e]) * g[e];
      }
      uint2 o2; o2.x = pack2(outv[0], outv[1]); o2.y = pack2(outv[2], outv[3]);
      *(uint2*)(cat + (size_t)tok * 1024 + 768 + c4) = o2;
    }
}

__device__ __attribute__((always_inline)) void combine_pass(PC p, int l, int ntok, unsigned char* smem) {
  const int tid = TID(), wave = tid >> 6, lane = tid & 63;
  float* sg = (float*)smem + wave * 192;
  const u16* slab = (const u16*)(p->ws + OFF_SLAB);
  const u16* rwl = (const u16*)(p->ws + OFF_RWL);
  const u16* dno = (const u16*)(p->ws + OFF_DNO);
  const u16* rwy = (const u16*)(p->ws + OFF_RWY);
  u16* cat = (u16*)(p->ws + OFF_H);
  const float* mu = p->in[I_RWMU] + l * 2 * 896;
  const float* gup = p->in[I_RWGUP] + (size_t)l * 64 * 256;
  const int c4 = lane * 4;
  __syncthreads();
  for (int tok0 = (BID() * 8 + wave) * 3; tok0 < ntok; tok0 += NBLK() * 8 * 3) {
#pragma unroll
    for (int tt = 0; tt < 3; ++tt) {
      const int tok = min(tok0 + tt, ntok - 1);
      int base, n;
      if (tok < TL) { base = (tok >> 11) << 11; n = 2048; } else { base = TL + (((tok - TL) >> 8) << 8); n = 256; }
      const int pos = tok - base;
      const int col = RW_OFF + 832 + lane;
      float u = bf2f(slab[(size_t)tok * PS + col]);
      float pv = pos > 0 ? bf2f(slab[(size_t)(tok - 1) * PS + col]) : 0.f;
      float nx = pos < n - 1 ? bf2f(slab[(size_t)(tok + 1) * PS + col]) : 0.f;
      float sv = u + mu[832 + lane] * (pv - u) + mu[896 + 832 + lane] * (nx - u);
      sg[tt * 64 + lane] = sigmoidf_(sv);
    }
    float g[3][4];
#pragma unroll
    for (int tt = 0; tt < 3; ++tt)
#pragma unroll
      for (int e = 0; e < 4; ++e) g[tt][e] = 0.f;
#pragma unroll 4
    for (int j = 0; j < 64; ++j) {
      const float4 gw = *(const float4*)(gup + j * 256 + c4);
#pragma unroll
      for (int tt = 0; tt < 3; ++tt) {
        const float sj = sg[tt * 64 + j];
        g[tt][0] = fmaf(sj, gw.x, g[tt][0]); g[tt][1] = fmaf(sj, gw.y, g[tt][1]); g[tt][2] = fmaf(sj, gw.z, g[tt][2]); g[tt][3] = fmaf(sj, gw.w, g[tt][3]);
      }
    }
#pragma unroll
    for (int tt = 0; tt < 3; ++tt)
      if (tok0 + tt < ntok) combine_token(p, l, tok0 + tt, g[tt], slab, rwl, dno, rwy, cat, mu, c4);
  }
}

#ifndef XB_ALL_RELEASE
#define XB_ALL_RELEASE 0
#endif
#define XB_TMO      128
#define XB_XCNT(j)  (256  + 64 * (j))
#define XB_XSUB(j)  (1280 + 64 * (j))
#define XB_XGEN(j)  (2304 + 64 * (j))
#define XB_TOP      3328
#define XB_TOPGEN   3392
#define XB_SPIN_CAP (1u << 18)
#define LAS __attribute__((address_space(3)))
DEV unsigned xb_ld(unsigned* p) { return __hip_atomic_load(p, __ATOMIC_RELAXED, __HIP_MEMORY_SCOPE_AGENT); }
DEV unsigned xb_add(unsigned* p, unsigned v) { return __hip_atomic_fetch_add(p, v, __ATOMIC_RELAXED, __HIP_MEMORY_SCOPE_AGENT); }
DEV unsigned xb_xcc_id() { return (unsigned)__builtin_amdgcn_s_getreg((3 << 11) | 20) & 0xFu; }
#define XB_SPIN(cond, bar) do { unsigned _sp = 0; while (cond) { __builtin_amdgcn_s_sleep(1); \
    if ((++_sp & 255u) == 0u) { if (xb_ld(&(bar)[XB_TMO])) break; if (_sp > XB_SPIN_CAP) { atomicAdd(&(bar)[XB_TMO], 1u); break; } } } } while (0)
struct XcdBarrier { unsigned* bar; unsigned x; volatile LAS unsigned* st; };
DEV XcdBarrier xcd_barrier_post(unsigned* bar, volatile LAS unsigned* st) {
  XcdBarrier b; b.bar = bar; b.x = xb_xcc_id(); b.st = st;
  if (threadIdx.x == 0) (void)xb_add(&bar[XB_XCNT(b.x)], 1u);
  return b;
}
DEV void xcd_barrier_complete(unsigned* bar, unsigned x, unsigned& nloc, unsigned& nx) {
  const unsigned G = gridDim.x * gridDim.y * gridDim.z;
  unsigned sum, cnt, mine, sp = 0u;
  for (;;) {
    sum = 0u; cnt = 0u; mine = 0u;
#pragma unroll
    for (unsigned j = 0; j < 16; ++j) { const unsigned c = xb_ld(&bar[XB_XCNT(j)]); sum += c; cnt += (c > 0u) ? 1u : 0u; mine = (j == x) ? c : mine; }
    if (sum == G) break;
    __builtin_amdgcn_s_sleep(1);
    if ((++sp & 255u) == 0u) { if (xb_ld(&bar[XB_TMO])) break; if (sp > XB_SPIN_CAP) { atomicAdd(&bar[XB_TMO], 1u); break; } }
  }
  nloc = mine > 0u ? mine : 1u; nx = cnt > 0u ? cnt : 1u;
}
DEV void xcd_barrier(const XcdBarrier& b) {
  asm volatile("s_waitcnt vmcnt(0)" ::: "memory");
  __syncthreads();
  if (threadIdx.x == 0) {
    unsigned* bar = b.bar;
    __builtin_amdgcn_s_waitcnt(0);
#if XB_ALL_RELEASE
    __builtin_amdgcn_fence(__ATOMIC_RELEASE, "agent");
    asm volatile("s_waitcnt vmcnt(0)" ::: "memory");
#endif
    unsigned nloc = b.st[0], nx = b.st[1];
    if (nloc == 0u) { xcd_barrier_complete(bar, b.x, nloc, nx); b.st[0] = nloc; b.st[1] = nx; }
    const unsigned old = xb_add(&bar[XB_XSUB(b.x)], 1u);
    const unsigned gen = old / nloc;
    if (old + 1u == (gen + 1u) * nloc) {
      __builtin_amdgcn_fence(__ATOMIC_RELEASE, "agent");
      asm volatile("s_waitcnt vmcnt(0)" ::: "memory");
      const unsigned og = xb_add(&bar[XB_TOP], 1u);
      const unsigned tg = og / nx;
      if (og + 1u == (tg + 1u) * nx) xb_add(&bar[XB_TOPGEN], 1u);
      else XB_SPIN(xb_ld(&bar[XB_TOPGEN]) == tg, bar);
      __builtin_amdgcn_fence(__ATOMIC_ACQUIRE, "agent");
      xb_add(&bar[XB_XGEN(b.x)], 1u);
      asm volatile("s_waitcnt vmcnt(0)" ::: "memory");
    } else {
      XB_SPIN(xb_ld(&bar[XB_XGEN(b.x)]) == gen, bar);
      __builtin_amdgcn_fence(__ATOMIC_ACQUIRE, "agent");
      asm volatile("s_waitcnt vmcnt(0)" ::: "memory");
    }
  }
  __syncthreads();
}

DEV void ctr_barrier(unsigned* ctr, unsigned& epoch) {
  asm volatile("s_waitcnt vmcnt(0)" ::: "memory");
  __syncthreads();
  if (threadIdx.x == 0) {
    __builtin_amdgcn_fence(__ATOMIC_RELEASE, "agent");
    asm volatile("s_waitcnt vmcnt(0)" ::: "memory");
    epoch += 1;
    const unsigned target = epoch * gridDim.x;
    (void)xb_add(ctr, 1u);
    unsigned sp = 0;
    while (xb_ld(ctr) < target) { __builtin_amdgcn_s_sleep(1); if (++sp > (1u << 24)) break; }
    __builtin_amdgcn_fence(__ATOMIC_ACQUIRE, "agent");
    asm volatile("s_waitcnt vmcnt(0)" ::: "memory");
  }
  __syncthreads();
}
#ifndef USE_CTR_BARRIER
#define USE_CTR_BARRIER 0
#endif
#if USE_CTR_BARRIER
#define GBAR() ctr_barrier((unsigned*)(launder(pk)->ws + OFF_BAR), gb_epoch)
#else
#define GBAR() xcd_barrier(xb)
#endif

__global__ void __launch_bounds__(512) fwd_megakernel(P p_unused) {
  cg::grid_group grid = cg::this_grid();
  PC pk = (PC)__builtin_amdgcn_kernarg_segment_ptr();
  __shared__ __attribute__((aligned(16))) unsigned char smem[SMEM_BYTES];
  __shared__ int s_task;
  __shared__ uint4 xb_words;
  if (threadIdx.x == 0) xb_words = make_uint4(0u, 0u, 0u, 0u);
  __syncthreads();
  const XcdBarrier xb = xcd_barrier_post((unsigned*)(launder(pk)->ws + OFF_BAR), (volatile LAS unsigned*)&xb_words);
  unsigned gb_epoch = 0;
  __shared__ int s_vbid;
  if (threadIdx.x == 0) s_vbid = (int)xb_add((unsigned*)(launder(pk)->ws + OFF_CNT) + 16 + xb.x, 1u) * 8 + (int)xb.x;
  const int tid = TID();
  const int nb = NBLK(), bid = BID();

  {
    LOADP();
    for (int rep = 0; rep <= PROBE_P0; ++rep) {
      for (int t = bid; t < 144 + 144; t += nb) {
        if (t < 144) task_mod(p, t, smem);
        else task_filter(p, t - 144, smem);
      }
      convert_all(p, 0, smem);
    }
  }
  grid.sync();
  int vbid;
  {
    unsigned* bar = (unsigned*)(launder(pk)->ws + OFF_BAR);
    bool ok = (gridDim.x == 256);
    for (int j = 0; j < 16; ++j) { const unsigned c = xb_ld(&bar[XB_XCNT(j)]); ok = ok && (c == (j < 8 ? 32u : 0u)); }
    vbid = ok ? s_vbid : -1;
    vbid = __builtin_amdgcn_readfirstlane(vbid);
  }

#pragma unroll 1
  for (int l = 0; l < 2; ++l) {
    const bool need_ctx = (l == 0);
    {
      LOADP();
      if (l == 1) convert_all(p, 1, smem);
      for (int rep = 0; rep <= PROBE_ADALN; ++rep) adaln_pass(p, l, 0, (l == 0) ? p->in[I_X] : p->out, (l == 0) ? p->in[I_CTX] : (const float*)(p->ws + OFF_XC), TT);
    }
    GBAR();
    {
      LOADP();
      Epi e{}; e.outb = (u16*)(p->ws + OFF_ACT);
      for (int rep = 0; rep <= PROBE_GEMM; ++rep) gemm_phase_big<0>((const u16*)(p->ws + OFF_H), 1024, (const u16*)(p->ws + OFF_WGU), 1024, TT, 5632, e, smem);
    }
    GBAR();
    {
      LOADP();
      float* xc = (float*)(p->ws + OFF_XC);
      Epi e{}; e.xs_lat = (l == 0) ? p->in[I_X] : p->out; e.xs_ctx = (l == 0) ? p->in[I_CTX] : xc; e.xd_lat = p->out; e.xd_ctx = xc;
      e.gate = (const float*)(p->ws + OFF_MOD) + (size_t)l * 9 * 9216 + 2 * 1024; e.coef = 0.5f;
      gemm_phase<1, 192>((const u16*)(p->ws + OFF_ACT), DFF, (const u16*)(p->ws + OFF_WDN), DFF, TT, 1024, e, smem, vbid);
    }
    GBAR();
    {
      LOADP();
      for (int rep = 0; rep <= PROBE_ADALN; ++rep) adaln_pass(p, l, 1, p->out, (const float*)(p->ws + OFF_XC), TT);
    }
    GBAR();
    {
      LOADP();
      Epi e{}; e.outb = (u16*)(p->ws + OFF_SLAB);
      for (int rep = 0; rep <= PROBE_GEMM; ++rep) gemm_phase_big<2>((const u16*)(p->ws + OFF_H), 1024, (const u16*)(p->ws + OFF_WIN), 1024, TT, PS, e, smem);
    }
    GBAR();
    {
      LOADP();
      for (int rep = 0; rep <= PROBE_PREP; ++rep) for (int t = bid; t < TT / 32; t += nb) prep_task(p, l, t, smem);
    }
    GBAR();
    if (bid < 64) { LOADP(); dn_scan_unit(p, l, bid, smem); }
    else if (bid < 192) { LOADP(); rw_scan_unit(p, l, bid - 64, smem); }
    {
      const int n_hy = need_ctx ? 512 : 256;
      const int n_na = need_ctx ? 512 + 64 : 512;
      const int ntask = n_hy + n_na;
      while (true) {
        LOADP();
        __syncthreads();
        if (tid == 0) s_task = atomicAdd((int*)(p->ws + OFF_CNT) + l * 4, 1);
        __syncthreads();
        const int t = s_task;
        if (t >= ntask) break;
        if (t < n_hy) hyena_task(p, l, 0, t, smem);
        else na_task(p, l, t - n_hy, smem);
      }
    }
    GBAR();
#if PROBE_SCAN
    for (int rep = 0; rep < PROBE_SCAN; ++rep) {
      if (bid < 64) { if (!(PROBE_MODE & 8)) { LOADP(); dn_scan_unit(p, l, bid, smem, PROBE_MODE & 6); } }
      else if (bid < 192) { if (!(PROBE_MODE & 16)) { LOADP(); rw_scan_unit(p, l, bid - 64, smem, PROBE_MODE & 6); } }
      GBAR();
    }
#endif
    for (int rep = 0; rep <= PROBE_M2; ++rep) {
    {
      LOADP();
      const int n_hy = need_ctx ? 512 : 256;
      for (int t = bid; t < n_hy; t += nb) hyena_task(p, l, 1, t, smem);
    }
    {
      LOADP();
      combine_pass(p, l, need_ctx ? TT : TL, smem);
    }
    }
    GBAR();
    {
      LOADP();
      float* xc = (float*)(p->ws + OFF_XC);
      Epi e{}; e.xs_lat = p->out; e.xs_ctx = xc; e.xd_lat = p->out; e.xd_ctx = xc;
      e.gate = (const float*)(p->ws + OFF_MOD) + (size_t)l * 9 * 9216 + 5 * 1024; e.coef = 1.0f;
      if (need_ctx) gemm_phase<1, 192>((const u16*)(p->ws + OFF_H), 1024, (const u16*)(p->ws + OFF_WOUT), 1024, TT, 1024, e, smem, vbid);
      else gemm_phase_big<1>((const u16*)(p->ws + OFF_H), 1024, (const u16*)(p->ws + OFF_WOUT), 1024, TL, 1024, e, smem);
    }
    GBAR();
    {
      LOADP();
      for (int rep = 0; rep <= PROBE_ADALN; ++rep) adaln_pass(p, l, 2, p->out, (const float*)(p->ws + OFF_XC), need_ctx ? TT : TL);
    }
    GBAR();
    {
      LOADP();
      Epi e{}; e.outb = (u16*)(p->ws + OFF_ACT);
      for (int rep = 0; rep <= PROBE_GEMM; ++rep) gemm_phase_big<0>((const u16*)(p->ws + OFF_H), 1024, (const u16*)(p->ws + OFF_WGU) + (size_t)5632 * 1024, 1024, need_ctx ? TT : TL, 5632, e, smem);
    }
    GBAR();
    {
      LOADP();
      float* xc = (float*)(p->ws + OFF_XC);
      Epi e{}; e.xs_lat = p->out; e.xs_ctx = xc; e.xd_lat = p->out; e.xd_ctx = xc;
      e.gate = (const float*)(p->ws + OFF_MOD) + (size_t)l * 9 * 9216 + 8 * 1024; e.coef = 0.5f;
      if (need_ctx) gemm_phase<1, 192>((const u16*)(p->ws + OFF_ACT), DFF, (const u16*)(p->ws + OFF_WDN) + (size_t)1024 * DFF, DFF, TT, 1024, e, smem, vbid);
      else gemm_phase_big<1>((const u16*)(p->ws + OFF_ACT), DFF, (const u16*)(p->ws + OFF_WDN) + (size_t)1024 * DFF, DFF, TL, 1024, e, smem);
    }
    GBAR();
    for (int rep = 0; rep < PROBE_SYNC; ++rep) GBAR();
  }
}

extern "C" void kernel_launch(void* const* d_in, const int* in_sizes, int n_in, void* d_out, int out_size, void* d_ws, size_t ws_size,
                              hipStream_t stream) {
  P p{};
  for (int i = 0; i < 37; ++i) p.in[i] = (const float*)d_in[i];
  p.out = (float*)d_out;
  p.ws = (unsigned char*)d_ws;
  p.pad_ = 0;
  static int grid_blocks = 0;
  if (!grid_blocks) {
    int dev = 0, cus = 0, per_cu = 0;
    hipGetDevice(&dev);
    hipDeviceGetAttribute(&cus, hipDeviceAttributeMultiprocessorCount, dev);
    hipOccupancyMaxActiveBlocksPerMultiprocessor(&per_cu, fwd_megakernel, 512, 0);
    if (per_cu < 1) per_cu = 1;
    grid_blocks = cus;
    if (ws_size < WS_TOTAL) fprintf(stderr, "workspace too small: %zu < %zu\n", ws_size, (size_t)WS_TOTAL);
  }
  hipMemsetAsync((unsigned char*)d_ws + OFF_CNT, 0, 256 + 14080, stream);
  void* args[] = {&p};
  hipError_t e = hipLaunchCooperativeKernel((void*)fwd_megakernel, dim3(grid_blocks), dim3(512), args, 0, stream);
  if (e != hipSuccess) fprintf(stderr, "cooperative launch failed: %s (grid %d)\n", hipGetErrorString(e), grid_blocks);
}
```

```cpp
#include <hip/hip_runtime.h>
#include <hip/hip_cooperative_groups.h>
#include <cstdio>
#include <cstdint>
namespace cg = cooperative_groups;

typedef unsigned short u16;
typedef short bf16x8 __attribute__((ext_vector_type(8)));
typedef short bf16x4 __attribute__((ext_vector_type(4)));
typedef float f32x4 __attribute__((ext_vector_type(4)));
typedef unsigned u32x4 __attribute__((ext_vector_type(4)));
typedef float f32x16 __attribute__((ext_vector_type(16)));
#define DEV __device__ __forceinline__

constexpr int TL = 16384, TC = 2048, TT = 18432, DM = 1024, DFF = 2816, PS = 3584;
constexpr int NA_OFF = 768, DN_OFF = 1536, RW_OFF = 2576;
constexpr int SMEM_BYTES = 147456;
#ifndef PROBE_SCAN
#define PROBE_SCAN 0
#endif
#ifndef PROBE_MODE
#define PROBE_MODE 6
#endif
#ifndef PROBE_GEMM
#define PROBE_GEMM 0
#endif
#ifndef PROBE_SYNC
#define PROBE_SYNC 0
#endif
#ifndef PROBE_P0
#define PROBE_P0 0
#endif
#ifndef PROBE_ADALN
#define PROBE_ADALN 0
#endif
#ifndef PROBE_PREP
#define PROBE_PREP 0
#endif
#ifndef PROBE_M2
#define PROBE_M2 0
#endif

constexpr size_t OFF_WGU = 0;
constexpr size_t OFF_WDN = OFF_WGU + (size_t)2 * 5632 * 1024 * 2;
constexpr size_t OFF_WIN = OFF_WDN + (size_t)2 * 1024 * 2816 * 2;
constexpr size_t OFF_WOUT = OFF_WIN + (size_t)3584 * 1024 * 2;
constexpr size_t OFF_XC = OFF_WOUT + (size_t)1024 * 1024 * 2;
constexpr size_t OFF_H = OFF_XC + (size_t)TC * 1024 * 4;
constexpr size_t OFF_MOD = OFF_H + (size_t)TT * 1024 * 2;
constexpr size_t FILT_LAYER = ((size_t)512 * 4096 + (size_t)512 * 512) * 2;
constexpr size_t OFF_FILT = OFF_MOD + (size_t)2 * 9 * 9216 * 4;
constexpr size_t OFF_FPART = OFF_FILT + 2 * FILT_LAYER;
constexpr size_t OFF_CNT = OFF_FPART + (size_t)2 * 72 * 1024 * 4;
constexpr size_t OFF_BAR = OFF_CNT + 256;
constexpr size_t BAR_BYTES = 3456 * 4;
constexpr size_t OFF_R1 = OFF_BAR + 14080;
constexpr size_t OFF_SLAB = OFF_R1;
constexpr size_t OFF_ACT = OFF_R1;
constexpr size_t OFF_HYZ = OFF_SLAB + (size_t)TT * PS * 2;
constexpr size_t OFF_HXT = OFF_HYZ + (size_t)TT * 256 * 2;
constexpr size_t OFF_DNO = OFF_HXT + (size_t)TT * 768 * 2;
constexpr size_t OFF_RWY = OFF_DNO + (size_t)TT * 256 * 4;
constexpr size_t OFF_RWL = OFF_RWY + (size_t)TT * 256 * 4;
constexpr size_t WS_TOTAL = OFF_RWL + (size_t)TT * 1024 * 2;

struct P {
  const float* in[37];
  float* out;
  unsigned char* ws;
  size_t pad_;
};
enum { I_X = 0, I_C, I_CTX, I_CCTX, I_WMOD, I_BMOD, I_NORMW, I_WGU, I_WDOWN, I_WIN, I_WOUT, I_HYCONV, I_HYW1, I_HYB1, I_HYW2,
       I_HYB2, I_HYW3, I_HYFREQ, I_HYBIAS, I_NAQN, I_NAKN, I_NARPB, I_DNCONV, I_DNALOG, I_DNDT, I_DNNORM, I_RWMU, I_RWW0,
       I_RWWUP, I_RWA0, I_RWAUP, I_RWGUP, I_RWKK, I_RWKA, I_RWRK, I_RWLNW, I_RWLNB };

typedef const P __attribute__((address_space(4)))* PC;
DEV PC launder(PC q) { asm volatile("" : "+s"(q)); return q; }
#define LOADP() PC p = launder(pk)

DEV u16 f2bf(float f) { unsigned u = __float_as_uint(f); u += 0x7fffu + ((u >> 16) & 1u); return (u16)(u >> 16); }
DEV float bf2f(u16 h) { return __uint_as_float(((unsigned)h) << 16); }
DEV float sigmoidf_(float x) { return __builtin_amdgcn_rcpf(1.f + __expf(-x)); }
DEV float siluf_(float x) { return x * __builtin_amdgcn_rcpf(1.f + __expf(-x)); }
DEV float softplusf_(float x) { return x > 20.f ? x : log1pf(__expf(x)); }
DEV float wave_sum(float v) {
#pragma unroll
  for (int o = 32; o > 0; o >>= 1) v += __shfl_xor(v, o);
  return v;
}
DEV float allred_rows(float x) {
  auto r = __builtin_amdgcn_permlane32_swap(__float_as_uint(x), __float_as_uint(x), false, false);
  float y = __uint_as_float(r[0]) + __uint_as_float(r[1]);
  auto r2 = __builtin_amdgcn_permlane16_swap(__float_as_uint(y), __float_as_uint(y), false, false);
  return __uint_as_float(r2[0]) + __uint_as_float(r2[1]);
}
DEV float allmax_rows(float x) {
  auto r = __builtin_amdgcn_permlane32_swap(__float_as_uint(x), __float_as_uint(x), false, false);
  float y = fmaxf(__uint_as_float(r[0]), __uint_as_float(r[1]));
  auto r2 = __builtin_amdgcn_permlane16_swap(__float_as_uint(y), __float_as_uint(y), false, false);
  return fmaxf(__uint_as_float(r2[0]), __uint_as_float(r2[1]));
}
DEV void unpack8(uint4 v, float* f) {
  f[0] = __uint_as_float(v.x << 16); f[1] = __uint_as_float(v.x & 0xffff0000u);
  f[2] = __uint_as_float(v.y << 16); f[3] = __uint_as_float(v.y & 0xffff0000u);
  f[4] = __uint_as_float(v.z << 16); f[5] = __uint_as_float(v.z & 0xffff0000u);
  f[6] = __uint_as_float(v.w << 16); f[7] = __uint_as_float(v.w & 0xffff0000u);
}
DEV unsigned pack2(float a, float b) { return (unsigned)f2bf(a) | ((unsigned)f2bf(b) << 16); }

DEV int TID() { int t = threadIdx.x; asm volatile("" : "+v"(t)); return t; }
DEV int BID() { int t = blockIdx.x; asm volatile("" : "+s"(t)); return t; }
DEV int NBLK() { int t = gridDim.x; asm volatile("" : "+s"(t)); return t; }
DEV int step_tok(int b, int dir, int s, int& pos, int& n) {
  if (s < 256) { n = 256; pos = dir ? 255 - s : s; return TL + b * 256 + pos; }
  n = 2048; pos = dir ? 2047 - (s - 256) : (s - 256); return b * 2048 + pos;
}

__device__ __attribute__((always_inline)) void task_mod(PC p, int task, unsigned char* smem) {
  float* sc = (float*)smem;
  float* part = (float*)(smem + 36864);
  const int tid = TID();
  for (int i = tid; i < 9 * 1024; i += 512) {
    int r = i >> 10, k = i & 1023;
    float v = (r < 8) ? p->in[I_C][r * 1024 + k] : p->in[I_CCTX][k];
    sc[i] = siluf_(v);
  }
  __syncthreads();
  const int l = task / 72, jj = tid & 127, j = (task % 72) * 128 + jj, kp = tid >> 7;
  const float* w = p->in[I_WMOD] + (size_t)l * 1024 * 9216 + j;
  float acc[9];
#pragma unroll
  for (int r = 0; r < 9; ++r) acc[r] = 0.f;
#pragma unroll 8
  for (int k = kp * 256; k < kp * 256 + 256; ++k) {
    float wv = w[(size_t)k * 9216];
#pragma unroll
    for (int r = 0; r < 9; ++r) acc[r] = fmaf(sc[r * 1024 + k], wv, acc[r]);
  }
#pragma unroll
  for (int r = 0; r < 9; ++r) part[(kp * 9 + r) * 128 + jj] = acc[r];
  __syncthreads();
  float* mod = (float*)(p->ws + OFF_MOD);
  for (int i = tid; i < 9 * 128; i += 512) {
    int r = i >> 7, c = i & 127;
    float s = part[(0 * 9 + r) * 128 + c] + part[(1 * 9 + r) * 128 + c] + part[(2 * 9 + r) * 128 + c] + part[(3 * 9 + r) * 128 + c];
    int jg = (task % 72) * 128 + c;
    mod[(size_t)(l * 9 + r) * 9216 + jg] = s + p->in[I_BMOD][l * 9216 + jg];
  }
  __syncthreads();
}

__device__ __attribute__((always_inline)) void task_filter(PC p, int task, unsigned char* smem) {
  float* z = (float*)smem;
  float* h1 = z + 32 * 34;
  float* h2t = h1 + 32 * 64;
  const int tid = TID();
  const int l = task / 72, ck = task % 72;
  const int ty = ck >= 64, n = ty ? 256 : 2048, chunk = ty ? ck - 64 : ck;
  const float* w1 = p->in[I_HYW1] + l * 33 * 64;
  const float* b1 = p->in[I_HYB1] + l * 64;
  const float* w2 = p->in[I_HYW2] + l * 64 * 64;
  const float* b2 = p->in[I_HYB2] + l * 64;
  const float* w3 = p->in[I_HYW3] + (size_t)l * 64 * 1024;
  const float* fr = p->in[I_HYFREQ] + l * 64;
  for (int i = tid; i < 32 * 33; i += 512) {
    int li = i / 33, e = i % 33;
    int lag = chunk * 32 + li;
    float v;
    if (e == 0) v = (float)lag / (float)(n - 1);
    else {
      float ang = (6.283185307179586f * (float)lag) / (float)n;
      int jb = (e - 1) & 15;
      float band = 1e-4f + (float)jb * ((15.f - 1e-4f) / 15.f);
      float a = band * ang;
      v = (e <= 16) ? cosf(a) : -sinf(a);
    }
    z[li * 34 + e] = v;
  }
  __syncthreads();
  for (int i = tid; i < 32 * 64; i += 512) {
    int li = i >> 6, m = i & 63;
    float s = b1[m];
    for (int e = 0; e < 33; ++e) s = fmaf(z[li * 34 + e], w1[e * 64 + m], s);
    h1[li * 64 + m] = sinf(fr[m] * s);
  }
  __syncthreads();
  for (int i = tid; i < 32 * 64; i += 512) {
    int li = i >> 6, m = i & 63;
    float s = b2[m];
    for (int e = 0; e < 64; ++e) s = fmaf(h1[li * 64 + e], w2[e * 64 + m], s);
    h2t[m * 32 + li] = sinf(fr[m] * s);
  }
  __syncthreads();
  u16* filt = (u16*)(p->ws + OFF_FILT + (size_t)l * FILT_LAYER) + (ty ? (size_t)512 * 4096 : 0);
  float* fpart = (float*)(p->ws + OFF_FPART) + (size_t)(l * 72 + ck) * 1024;
  const float min_decay = -4.605170185988091f / 1.5f, max_decay = -4.605170185988091f / 0.3f;
#pragma unroll 1
  for (int half = 0; half < 2; ++half) {
    const int o = tid + half * 512;
    float acc[32];
#pragma unroll
    for (int i = 0; i < 32; ++i) acc[i] = 0.f;
#pragma unroll 1
    for (int m0 = 0; m0 < 64; m0 += 8) {
      float wv8[8];
#pragma unroll
      for (int j = 0; j < 8; ++j) wv8[j] = w3[(m0 + j) * 1024 + o];
#pragma unroll
      for (int j = 0; j < 8; ++j) {
        const float wv = wv8[j];
#pragma unroll
        for (int q = 0; q < 8; ++q) {
          float4 hv = *(const float4*)(h2t + (m0 + j) * 32 + q * 4);
          acc[q * 4 + 0] = fmaf(hv.x, wv, acc[q * 4 + 0]);
          acc[q * 4 + 1] = fmaf(hv.y, wv, acc[q * 4 + 1]);
          acc[q * 4 + 2] = fmaf(hv.z, wv, acc[q * 4 + 2]);
          acc[q * 4 + 3] = fmaf(hv.w, wv, acc[q * 4 + 3]);
        }
      }
    }
    const int dir = o >> 9, oc = o & 511;
    const float delta = fabsf(min_decay + (float)oc * ((max_decay - min_decay) / 511.f));
    float asum = 0.f;
    u16* frow = filt + (size_t)oc * (2 * n);
#pragma unroll
    for (int li = 0; li < 32; ++li) {
      int lag = chunk * 32 + li;
      float t = (float)lag / (float)(n - 1);
      float v = acc[li] * __expf(-t * delta);
      if (dir == 0) { frow[n - 1 + lag] = f2bf(v); asum += fabsf(v); }
      else if (lag >= 1) { frow[n - 1 - lag] = f2bf(v); asum += fabsf(v); }
    }
    fpart[o] = asum;
  }
  __syncthreads();
}

DEV void lds_barrier() { asm volatile("s_waitcnt lgkmcnt(0)\n\ts_barrier" ::: "memory"); }
constexpr int NCONV_TILES = 2816 + 1408 + 896 + 256;
struct ConvDesc { const float* src; u16* dst; int K, N, ndt, kt, mode; };
DEV ConvDesc conv_desc(PC p, int l, int t) {
  ConvDesc d;
  if (t < 2816) {
    int f = t / 1408, r = t % 1408;
    d.src = p->in[I_WGU] + (size_t)(l * 2 + f) * 1024 * 5632; d.K = 1024; d.N = 5632; d.dst = (u16*)(p->ws + OFF_WGU) + (size_t)f * 5632 * 1024; d.ndt = r / 16; d.kt = r % 16; d.mode = 1;
  } else if (t < 2816 + 1408) {
    t -= 2816;
    int f = t / 704, r = t % 704;
    d.src = p->in[I_WDOWN] + (size_t)(l * 2 + f) * 2816 * 1024; d.K = 2816; d.N = 1024; d.dst = (u16*)(p->ws + OFF_WDN) + (size_t)f * 1024 * 2816; d.ndt = r / 44; d.kt = r % 44; d.mode = 0;
  } else if (t < 2816 + 1408 + 896) {
    t -= 2816 + 1408;
    d.src = p->in[I_WIN] + (size_t)l * 1024 * 3472; d.K = 1024; d.N = 3472; d.dst = (u16*)(p->ws + OFF_WIN); d.ndt = t / 16; d.kt = t % 16; d.mode = 2;
  } else {
    t -= 2816 + 1408 + 896;
    d.src = p->in[I_WOUT] + (size_t)l * 1024 * 1024; d.K = 1024; d.N = 1024; d.dst = (u16*)(p->ws + OFF_WOUT); d.ndt = t / 16; d.kt = t % 16; d.mode = 0;
  }
  return d;
}
DEV void conv_load(const ConvDesc& d, float* v) {
  const int tid = TID();
  const int nn = tid & 63, nd = d.ndt * 64 + nn;
  int col;
  if (d.mode == 1) { int g = nd >> 5, r = nd & 31; col = (r < 16) ? g * 16 + r : DFF + g * 16 + (r - 16); }
  else if (d.mode == 2) col = (nd < 3472) ? nd : 0;
  else col = nd;
  const float* sp = d.src + (size_t)(d.kt * 64 + (tid >> 6)) * d.N + col;
#pragma unroll
  for (int i = 0; i < 8; ++i) v[i] = sp[(size_t)(i * 8) * d.N];
}
DEV void conv_store(const ConvDesc& d, const float* v, unsigned char* smem) {
  float* tile = (float*)smem;
  const int tid = TID();
  const int nn0 = tid & 63;
  const bool pad = (d.mode == 2) && (d.ndt * 64 + nn0 >= 3472);
#pragma unroll
  for (int i = 0; i < 8; ++i) tile[((tid >> 6) + i * 8) * 65 + nn0] = pad ? 0.f : v[i];
  lds_barrier();
  {
    int nn = tid >> 3, kc = tid & 7;
    uint4 o;
    o.x = pack2(tile[(kc * 8 + 0) * 65 + nn], tile[(kc * 8 + 1) * 65 + nn]);
    o.y = pack2(tile[(kc * 8 + 2) * 65 + nn], tile[(kc * 8 + 3) * 65 + nn]);
    o.z = pack2(tile[(kc * 8 + 4) * 65 + nn], tile[(kc * 8 + 5) * 65 + nn]);
    o.w = pack2(tile[(kc * 8 + 6) * 65 + nn], tile[(kc * 8 + 7) * 65 + nn]);
    *(uint4*)(d.dst + (size_t)(d.ndt * 64 + nn) * d.K + d.kt * 64 + kc * 8) = o;
  }
  lds_barrier();
}
__device__ __attribute__((always_inline)) void convert_all(PC p, int l, unsigned char* smem) {
  const int nb = NBLK();
  int t = BID();
  if (t >= NCONV_TILES) return;
  __syncthreads();
  float cur[8], nxt[8];
  conv_load(conv_desc(p, l, t), cur);
#pragma unroll 1
  for (; t < NCONV_TILES; t += nb) {
    const int tn = (t + nb < NCONV_TILES) ? t + nb : t;
    conv_load(conv_desc(p, l, tn), nxt);
    conv_store(conv_desc(p, l, t), cur, smem);
#pragma unroll
    for (int i = 0; i < 8; ++i) cur[i] = nxt[i];
  }
  __syncthreads();
}

__device__ __attribute__((always_inline)) void adaln_pass(PC p, int l, int sub, const float* xlat, const float* xctx, int ntok) {
  const int lane = TID() & 63, wave = TID() >> 6;
  const float* nw = p->in[I_NORMW] + (l * 3 + sub) * 1024;
  const float* mod = (const float*)(p->ws + OFF_MOD) + (size_t)l * 9 * 9216;
  u16* H = (u16*)(p->ws + OFF_H);
  for (int tok = BID() * 8 + wave; tok < ntok; tok += NBLK() * 8) {
    const float* src = tok < TL ? xlat + (size_t)tok * 1024 : xctx + (size_t)(tok - TL) * 1024;
    const int r = tok < TL ? (tok >> 11) : 8;
    const float* sh = mod + (size_t)r * 9216 + (3 * sub) * 1024;
    const float* sc = sh + 1024;
    float4 v[4];
    float ss = 0.f;
#pragma unroll
    for (int i = 0; i < 4; ++i) {
      v[i] = *(const float4*)(src + i * 256 + lane * 4);
      ss += v[i].x * v[i].x + v[i].y * v[i].y + v[i].z * v[i].z + v[i].w * v[i].w;
    }
    ss = wave_sum(ss);
    const float rinv = rsqrtf(ss * (1.f / 1024.f) + 1e-6f);
#pragma unroll
    for (int i = 0; i < 4; ++i) {
      const int c = i * 256 + lane * 4;
      float4 w4 = *(const float4*)(nw + c), s4 = *(const float4*)(sc + c), h4 = *(const float4*)(sh + c);
      float a = v[i].x * rinv * w4.x * (1.f + s4.x) + h4.x;
      float b = v[i].y * rinv * w4.y * (1.f + s4.y) + h4.y;
      float c2 = v[i].z * rinv * w4.z * (1.f + s4.z) + h4.z;
      float d = v[i].w * rinv * w4.w * (1.f + s4.w) + h4.w;
      uint2 o; o.x = pack2(a, b); o.y = pack2(c2, d);
      *(uint2*)(H + (size_t)tok * 1024 + c) = o;
    }
  }
}

struct Epi {
  u16* outb; const float* xs_lat; const float* xs_ctx; float* xd_lat; float* xd_ctx; const float* gate; float coef;
};
template <int MODE, int BM = 256>
__device__ __attribute__((always_inline)) void gemm_phase(const u16* __restrict__ A, int lda, const u16* __restrict__ Bt, int K, int M, int N, Epi e, unsigned char* smem, int vbid, int row0 = 0) {
  constexpr int BUF = (256 + 128) * 72;
  constexpr int MI = BM / 64;
  constexpr int WM = BM / 4;
  u16* L = (u16*)smem;
  const int tid = TID(), lane = tid & 63, wave = tid >> 6, wm = wave >> 1, wn = wave & 1;
  const int nMt = M / BM, nNt = N / 128, ntiles = nMt * nNt, nk = K / 64;
  const int lrow = tid >> 3, lch = tid & 7;
  const int fr = lane & 15, fq = lane >> 4;
  const int nb_ = NBLK();
  const bool swz = (vbid >= 0) && (nb_ == 256) && (nMt % 8 == 0) && (nNt % 4 == 0);
  int bid_ = swz ? vbid : BID();
  asm volatile("" : "+s"(bid_));
  const int nPM = nMt >> 3, npatch = nPM * (nNt >> 2);
  for (int it = 0;; ++it) {
    int mt, nt;
    if (swz) {
      const int pi = it * 8 + (bid_ & 7);
      if (pi >= npatch) break;
      mt = (pi % nPM) * 8 + ((bid_ >> 3) & 7);
      nt = (pi / nPM) * 4 + (bid_ >> 6);
    } else {
      const int tile = bid_ + it * nb_;
      if (tile >= ntiles) break;
      mt = tile % nMt; nt = tile / nMt;
    }
    const int m0 = row0 + mt * BM, n0 = nt * 128;
    f32x4 acc[MI][4];
#pragma unroll
    for (int i = 0; i < MI; ++i)
#pragma unroll
      for (int j = 0; j < 4; ++j) acc[i][j] = (f32x4){0.f, 0.f, 0.f, 0.f};
    const u16* Ap = A + (size_t)(m0 + lrow) * lda + lch * 8;
    const u16* Bp = Bt + (size_t)(n0 + lrow) * K + lch * 8;
    u32x4 ra0[MI], rb0[2], ra1[MI], rb1[2];
#define G_LOAD(RA, RB, KT) do { const int ko_ = (KT) * 64; \
      _Pragma("unroll") for (int i = 0; i < MI; ++i) RA[i] = *(const u32x4*)(Ap + (size_t)(i * 64) * lda + ko_); \
      _Pragma("unroll") for (int i = 0; i < 2; ++i) RB[i] = *(const u32x4*)(Bp + (size_t)(i * 64) * K + ko_); } while (0)
#define L_STORE(RA, RB, BUFI) do { u16* W_ = L + (BUFI) * BUF; \
      _Pragma("unroll") for (int i = 0; i < MI; ++i) *(u32x4*)(W_ + (lrow + i * 64) * 72 + lch * 8) = RA[i]; \
      _Pragma("unroll") for (int i = 0; i < 2; ++i) *(u32x4*)(W_ + 256 * 72 + (lrow + i * 64) * 72 + lch * 8) = RB[i]; } while (0)
#define FRAGS(AF, BF, BUFI, KS) do { const u16* As = L + (BUFI) * BUF; const u16* Bs = As + 256 * 72; \
      _Pragma("unroll") for (int mi = 0; mi < MI; ++mi) AF[mi] = *(const bf16x8*)(As + (wm * WM + mi * 16 + fr) * 72 + (KS) * 32 + fq * 8); \
      _Pragma("unroll") for (int ni = 0; ni < 4; ++ni) BF[ni] = *(const bf16x8*)(Bs + (wn * 64 + ni * 16 + fr) * 72 + (KS) * 32 + fq * 8); } while (0)
#define MMA16(AF, BF) do { \
      _Pragma("unroll") for (int mi = 0; mi < MI; ++mi) \
        _Pragma("unroll") for (int ni = 0; ni < 4; ++ni) acc[mi][ni] = __builtin_amdgcn_mfma_f32_16x16x32_bf16(BF[ni], AF[mi], acc[mi][ni], 0, 0, 0); } while (0)
#define KSTEP(BUFI, RA, RB, NBUFI) do { \
      bf16x8 af0[MI], bf0[4], af1[MI], bf1[4]; \
      FRAGS(af0, bf0, BUFI, 0); \
      __builtin_amdgcn_sched_barrier(0); \
      FRAGS(af1, bf1, BUFI, 1); \
      MMA16(af0, bf0); \
      if (MI >= 3) { _Pragma("unroll") for (int q_ = 0; q_ < MI * 2; ++q_) { __builtin_amdgcn_sched_group_barrier(0x008, 2, 0); __builtin_amdgcn_sched_group_barrier(0x100, 1, 0); } } \
      if (MI == 3) __builtin_amdgcn_sched_group_barrier(0x100, 1, 0); \
      __builtin_amdgcn_sched_barrier(0); \
      L_STORE(RA, RB, NBUFI); \
      MMA16(af1, bf1); \
      if (MI >= 3) { _Pragma("unroll") for (int q_ = 0; q_ < MI + 2; ++q_) { __builtin_amdgcn_sched_group_barrier(0x008, 2, 0); __builtin_amdgcn_sched_group_barrier(0x200, 1, 0); } \
        __builtin_amdgcn_sched_group_barrier(0x008, (MI >= 3) ? MI * 4 - 2 * (MI + 2) : 0, 0); } \
      __builtin_amdgcn_sched_barrier(0); \
      } while (0)
    G_LOAD(ra0, rb0, 0);
    G_LOAD(ra1, rb1, 1);
    __syncthreads();
    L_STORE(ra0, rb0, 0);
    __syncthreads();
    for (int kt = 0; kt < nk; kt += 2) {
      G_LOAD(ra0, rb0, min(kt + 2, nk - 1));
      KSTEP(0, ra1, rb1, 1);
      lds_barrier();
      G_LOAD(ra1, rb1, min(kt + 3, nk - 1));
      KSTEP(1, ra0, rb0, 0);
      lds_barrier();
    }
    asm volatile("s_waitcnt vmcnt(0)" ::: "memory");
#undef FRAGS
#undef MMA16
#undef KSTEP
#undef G_LOAD
#undef L_STORE
    if (MODE == 0) {
#pragma unroll
      for (int mi = 0; mi < MI; ++mi) {
        const int tok = m0 + wm * WM + mi * 16 + fr;
#pragma unroll
        for (int np = 0; np < 2; ++np) {
          const int ffc = ((n0 + wn * 64) >> 1) + np * 16 + fq * 4;
          const f32x4 g = acc[mi][np * 2], u = acc[mi][np * 2 + 1];
          uint2 o;
          o.x = pack2(siluf_(g[0]) * u[0], siluf_(g[1]) * u[1]);
          o.y = pack2(siluf_(g[2]) * u[2], siluf_(g[3]) * u[3]);
          *(uint2*)(e.outb + (size_t)tok * DFF + ffc) = o;
        }
      }
    } else if (MODE == 1) {
#pragma unroll
      for (int mi = 0; mi < MI; ++mi) {
        const int tok = m0 + wm * WM + mi * 16 + fr;
        const bool isctx = tok >= TL;
        const int r = isctx ? 8 : (tok >> 11);
        const float* xs = isctx ? e.xs_ctx + (size_t)(tok - TL) * 1024 : e.xs_lat + (size_t)tok * 1024;
        float* xd = isctx ? e.xd_ctx + (size_t)(tok - TL) * 1024 : e.xd_lat + (size_t)tok * 1024;
        const float* g = e.gate + (size_t)r * 9216;
#pragma unroll
        for (int ni = 0; ni < 4; ++ni) {
          const int col = n0 + wn * 64 + ni * 16 + fq * 4;
          const float4 gv = *(const float4*)(g + col);
          const float4 xv = *(const float4*)(xs + col);
          float4 o;
          o.x = xv.x + gv.x * e.coef * acc[mi][ni][0];
          o.y = xv.y + gv.y * e.coef * acc[mi][ni][1];
          o.z = xv.z + gv.z * e.coef * acc[mi][ni][2];
          o.w = xv.w + gv.w * e.coef * acc[mi][ni][3];
          *(float4*)(xd + col) = o;
        }
        __builtin_amdgcn_sched_barrier(0);
      }
    } else {
#pragma unroll
      for (int mi = 0; mi < MI; ++mi) {
        const int tok = m0 + wm * WM + mi * 16 + fr;
#pragma unroll
        for (int ni = 0; ni < 4; ++ni) {
          const int col = n0 + wn * 64 + ni * 16 + fq * 4;
          uint2 o;
          o.x = pack2(acc[mi][ni][0], acc[mi][ni][1]);
          o.y = pack2(acc[mi][ni][2], acc[mi][ni][3]);
          *(uint2*)(e.outb + (size_t)tok * PS + col) = o;
        }
      }
    }
  }
}

template <int MODE>
__device__ __attribute__((always_inline)) void gemm_phase_big(const u16* __restrict__ A, int lda, const u16* __restrict__ Bt, int K, int M, int N, Epi e, unsigned char* smem) {
  constexpr int BUF = 512 * 72;
  u16* L = (u16*)smem;
  const int tid = TID(), lane = tid & 63, wave = tid >> 6, wm = wave >> 1, wn = wave & 1;
  const int nMt = M / 256, nNt = N / 256, ntiles = nMt * nNt, nk = K / 64;
  const int lrow = tid >> 3, lch = tid & 7;
  const int fr = lane & 15, fq = lane >> 4;
  const int nb_ = NBLK();
  for (int tile = BID(); tile < ntiles; tile += nb_) {
    const int mt = tile % nMt, nt = tile / nMt;
    const int m0 = mt * 256, n0 = nt * 256;
    f32x4 acc[4][8];
#pragma unroll
    for (int i = 0; i < 4; ++i)
#pragma unroll
      for (int j = 0; j < 8; ++j) acc[i][j] = (f32x4){0.f, 0.f, 0.f, 0.f};
    const u16* Ap = A + (size_t)(m0 + lrow) * lda + lch * 8;
    const u16* Bp = Bt + (size_t)(n0 + lrow) * K + lch * 8;
    u32x4 ra[4], rb[4];
#define G_LOADB(KT) do { const int ko_ = (KT) * 64; \
      _Pragma("unroll") for (int i = 0; i < 4; ++i) ra[i] = *(const u32x4*)(Ap + (size_t)(i * 64) * lda + ko_); \
      _Pragma("unroll") for (int i = 0; i < 4; ++i) rb[i] = *(const u32x4*)(Bp + (size_t)(i * 64) * K + ko_); } while (0)
#define L_STOREB(BUFI) do { u16* W_ = L + (BUFI) * BUF; \
      _Pragma("unroll") for (int i = 0; i < 4; ++i) *(u32x4*)(W_ + (lrow + i * 64) * 72 + lch * 8) = ra[i]; \
      _Pragma("unroll") for (int i = 0; i < 4; ++i) *(u32x4*)(W_ + 256 * 72 + (lrow + i * 64) * 72 + lch * 8) = rb[i]; } while (0)
    G_LOADB(0);
    __syncthreads();
    L_STOREB(0);
    G_LOADB(min(1, nk - 1));
    __syncthreads();
#define FRAGSB(KS) do { \
        _Pragma("unroll") for (int mi = 0; mi < 4; ++mi) af[mi] = *(const bf16x8*)(As + (wm * 64 + mi * 16 + fr) * 72 + (KS) * 32 + fq * 8); \
        _Pragma("unroll") for (int ni = 0; ni < 8; ++ni) bfr[ni] = *(const bf16x8*)(Bs + (wn * 128 + ni * 16 + fr) * 72 + (KS) * 32 + fq * 8); } while (0)
#define MMAB() do { \
        _Pragma("unroll") for (int ni = 0; ni < 8; ++ni) \
          _Pragma("unroll") for (int mi = 0; mi < 4; ++mi) acc[mi][ni] = __builtin_amdgcn_mfma_f32_16x16x32_bf16(bfr[ni], af[mi], acc[mi][ni], 0, 0, 0); } while (0)
    for (int kt = 0; kt < nk; ++kt) {
      const u16* As = L + (kt & 1) * BUF;
      const u16* Bs = As + 256 * 72;
      bf16x8 af[4], bfr[8];
      FRAGSB(0);
      __builtin_amdgcn_sched_barrier(0);
      MMAB();
      L_STOREB((kt + 1) & 1);
#pragma unroll
      for (int q_ = 0; q_ < 8; ++q_) { __builtin_amdgcn_sched_group_barrier(0x008, 4, 0); __builtin_amdgcn_sched_group_barrier(0x200, 1, 0); }
      __builtin_amdgcn_sched_barrier(0);
      G_LOADB(min(kt + 2, nk - 1));
      FRAGSB(1);
      __builtin_amdgcn_sched_barrier(0);
      MMAB();
      __builtin_amdgcn_sched_barrier(0);
      lds_barrier();
    }
#undef FRAGSB
#undef MMAB
    asm volatile("s_waitcnt vmcnt(0)" ::: "memory");
#undef G_LOADB
#undef L_STOREB
    if (MODE == 0) {
#pragma unroll
      for (int mi = 0; mi < 4; ++mi) {
        const int tok = m0 + wm * 64 + mi * 16 + fr;
#pragma unroll
        for (int np = 0; np < 4; ++np) {
          const int ffc = ((n0 + wn * 128) >> 1) + np * 16 + fq * 4;
          const f32x4 g = acc[mi][np * 2], u = acc[mi][np * 2 + 1];
          uint2 o;
          o.x = pack2(siluf_(g[0]) * u[0], siluf_(g[1]) * u[1]);
          o.y = pack2(siluf_(g[2]) * u[2], siluf_(g[3]) * u[3]);
          *(uint2*)(e.outb + (size_t)tok * DFF + ffc) = o;
        }
      }
    } else if (MODE == 1) {
#pragma unroll
      for (int mi = 0; mi < 4; ++mi) {
        const int tok = m0 + wm * 64 + mi * 16 + fr;
        const bool isctx = tok >= TL;
        const int r = isctx ? 8 : (tok >> 11);
        const float* xs = isctx ? e.xs_ctx + (size_t)(tok - TL) * 1024 : e.xs_lat + (size_t)tok * 1024;
        float* xd = isctx ? e.xd_ctx + (size_t)(tok - TL) * 1024 : e.xd_lat + (size_t)tok * 1024;
        const float* g = e.gate + (size_t)r * 9216;
#pragma unroll
        for (int ni = 0; ni < 8; ++ni) {
          const int col = n0 + wn * 128 + ni * 16 + fq * 4;
          const float4 gv = *(const float4*)(g + col);
          const float4 xv = *(const float4*)(xs + col);
          float4 o;
          o.x = xv.x + gv.x * e.coef * acc[mi][ni][0];
          o.y = xv.y + gv.y * e.coef * acc[mi][ni][1];
          o.z = xv.z + gv.z * e.coef * acc[mi][ni][2];
          o.w = xv.w + gv.w * e.coef * acc[mi][ni][3];
          *(float4*)(xd + col) = o;
        }
        __builtin_amdgcn_sched_barrier(0);
      }
    } else {
#pragma unroll
      for (int mi = 0; mi < 4; ++mi) {
        const int tok = m0 + wm * 64 + mi * 16 + fr;
#pragma unroll
        for (int ni = 0; ni < 8; ++ni) {
          const int col = n0 + wn * 128 + ni * 16 + fq * 4;
          uint2 o;
          o.x = pack2(acc[mi][ni][0], acc[mi][ni][1]);
          o.y = pack2(acc[mi][ni][2], acc[mi][ni][3]);
          *(uint2*)(e.outb + (size_t)tok * PS + col) = o;
        }
      }
    }
  }
}

__device__ __attribute__((always_inline)) void prep_task(PC p, int l, int task, unsigned char* smem) {
  float* raw = (float*)smem;
  float* sv = raw + 34 * 64;
  const int tid = TID();
  const u16* slab = (const u16*)(p->ws + OFF_SLAB);
  const int tok0 = task * 32;
  int base, n;
  if (tok0 < TL) { base = (tok0 >> 11) << 11; n = 2048; } else { base = TL + (((tok0 - TL) >> 8) << 8); n = 256; }
  const int pos0 = tok0 - base;
  for (int i = tid; i < 34 * 64; i += 512) {
    int rr = i >> 6, j = i & 63, pos = pos0 - 1 + rr;
    raw[i] = (pos >= 0 && pos < n) ? bf2f(slab[(size_t)(base + pos) * PS + RW_OFF + 768 + j]) : 0.f;
  }
  __syncthreads();
  const float* mu = p->in[I_RWMU] + l * 2 * 896;
  for (int i = tid; i < 32 * 64; i += 512) {
    int t = i >> 6, j = i & 63;
    float u = raw[(t + 1) * 64 + j], pv = raw[t * 64 + j], nx = raw[(t + 2) * 64 + j];
    float s = u + mu[768 + j] * (pv - u) + mu[896 + 768 + j] * (nx - u);
    if (j < 32) s = tanhf(s);
    sv[i] = s;
  }
  __syncthreads();
  {
    const int c = tid & 255, d = tid >> 8;
    const float* wup = p->in[I_RWWUP] + (size_t)(l * 2 + d) * 32 * 256 + c;
    const float* aup = p->in[I_RWAUP] + (size_t)(l * 2 + d) * 32 * 256 + c;
    float wu[32], au[32];
#pragma unroll
    for (int j = 0; j < 32; ++j) { wu[j] = wup[j * 256]; au[j] = aup[j * 256]; }
    u16* rwl = (u16*)(p->ws + OFF_RWL);
    const float rw_w0 = p->in[I_RWW0][(l * 2 + d) * 256 + c], rw_a0 = p->in[I_RWA0][(l * 2 + d) * 256 + c];
#pragma unroll 2
    for (int t = 0; t < 32; ++t) {
      float aw = 0.f, aa = 0.f;
#pragma unroll
      for (int q = 0; q < 8; ++q) {
        float4 x = *(const float4*)(sv + t * 64 + q * 4);
        float4 y = *(const float4*)(sv + t * 64 + 32 + q * 4);
        aw = fmaf(x.x, wu[q * 4], aw); aw = fmaf(x.y, wu[q * 4 + 1], aw); aw = fmaf(x.z, wu[q * 4 + 2], aw); aw = fmaf(x.w, wu[q * 4 + 3], aw);
        aa = fmaf(y.x, au[q * 4], aa); aa = fmaf(y.y, au[q * 4 + 1], aa); aa = fmaf(y.z, au[q * 4 + 2], aa); aa = fmaf(y.w, au[q * 4 + 3], aa);
      }
      const float zz = -(rw_w0 + aw);
      const float sp = zz > 20.f ? zz : __logf(1.f + __expf(zz));
      rwl[(size_t)(tok0 + t) * 1024 + d * 512 + c] = f2bf(__expf(-sp - 0.5f));
      rwl[(size_t)(tok0 + t) * 1024 + d * 512 + 256 + c] = f2bf(sigmoidf_(rw_a0 + aa));
    }
  }
  {
    const float* hc = p->in[I_HYCONV] + l * 3 * 768;
    u16* hxt = (u16*)(p->ws + OFF_HXT);
#pragma unroll 1
    for (int cidx = tid; cidx < 768; cidx += 512) {
      const float w0 = hc[cidx], w1 = hc[768 + cidx], w2 = hc[1536 + cidx];
      float pv = pos0 > 0 ? bf2f(slab[(size_t)(tok0 - 1) * PS + cidx]) : 0.f;
      float cur = bf2f(slab[(size_t)tok0 * PS + cidx]);
      unsigned pk[16];
#pragma unroll
      for (int t = 0; t < 32; t += 2) {
        float nx0 = (pos0 + t + 1 < n) ? bf2f(slab[(size_t)(tok0 + t + 1) * PS + cidx]) : 0.f;
        float v0 = w0 * pv + w1 * cur + w2 * nx0;
        float nx1 = (pos0 + t + 2 < n) ? bf2f(slab[(size_t)(tok0 + t + 2) * PS + cidx]) : 0.f;
        float v1 = w0 * cur + w1 * nx0 + w2 * nx1;
        pk[t >> 1] = pack2(v0, v1);
        pv = nx0; cur = nx1;
      }
      uint4* dst = (uint4*)(hxt + (size_t)cidx * TT + tok0);
      dst[0] = make_uint4(pk[0], pk[1], pk[2], pk[3]);
      dst[1] = make_uint4(pk[4], pk[5], pk[6], pk[7]);
      dst[2] = make_uint4(pk[8], pk[9], pk[10], pk[11]);
      dst[3] = make_uint4(pk[12], pk[13], pk[14], pk[15]);
    }
  }
  __syncthreads();
}

typedef float f32x2 __attribute__((ext_vector_type(2)));
DEV float quad_sum(float x) {
  x += __builtin_bit_cast(float, __builtin_amdgcn_update_dpp(0, __builtin_bit_cast(int, x), 0xB1, 0xf, 0xf, true));
  x += __builtin_bit_cast(float, __builtin_amdgcn_update_dpp(0, __builtin_bit_cast(int, x), 0x4E, 0xf, 0xf, true));
  return x;
}
constexpr int DN_STRIDE = 200, RW_STRIDE = 392, CHUNK = 16, NCHUNK = 2304 / CHUNK;
DEV void ld16(f32x2* o, const float* d) {
#pragma unroll
  for (int i = 0; i < 4; ++i) {
    float4 a = *(const float4*)(d + i * 4);
    o[2 * i] = (f32x2){a.x, a.y};
    o[2 * i + 1] = (f32x2){a.z, a.w};
  }
}
struct DnOps { f32x2 q[8], k[8]; float vv, a, be, kq; };
DEV void dn_load(DnOps& o, const float* d, int kp, int col) {
  ld16(o.q, d + kp * 16); ld16(o.k, d + 64 + kp * 16);
  o.vv = d[128 + col]; o.a = d[192]; o.be = d[193]; o.kq = d[194];
}
DEV float dn_step(f32x2* S, const DnOps& c) {
  f32x2 a1 = (f32x2){0.f, 0.f}, a2 = (f32x2){0.f, 0.f};
#pragma unroll
  for (int i = 0; i < 8; ++i) { a1 = __builtin_elementwise_fma(S[i], c.k[i], a1); a2 = __builtin_elementwise_fma(S[i], c.q[i], a2); }
  const float dk = quad_sum(a1.x + a1.y), dq = quad_sum(a2.x + a2.y);
  const float cc = c.be * (c.vv - c.a * dk);
  const f32x2 a2v = (f32x2){c.a, c.a}, c2v = (f32x2){cc, cc};
#pragma unroll
  for (int i = 0; i < 8; ++i) { S[i] = S[i] * a2v; S[i] = __builtin_elementwise_fma(c.k[i], c2v, S[i]); }
  return c.a * dq + cc * c.kq;
}
struct RwOps { f32x2 wr[8], w[8], kd[8], av[8], bv[8]; float vv, s1, s2; };
DEV void rw_load(RwOps& o, const float* d, int kp, int col) {
  ld16(o.wr, d + kp * 16); ld16(o.w, d + 64 + kp * 16); ld16(o.kd, d + 128 + kp * 16); ld16(o.av, d + 192 + kp * 16); ld16(o.bv, d + 256 + kp * 16);
  o.vv = d[320 + col]; o.s1 = d[384]; o.s2 = d[385];
}
DEV float rw_step(f32x2* S, const RwOps& c) {
  f32x2 a1 = (f32x2){0.f, 0.f}, a2 = (f32x2){0.f, 0.f};
#pragma unroll
  for (int i = 0; i < 8; ++i) { a1 = __builtin_elementwise_fma(S[i], c.av[i], a1); a2 = __builtin_elementwise_fma(S[i], c.wr[i], a2); }
  const float sa = quad_sum(a1.x + a1.y), yp = quad_sum(a2.x + a2.y);
  const f32x2 sa2 = (f32x2){sa, sa}, v2 = (f32x2){c.vv, c.vv};
#pragma unroll
  for (int i = 0; i < 8; ++i) { S[i] = S[i] * c.w[i]; S[i] = __builtin_elementwise_fma(sa2, c.bv[i], S[i]); S[i] = __builtin_elementwise_fma(v2, c.kd[i], S[i]); }
  return yp + sa * c.s1 + c.vv * c.s2;
}

DEV float wave_allsum_dpp(float x) {
  x += __builtin_bit_cast(float, __builtin_amdgcn_update_dpp(0, __builtin_bit_cast(int, x), 0xB1, 0xf, 0xf, true));
  x += __builtin_bit_cast(float, __builtin_amdgcn_update_dpp(0, __builtin_bit_cast(int, x), 0x4E, 0xf, 0xf, true));
  x += __builtin_bit_cast(float, __builtin_amdgcn_update_dpp(0, __builtin_bit_cast(int, x), 0x124, 0xf, 0xf, true));
  x += __builtin_bit_cast(float, __builtin_amdgcn_update_dpp(0, __builtin_bit_cast(int, x), 0x128, 0xf, 0xf, true));
  return allred_rows(x);
}
DEV float softplus_fast(float x) { return x > 20.f ? x : __logf(1.f + __expf(x)); }

DEV float oct_sum(float x) {
  x += __builtin_bit_cast(float, __builtin_amdgcn_update_dpp(0, __builtin_bit_cast(int, x), 0xB1, 0xf, 0xf, true));
  x += __builtin_bit_cast(float, __builtin_amdgcn_update_dpp(0, __builtin_bit_cast(int, x), 0x4E, 0xf, 0xf, true));
  x += __builtin_bit_cast(float, __builtin_amdgcn_update_dpp(0, __builtin_bit_cast(int, x), 0x141, 0xf, 0xf, true));
  return x;
}
DEV void ld8(f32x2* o, const float* d) {
#pragma unroll
  for (int i = 0; i < 2; ++i) {
    float4 a = *(const float4*)(d + i * 4);
    o[2 * i] = (f32x2){a.x, a.y};
    o[2 * i + 1] = (f32x2){a.z, a.w};
  }
}
struct RwOps8 { f32x2 wr[4], w[4], kd[4], av[4], bv[4]; float vv, s1, s2; };
DEV void rw_load8(RwOps8& o, const float* d, int kp, int row) {
  ld8(o.wr, d + kp * 8); ld8(o.w, d + 64 + kp * 8); ld8(o.kd, d + 128 + kp * 8); ld8(o.av, d + 192 + kp * 8); ld8(o.bv, d + 256 + kp * 8);
  o.vv = d[320 + row]; o.s1 = d[384]; o.s2 = d[385];
}
DEV float rw_step8(f32x2* S, const RwOps8& c) {
  f32x2 a1 = (f32x2){0.f, 0.f}, a2 = (f32x2){0.f, 0.f};
#pragma unroll
  for (int i = 0; i < 4; ++i) { a1 = __builtin_elementwise_fma(S[i], c.av[i], a1); a2 = __builtin_elementwise_fma(S[i], c.wr[i], a2); }
  const float sa = oct_sum(a1.x + a1.y), yp = oct_sum(a2.x + a2.y);
  const f32x2 sa2 = (f32x2){sa, sa}, v2 = (f32x2){c.vv, c.vv};
#pragma unroll
  for (int i = 0; i < 4; ++i) { S[i] = S[i] * c.w[i]; S[i] = __builtin_elementwise_fma(sa2, c.bv[i], S[i]); S[i] = __builtin_elementwise_fma(v2, c.kd[i], S[i]); }
  return yp + sa * c.s1 + c.vv * c.s2;
}

struct DnRaw { uint4 c[3], pv[3], nx[3]; unsigned xa, xb; float fp, fn; };
DEV void dn_prep_load(DnRaw& R, PC p, int b, int hd, int dir, int ci) {
  const int ptid = TID() - 256;
  const u16* slab = (const u16*)(p->ws + OFF_SLAB);
  const int st = (ptid >> 3) & 15, g = ptid & 7;
  int pos, n;
  const int tok = step_tok(b, dir, ci * CHUNK + st, pos, n);
  const int tp = pos > 0 ? tok - 1 : tok, tn = pos < n - 1 ? tok + 1 : tok;
  R.fp = pos > 0 ? 1.f : 0.f; R.fn = pos < n - 1 ? 1.f : 0.f;
#pragma unroll
  for (int v3 = 0; v3 < 3; ++v3) {
    const int col = DN_OFF + v3 * 256 + hd * 64 + g * 8;
    R.c[v3] = *(const uint4*)(slab + (size_t)tok * PS + col);
    R.pv[v3] = *(const uint4*)(slab + (size_t)tp * PS + col);
    R.nx[v3] = *(const uint4*)(slab + (size_t)tn * PS + col);
  }
  int pos2, n2;
  const int tok2 = step_tok(b, dir, ci * CHUNK + (ptid & 15), pos2, n2);
  R.xb = slab[(size_t)tok2 * PS + DN_OFF + 1024 + dir * 8 + hd];
  R.xa = slab[(size_t)tok2 * PS + DN_OFF + 1024 + dir * 8 + 4 + hd];
}
DEV void dn_prep_compute(const DnRaw& R, float* dst, const float* cw, float Aexp, float dtb) {
  const int ptid = TID() - 256;
  if (ptid < 128) {
    const int st = ptid >> 3, g = ptid & 7;
    float res[3][8];
    float ssq = 0.f, ssk = 0.f, qk = 0.f;
#pragma unroll
    for (int v3 = 0; v3 < 3; ++v3) {
      float cur[8], pv[8], nx[8];
      unpack8(R.c[v3], cur); unpack8(R.pv[v3], pv); unpack8(R.nx[v3], nx);
      const float* c0 = cw + v3 * 64 + g * 8;
#pragma unroll
      for (int e = 0; e < 8; ++e) res[v3][e] = siluf_(c0[e] * R.fp * pv[e] + c0[192 + e] * cur[e] + c0[384 + e] * R.fn * nx[e]);
    }
#pragma unroll
    for (int e = 0; e < 8; ++e) { ssq += res[0][e] * res[0][e]; ssk += res[1][e] * res[1][e]; qk += res[0][e] * res[1][e]; }
    ssq += __shfl_xor(ssq, 1); ssq += __shfl_xor(ssq, 2); ssq += __shfl_xor(ssq, 4);
    ssk += __shfl_xor(ssk, 1); ssk += __shfl_xor(ssk, 2); ssk += __shfl_xor(ssk, 4);
    qk += __shfl_xor(qk, 1); qk += __shfl_xor(qk, 2); qk += __shfl_xor(qk, 4);
    const float scq = rsqrtf(ssq + 1e-6f) * 0.125f, sck = rsqrtf(ssk + 1e-6f);
    float* d = dst + st * DN_STRIDE + g * 8;
    *(float4*)d = make_float4(res[0][0] * scq, res[0][1] * scq, res[0][2] * scq, res[0][3] * scq);
    *(float4*)(d + 4) = make_float4(res[0][4] * scq, res[0][5] * scq, res[0][6] * scq, res[0][7] * scq);
    *(float4*)(d + 64) = make_float4(res[1][0] * sck, res[1][1] * sck, res[1][2] * sck, res[1][3] * sck);
    *(float4*)(d + 68) = make_float4(res[1][4] * sck, res[1][5] * sck, res[1][6] * sck, res[1][7] * sck);
    *(float4*)(d + 128) = make_float4(res[2][0], res[2][1], res[2][2], res[2][3]);
    *(float4*)(d + 132) = make_float4(res[2][4], res[2][5], res[2][6], res[2][7]);
    if (g == 0) dst[st * DN_STRIDE + 194] = qk * scq * sck;
  } else if (ptid < 128 + CHUNK) {
    const int st = ptid - 128;
    const float g = -Aexp * softplus_fast(bf2f((u16)R.xa) + dtb);
    dst[st * DN_STRIDE + 192] = __expf(g);
    dst[st * DN_STRIDE + 193] = sigmoidf_(bf2f((u16)R.xb));
  }
}

__device__ __attribute__((always_inline)) void dn_scan_unit(PC p, int l, int unit, unsigned char* smem, const int MODE = 7) {
  const int b = unit >> 3, hd = (unit >> 1) & 3, dir = unit & 1;
  float* buf = (float*)smem;
  float* cw = buf + 2 * CHUNK * DN_STRIDE + 64;
  const int tid = TID(), wave = tid >> 6, lane = tid & 63;
  __syncthreads();
  for (int i = tid; i < 576; i += 512) {
    int tap = i / 192, rem = i % 192, v3 = rem >> 6, d = rem & 63;
    cw[i] = p->in[I_DNCONV][(l * 3 + tap) * 768 + v3 * 256 + hd * 64 + d];
  }
  const float Aexp = __expf(p->in[I_DNALOG][l * 8 + dir * 4 + hd]);
  const float dtb = p->in[I_DNDT][l * 8 + dir * 4 + hd];
  u16* dno = (u16*)(p->ws + OFF_DNO) + (size_t)dir * TT * 256;
  __syncthreads();
  f32x2 S[8];
#pragma unroll
  for (int j = 0; j < 8; ++j) S[j] = (f32x2){0.f, 0.f};
  const int kp = lane & 3, col = (wave & 3) * 16 + (lane >> 2);
  DnRaw R0, R1;
  if (wave >= 4) {
    dn_prep_load(R0, p, b, hd, dir, 0); dn_prep_compute(R0, buf, cw, Aexp, dtb);
    dn_prep_load(R0, p, b, hd, dir, 1); dn_prep_load(R1, p, b, hd, dir, 2);
  }
  __syncthreads();
#define DN_SCAN_CHUNK(CI) do { \
      const float* bb = buf + ((CI) & 1) * CHUNK * DN_STRIDE; \
      int pos, n; \
      const int tok0 = step_tok(b, dir, (CI) * CHUNK, pos, n); \
      const int tstep = dir ? -1 : 1; \
      u16* op = dno + (size_t)tok0 * 256 + hd * 64 + col; \
      DnOps A, B; \
      dn_load(A, bb, kp, col); \
      _Pragma("unroll 1") for (int st = 0; st < CHUNK; st += 2) { \
        dn_load(B, bb + (st + 1) * DN_STRIDE, kp, col); \
        const float o0 = dn_step(S, A); \
        if ((MODE & 1) && kp == 0) op[(ptrdiff_t)(st * tstep) * 256] = f2bf(o0); sink += o0; \
        dn_load(A, bb + (st + 2) * DN_STRIDE, kp, col); \
        const float o1 = dn_step(S, B); \
        if ((MODE & 1) && kp == 0) op[(ptrdiff_t)((st + 1) * tstep) * 256] = f2bf(o1); sink += o1; \
      } } while (0)
  float sink = 0.f;
  if (wave >= 4 && !(MODE & 2)) {
#pragma unroll 1
    for (int ci = 0; ci < NCHUNK; ci += 2) { lds_barrier(); lds_barrier(); }
  } else if (wave < 4 && !(MODE & 4)) {
#pragma unroll 1
    for (int ci = 0; ci < NCHUNK; ci += 2) { lds_barrier(); lds_barrier(); }
  } else if (wave >= 4) {
#pragma unroll 1
    for (int ci = 0; ci < NCHUNK; ci += 2) {
      dn_prep_compute(R0, buf + CHUNK * DN_STRIDE, cw, Aexp, dtb);
      dn_prep_load(R0, p, b, hd, dir, min(ci + 3, NCHUNK - 1));
      lds_barrier();
      if (ci + 2 < NCHUNK) dn_prep_compute(R1, buf, cw, Aexp, dtb);
      dn_prep_load(R1, p, b, hd, dir, min(ci + 4, NCHUNK - 1));
      lds_barrier();
    }
  } else {
#pragma unroll 1
    for (int ci = 0; ci < NCHUNK; ci += 2) {
      DN_SCAN_CHUNK(ci);
      lds_barrier();
      DN_SCAN_CHUNK(ci + 1);
      lds_barrier();
    }
    if (!(MODE & 1) && sink == 12345.678f) dno[col] = f2bf(sink);
  }
  asm volatile("s_waitcnt vmcnt(0)" ::: "memory");
  __syncthreads();
}

struct RwRaw { unsigned u[3][6]; unsigned wl[4], al[4]; unsigned vmask; };
DEV void rw_prep_load(RwRaw& R, PC p, int b, int hd, int dir, int ci, int pw) {
  const int lane = TID() & 63;
  const u16* slab = (const u16*)(p->ws + OFF_SLAB);
  const u16* rwl = (const u16*)(p->ws + OFF_RWL);
  const int ch = hd * 64 + lane;
  int pos0, n;
  const int tokc = step_tok(b, dir, ci * CHUNK, pos0, n);
  const int base = tokc - pos0;
  const int plo = dir ? pos0 - (pw * 4 + 3) : pos0 + pw * 4;
  unsigned vm = 0;
#pragma unroll
  for (int i = 0; i < 6; ++i) {
    const int pos = plo - 1 + i;
    const int posc = min(max(pos, 0), n - 1);
    vm |= (pos == posc ? 1u : 0u) << i;
#pragma unroll
    for (int sg = 0; sg < 3; ++sg) R.u[sg][i] = slab[(size_t)(base + posc) * PS + RW_OFF + sg * 256 + ch];
  }
  R.vmask = vm;
#pragma unroll
  for (int q = 0; q < 4; ++q) {
    const int pos = dir ? pos0 - (pw * 4 + q) : pos0 + pw * 4 + q;
    R.wl[q] = rwl[(size_t)(base + pos) * 1024 + dir * 512 + ch];
    R.al[q] = rwl[(size_t)(base + pos) * 1024 + dir * 512 + 256 + ch];
  }
}
struct RwConst { float m0[3], m1[3], kk_w, ka_w, w0, a0; };
DEV void rw_const_load(RwConst& C, PC p, int l, int hd, int dir) {
  const int lane = TID() & 63;
  const int ch = hd * 64 + lane;
  const float* mu = p->in[I_RWMU] + l * 2 * 896;
  C.kk_w = p->in[I_RWKK][l * 256 + ch]; C.ka_w = p->in[I_RWKA][l * 256 + ch];
  C.w0 = p->in[I_RWW0][(l * 2 + dir) * 256 + ch]; C.a0 = p->in[I_RWA0][(l * 2 + dir) * 256 + ch];
#pragma unroll
  for (int sg = 0; sg < 3; ++sg) { C.m0[sg] = mu[sg * 256 + ch]; C.m1[sg] = mu[896 + sg * 256 + ch]; }
}
DEV void rw_prep_compute(const RwRaw& R, const RwConst& C, int dir, float* dst, int pw) {
  const int lane = TID() & 63;
  const float kk_w = C.kk_w, ka_w = C.ka_w, w0 = C.w0, a0 = C.a0;
  float m0[3], m1[3];
#pragma unroll
  for (int sg = 0; sg < 3; ++sg) { m0[sg] = C.m0[sg]; m1[sg] = C.m1[sg]; }
  float uf[3][6];
#pragma unroll
  for (int sg = 0; sg < 3; ++sg)
#pragma unroll
    for (int i = 0; i < 6; ++i) uf[sg][i] = ((R.vmask >> i) & 1u) ? __uint_as_float(R.u[sg][i] << 16) : 0.f;
#pragma unroll
  for (int q = 0; q < 4; ++q) {
    const int st = pw * 4 + q;
    const int ic = dir ? 4 - q : 1 + q;
    float ts[3];
#pragma unroll
    for (int sg = 0; sg < 3; ++sg) {
      const float u = uf[sg][ic], pv = uf[sg][ic - 1], nx = uf[sg][ic + 1];
      ts[sg] = u + m0[sg] * (pv - u) + m1[sg] * (nx - u);
    }
    const float r = ts[0], k = ts[1], v = ts[2];
    const float kr = k * kk_w;
    const float w = __expf(-__uint_as_float(R.wl[q] << 16));
    const float a = __uint_as_float(R.al[q] << 16);
    const float kd = k * (1.f + (a - 1.f) * ka_w);
    const float ss = wave_allsum_dpp(kr * kr), t1 = wave_allsum_dpp(kr * a * r), t2 = wave_allsum_dpp(kd * r);
    const float rn = rsqrtf(ss + 1e-6f);
    const float kk = kr * rn;
    float* d = dst + st * RW_STRIDE;
    d[lane] = w * r; d[64 + lane] = w; d[128 + lane] = kd; d[192 + lane] = -kk; d[256 + lane] = kk * a; d[320 + lane] = v;
    if (lane == 0) { d[384] = t1 * rn; d[385] = t2; }
  }
}

__device__ __attribute__((always_inline)) void rw_scan_unit(PC p, int l, int hunit, unsigned char* smem, const int MODE = 7) {
  const int unit = hunit >> 1, half = hunit & 1;
  const int b = unit >> 3, hd = (unit >> 1) & 3, dir = unit & 1;
  float* buf = (float*)smem;
  const int tid = TID(), wave = tid >> 6, lane = tid & 63;
  u16* rwy = (u16*)(p->ws + OFF_RWY) + (size_t)dir * TT * 256;
  __syncthreads();
  f32x2 S[8];
#pragma unroll
  for (int j = 0; j < 8; ++j) S[j] = (f32x2){0.f, 0.f};
  const bool is_scan = wave < 4;
  const bool is_prep = wave >= 4;
  const int pw = wave & 3;
  const int kp = lane & 7, col = half * 32 + (wave & 3) * 8 + (lane >> 3);
  RwRaw R0, R1;
  RwConst C;
  rw_const_load(C, p, l, hd, dir);
  if (is_prep) {
    rw_prep_load(R0, p, b, hd, dir, 0, pw); rw_prep_compute(R0, C, dir, buf, pw);
    rw_prep_load(R0, p, b, hd, dir, 1, pw); rw_prep_load(R1, p, b, hd, dir, 2, pw);
  }
  __syncthreads();
#define RW_SCAN_CHUNK(CI) do { \
      const float* bb = buf + ((CI) & 1) * CHUNK * RW_STRIDE; \
      int pos, n; \
      const int tok0 = step_tok(b, dir, (CI) * CHUNK, pos, n); \
      const int tstep = dir ? -1 : 1; \
      u16* op = rwy + (size_t)tok0 * 256 + hd * 64 + col; \
      RwOps8 A, B; \
      rw_load8(A, bb, kp, col); \
      _Pragma("unroll 1") for (int st = 0; st < CHUNK; st += 2) { \
        rw_load8(B, bb + (st + 1) * RW_STRIDE, kp, col); \
        const float y0 = rw_step8(S, A); \
        if ((MODE & 1) && kp == 0) op[(ptrdiff_t)(st * tstep) * 256] = f2bf(y0); sink += y0; \
        rw_load8(A, bb + (st + 2) * RW_STRIDE, kp, col); \
        const float y1 = rw_step8(S, B); \
        if ((MODE & 1) && kp == 0) op[(ptrdiff_t)((st + 1) * tstep) * 256] = f2bf(y1); sink += y1; \
      } } while (0)
  float sink = 0.f;
  if ((is_prep && !(MODE & 2)) || (is_scan && !(MODE & 4))) {
#pragma unroll 1
    for (int ci = 0; ci < NCHUNK; ci += 2) { lds_barrier(); lds_barrier(); }
  } else if (is_prep) {
#pragma unroll 1
    for (int ci = 0; ci < NCHUNK; ci += 2) {
      rw_prep_compute(R0, C, dir, buf + CHUNK * RW_STRIDE, pw);
      rw_prep_load(R0, p, b, hd, dir, min(ci + 3, NCHUNK - 1), pw);
      lds_barrier();
      if (ci + 2 < NCHUNK) rw_prep_compute(R1, C, dir, buf, pw);
      rw_prep_load(R1, p, b, hd, dir, min(ci + 4, NCHUNK - 1), pw);
      lds_barrier();
    }
  } else if (is_scan) {
#pragma unroll 1
    for (int ci = 0; ci < NCHUNK; ci += 2) {
      RW_SCAN_CHUNK(ci);
      lds_barrier();
      RW_SCAN_CHUNK(ci + 1);
      lds_barrier();
    }
    if (!(MODE & 1) && sink == 12345.678f) rwy[col] = f2bf(sink);
  } else {
#pragma unroll 1
    for (int ci = 0; ci < NCHUNK; ci += 2) { lds_barrier(); lds_barrier(); }
  }
  asm volatile("s_waitcnt vmcnt(0)" ::: "memory");
  __syncthreads();
}

constexpr int USTR = 2248;
__device__ __attribute__((always_inline)) void hyena_task(PC p, int l, int order, int task, unsigned char* smem) {
  const int tid = TID(), wave = tid >> 6, lane = tid & 63;
  const int ty = task >> 8, ch = task & 255, n = ty ? 256 : 2048;
  const int oc = order * 256 + ch;
  u16* F = (u16*)smem;
  u16* Ts = F + 4096 * 8;
  u16* Us = Ts + 4096;
  const int seq0 = ty ? TL : 0;
  __syncthreads();
  {
    const u16* filt = (const u16*)(p->ws + OFF_FILT + (size_t)l * FILT_LAYER) + (ty ? (size_t)512 * 4096 : 0) + (size_t)oc * (2 * n);
    for (int i = tid * 8; i < 2 * n; i += 512 * 8) *(uint4*)(Ts + i) = *(const uint4*)(filt + i);
    const u16* Usrc = (const u16*)(p->ws + (order == 0 ? OFF_HXT : OFF_HYZ)) + (size_t)ch * TT + seq0;
    const int nch = (n + 192) / 8;
    for (int idx = tid; idx < 8 * nch; idx += 512) {
      const int b = idx / nch, c8 = idx % nch, s = c8 * 8 - 96;
      uint4 v = make_uint4(0, 0, 0, 0);
      if (s >= 0 && s < n) v = *(const uint4*)(Usrc + (size_t)b * n + s);
      *(uint4*)(Us + b * USTR + c8 * 8) = v;
    }
  }
  __syncthreads();
  for (int E = tid; E < 2 * n; E += 512) {
    unsigned w[4];
#pragma unroll
    for (int q = 0; q < 4; ++q) {
      const int x0 = E - 2 * q, x1 = E - 2 * q - 1;
      const unsigned lo = (x0 >= 0 && x0 <= 2 * n - 2) ? Ts[x0] : 0u;
      const unsigned hi = (x1 >= 0 && x1 <= 2 * n - 2) ? Ts[x1] : 0u;
      w[q] = lo | (hi << 16);
    }
    *(uint4*)(F + E * 8) = make_uint4(w[0], w[1], w[2], w[3]);
  }
  float asum = 0.f;
  {
    const float* fp = (const float*)(p->ws + OFF_FPART) + (size_t)(l * 72 + (ty ? 64 : 0)) * 1024 + oc;
    const int nck = ty ? 8 : 64;
    for (int c = 0; c < nck; ++c) asum += fp[c * 1024] + fp[c * 1024 + 512];
  }
  const float inv = 1.f / asum;
  __syncthreads();
  const int ntile = n >> 7;
  if (wave < ntile) {
    const bool two = (wave + 8) < ntile;
    f32x16 acc0, acc1;
#pragma unroll
    for (int i = 0; i < 16; ++i) { acc0[i] = 0.f; acc1[i] = 0.f; }
    const int m = lane & 31, kh = lane >> 5, dl = m >> 3, bb = m & 7;
    const u16* Bp = Us + bb * USTR + 8 * kh + 32 * dl;
    const int T0 = wave * 128;
    const int nsteps = (n + 96) / 16;
    const u16* Ap = F + (size_t)(T0 + 96 + n - 1 + m - 8 * kh) * 8;
#pragma unroll 2
    for (int st = 0; st < nsteps; ++st) {
      const bf16x8 bfrag = *(const bf16x8*)(Bp + st * 16);
      const bf16x8 a0 = *(const bf16x8*)(Ap - st * 128);
      acc0 = __builtin_amdgcn_mfma_f32_32x32x16_bf16(a0, bfrag, acc0, 0, 0, 0);
      if (two) {
        const bf16x8 a1 = *(const bf16x8*)(Ap - st * 128 + 1024 * 8);
        acc1 = __builtin_amdgcn_mfma_f32_32x32x16_bf16(a1, bfrag, acc1, 0, 0, 0);
      }
    }
    const float bias = p->in[I_HYBIAS][l * 512 + oc];
    const u16* gsrc = (const u16*)(p->ws + OFF_HXT) + (size_t)((order == 0 ? 256 : 512) + ch) * TT;
    const u16* usrc = (const u16*)(p->ws + (order == 0 ? OFF_HXT : OFF_HYZ)) + (size_t)ch * TT;
#pragma unroll
    for (int tsel = 0; tsel < 2; ++tsel) {
      if (tsel == 1 && !two) break;
      const int Tb = T0 + tsel * 1024;
#pragma unroll
      for (int rq = 0; rq < 4; ++rq) {
        const int t = Tb + 32 * dl + 8 * rq + 4 * kh;
        const size_t tok = (size_t)seq0 + (size_t)bb * n + t;
        const uint2 gx = *(const uint2*)(gsrc + tok);
        const uint2 ux = *(const uint2*)(usrc + tok);
        const float g[4] = {__uint_as_float(gx.x << 16), __uint_as_float(gx.x & 0xffff0000u), __uint_as_float(gx.y << 16), __uint_as_float(gx.y & 0xffff0000u)};
        const float u[4] = {__uint_as_float(ux.x << 16), __uint_as_float(ux.x & 0xffff0000u), __uint_as_float(ux.y << 16), __uint_as_float(ux.y & 0xffff0000u)};
        float o[4];
#pragma unroll
        for (int e = 0; e < 4; ++e) {
          const float y = (tsel == 0 ? acc0[rq * 4 + e] : acc1[rq * 4 + e]) * inv;
          o[e] = g[e] * (y + u[e] * bias);
        }
        if (order == 0) {
          uint2 ov; ov.x = pack2(o[0], o[1]); ov.y = pack2(o[2], o[3]);
          *(uint2*)((u16*)(p->ws + OFF_HYZ) + (size_t)ch * TT + tok) = ov;
        } else {
          u16* cat = (u16*)(p->ws + OFF_H);
#pragma unroll
          for (int e = 0; e < 4; ++e) cat[(tok + e) * 1024 + ch] = f2bf(o[e]);
        }
      }
    }
  }
}

__device__ __attribute__((always_inline)) void na_task(PC p, int l, int task, unsigned char* smem) {
  u16* Qs = (u16*)smem;
  u16* Ks = Qs + 128 * 72;
  u16* Vt = Ks + 64 * 72;
  float* rpbs = (float*)(Vt + 64 * 72);
  const int tid = TID(), wave = tid >> 6, lane = tid & 63;
  const int grp = wave >> 2, w4 = wave & 3;
  const u16* slab = (const u16*)(p->ws + OFF_SLAB);
  int b, hd, r0 = 0, u0 = 0, nloc = 0, qbase0, qbase1;
  const bool local = task < 512;
  if (local) {
    b = task >> 6; hd = (task >> 4) & 3; r0 = (task & 15) * 2;
    u0 = min(max(r0 - 4, 0), 24);
    nloc = min(max(r0 + 1 - 4, 0), 24) + 8 - u0;
    qbase0 = b * 2048 + r0 * 64; qbase1 = qbase0 + 64;
  } else {
    const int t2 = task - 512; b = t2 >> 3; hd = (t2 >> 1) & 3;
    qbase0 = TL + b * 256 + (t2 & 1) * 128; qbase1 = qbase0 + 64;
  }
  const int nchunks = nloc + 4;
  const int r = r0 + grp;
  const int rs = min(max(r - 4, 0), 24);
  const int qtok0 = grp ? qbase1 : qbase0;
  const float* qn = p->in[I_NAQN] + l * 64;
  const float* kn = p->in[I_NAKN] + l * 64;
  __syncthreads();
  {
    const int q = tid >> 2, dq = tid & 3;
    const int qt = (q < 64 ? qbase0 : qbase1) + (q & 63);
    float v[16];
    unpack8(*(const uint4*)(slab + (size_t)qt * PS + NA_OFF + hd * 64 + dq * 16), v);
    unpack8(*(const uint4*)(slab + (size_t)qt * PS + NA_OFF + hd * 64 + dq * 16 + 8), v + 8);
    float ss = 0.f;
#pragma unroll
    for (int e = 0; e < 16; ++e) ss += v[e] * v[e];
    ss += __shfl_xor(ss, 1); ss += __shfl_xor(ss, 2);
    const float rinv = rsqrtf(ss * (1.f / 64.f) + 1e-6f);
    uint4 o0, o1;
    o0.x = pack2(v[0] * rinv * qn[dq * 16 + 0], v[1] * rinv * qn[dq * 16 + 1]);
    o0.y = pack2(v[2] * rinv * qn[dq * 16 + 2], v[3] * rinv * qn[dq * 16 + 3]);
    o0.z = pack2(v[4] * rinv * qn[dq * 16 + 4], v[5] * rinv * qn[dq * 16 + 5]);
    o0.w = pack2(v[6] * rinv * qn[dq * 16 + 6], v[7] * rinv * qn[dq * 16 + 7]);
    o1.x = pack2(v[8] * rinv * qn[dq * 16 + 8], v[9] * rinv * qn[dq * 16 + 9]);
    o1.y = pack2(v[10] * rinv * qn[dq * 16 + 10], v[11] * rinv * qn[dq * 16 + 11]);
    o1.z = pack2(v[12] * rinv * qn[dq * 16 + 12], v[13] * rinv * qn[dq * 16 + 13]);
    o1.w = pack2(v[14] * rinv * qn[dq * 16 + 14], v[15] * rinv * qn[dq * 16 + 15]);
    *(uint4*)(Qs + q * 72 + dq * 16) = o0;
    *(uint4*)(Qs + q * 72 + dq * 16 + 8) = o1;
    for (int i = tid; i < 15 * 31; i += 512) rpbs[i] = p->in[I_NARPB][(size_t)(l * 4 + hd) * 15 * 31 + i];
  }
  const int fr = lane & 15, fq = lane >> 4;
  const int qc = w4 * 16 + fr;
  const int cs = min(max(qc - 8, 0), 48);
  float m = -1e30f, lsum = 0.f;
  f32x4 o[4];
#pragma unroll
  for (int i = 0; i < 4; ++i) o[i] = (f32x4){0.f, 0.f, 0.f, 0.f};
  bf16x8 bq[2];
  uint4 kraw, vraw;
  const int skey = tid >> 3, sdc = tid & 7;
#define NA_KTOK(CI) (((CI) < nloc) ? b * 2048 + (u0 + (CI)) * 64 : TL + b * 256 + ((CI) - nloc) * 64)
  {
    const int kt0 = NA_KTOK(0);
    kraw = *(const uint4*)(slab + (size_t)(kt0 + skey) * PS + NA_OFF + 256 + hd * 64 + sdc * 8);
    vraw = *(const uint4*)(slab + (size_t)(kt0 + skey) * PS + NA_OFF + 512 + hd * 64 + sdc * 8);
  }
#pragma unroll 1
  for (int ci = 0; ci < nchunks; ++ci) {
    __syncthreads();
    const bool lc = ci < nloc;
    const int rr = u0 + ci;
    const bool active = !lc || (rr >= rs && rr < rs + 8);
    {
      const int key = skey, dc = sdc;
      float v[8];
      unpack8(kraw, v);
      float ss = 0.f;
#pragma unroll
      for (int e = 0; e < 8; ++e) ss += v[e] * v[e];
      ss += __shfl_xor(ss, 1); ss += __shfl_xor(ss, 2); ss += __shfl_xor(ss, 4);
      const float rinv = rsqrtf(ss * (1.f / 64.f) + 1e-6f);
      uint4 ov;
      ov.x = pack2(v[0] * rinv * kn[dc * 8 + 0], v[1] * rinv * kn[dc * 8 + 1]);
      ov.y = pack2(v[2] * rinv * kn[dc * 8 + 2], v[3] * rinv * kn[dc * 8 + 3]);
      ov.z = pack2(v[4] * rinv * kn[dc * 8 + 4], v[5] * rinv * kn[dc * 8 + 5]);
      ov.w = pack2(v[6] * rinv * kn[dc * 8 + 6], v[7] * rinv * kn[dc * 8 + 7]);
      *(uint4*)(Ks + key * 72 + dc * 8) = ov;
      const unsigned w4[4] = {vraw.x, vraw.y, vraw.z, vraw.w};
#pragma unroll
      for (int e = 0; e < 4; ++e) {
        Vt[(dc * 8 + 2 * e) * 72 + key] = (u16)(w4[e] & 0xffffu);
        Vt[(dc * 8 + 2 * e + 1) * 72 + key] = (u16)(w4[e] >> 16);
      }
    }
    __syncthreads();
    if (ci + 1 < nchunks) {
      const int kt1 = NA_KTOK(ci + 1);
      kraw = *(const uint4*)(slab + (size_t)(kt1 + skey) * PS + NA_OFF + 256 + hd * 64 + sdc * 8);
      vraw = *(const uint4*)(slab + (size_t)(kt1 + skey) * PS + NA_OFF + 512 + hd * 64 + sdc * 8);
    }
    if (ci == 0) {
      bq[0] = *(const bf16x8*)(Qs + (grp * 64 + w4 * 16 + fr) * 72 + fq * 8);
      bq[1] = *(const bf16x8*)(Qs + (grp * 64 + w4 * 16 + fr) * 72 + 32 + fq * 8);
    }
    if (active) {
      f32x4 s[4];
#pragma unroll
      for (int mt = 0; mt < 4; ++mt) {
        s[mt] = (f32x4){0.f, 0.f, 0.f, 0.f};
#pragma unroll
        for (int ks = 0; ks < 2; ++ks) {
          bf16x8 a = *(const bf16x8*)(Ks + (mt * 16 + fr) * 72 + ks * 32 + fq * 8);
          s[mt] = __builtin_amdgcn_mfma_f32_16x16x32_bf16(a, bq[ks], s[mt], 0, 0, 0);
        }
      }
      float cmax = -1e30f;
#pragma unroll
      for (int mt = 0; mt < 4; ++mt)
#pragma unroll
        for (int j = 0; j < 4; ++j) {
          float v = s[mt][j] * 0.125f;
          if (lc) {
            const int kc = mt * 16 + fq * 4 + j;
            const bool ok = (kc >= cs) && (kc < cs + 16);
            int dcol = min(max(kc - qc, -15), 15);
            v = ok ? v + rpbs[(rr - r + 7) * 31 + dcol + 15] : -1e30f;
          }
          s[mt][j] = v;
          cmax = fmaxf(cmax, v);
        }
      cmax = allmax_rows(cmax);
      const float mnew = fmaxf(m, cmax);
      const float alpha = __expf(m - mnew);
      m = mnew;
      float ps = 0.f;
#pragma unroll
      for (int mt = 0; mt < 4; ++mt)
#pragma unroll
        for (int j = 0; j < 4; ++j) { float pp = __expf(s[mt][j] - mnew); s[mt][j] = pp; ps += pp; }
      lsum = lsum * alpha + ps;
#pragma unroll
      for (int dt = 0; dt < 4; ++dt) o[dt] *= alpha;
      bf16x8 pb[2];
#pragma unroll
      for (int h2 = 0; h2 < 2; ++h2) {
#pragma unroll
        for (int e = 0; e < 4; ++e) {
          pb[h2][e] = (short)f2bf(s[2 * h2][e]);
          pb[h2][4 + e] = (short)f2bf(s[2 * h2 + 1][e]);
        }
      }
#pragma unroll
      for (int dt = 0; dt < 4; ++dt)
#pragma unroll
        for (int h2 = 0; h2 < 2; ++h2) {
          bf16x4 va = *(const bf16x4*)(Vt + (dt * 16 + fr) * 72 + (2 * h2) * 16 + fq * 4);
          bf16x4 vb = *(const bf16x4*)(Vt + (dt * 16 + fr) * 72 + (2 * h2 + 1) * 16 + fq * 4);
          bf16x8 a = __builtin_shufflevector(va, vb, 0, 1, 2, 3, 4, 5, 6, 7);
          o[dt] = __builtin_amdgcn_mfma_f32_16x16x32_bf16(a, pb[h2], o[dt], 0, 0, 0);
        }
    }
  }
  {
    lsum = allred_rows(lsum);
    const float inv = 1.f / lsum;
    u16* cat = (u16*)(p->ws + OFF_H);
    const int tok = qtok0 + w4 * 16 + fr;
#pragma unroll
    for (int dt = 0; dt < 4; ++dt) {
      uint2 ov;
      ov.x = pack2(o[dt][0] * inv, o[dt][1] * inv);
      ov.y = pack2(o[dt][2] * inv, o[dt][3] * inv);
      *(uint2*)(cat + (size_t)tok * 1024 + 256 + hd * 64 + dt * 16 + fq * 4) = ov;
    }
  }
}

DEV void combine_token(PC p, int l, int tok, const float* g, const u16* slab, const u16* rwl, const u16* dno, const u16* rwy, u16* cat, const float* mu, int c4) {
    int base, n;
    if (tok < TL) { base = (tok >> 11) << 11; n = 2048; } else { base = TL + (((tok - TL) >> 8) << 8); n = 256; }
    const int pos = tok - base;
    {
      float4 ov;
      {
        const uint2 f0 = *(const uint2*)(dno + (size_t)tok * 256 + c4), f1 = *(const uint2*)(dno + (size_t)TT * 256 + (size_t)tok * 256 + c4);
        ov.x = __uint_as_float(f0.x << 16) + __uint_as_float(f1.x << 16);
        ov.y = __uint_as_float(f0.x & 0xffff0000u) + __uint_as_float(f1.x & 0xffff0000u);
        ov.z = __uint_as_float(f0.y << 16) + __uint_as_float(f1.y << 16);
        ov.w = __uint_as_float(f0.y & 0xffff0000u) + __uint_as_float(f1.y & 0xffff0000u);
      }
      float ss = ov.x * ov.x + ov.y * ov.y + ov.z * ov.z + ov.w * ov.w;
      ss += __shfl_xor(ss, 1); ss += __shfl_xor(ss, 2); ss += __shfl_xor(ss, 4); ss += __shfl_xor(ss, 8);
      const float rinv = rsqrtf(ss * (1.f / 64.f) + 1e-6f);
      const float* nw = p->in[I_DNNORM] + l * 64 + (c4 & 63);
      uint2 zz = *(const uint2*)(slab + (size_t)tok * PS + DN_OFF + 768 + c4);
      float z0 = __uint_as_float(zz.x << 16), z1 = __uint_as_float(zz.x & 0xffff0000u), z2 = __uint_as_float(zz.y << 16), z3 = __uint_as_float(zz.y & 0xffff0000u);
      uint2 o2;
      o2.x = pack2(ov.x * rinv * nw[0] * siluf_(z0), ov.y * rinv * nw[1] * siluf_(z1));
      o2.y = pack2(ov.z * rinv * nw[2] * siluf_(z2), ov.w * rinv * nw[3] * siluf_(z3));
      *(uint2*)(cat + (size_t)tok * 1024 + 512 + c4) = o2;
    }
    {
      float ts[3][4];
#pragma unroll
      for (int sgi = 0; sgi < 3; ++sgi) {
        const int col = RW_OFF + sgi * 256 + c4;
        uint2 cu = *(const uint2*)(slab + (size_t)tok * PS + col);
        uint2 pu = pos > 0 ? *(const uint2*)(slab + (size_t)(tok - 1) * PS + col) : make_uint2(0, 0);
        uint2 nu = pos < n - 1 ? *(const uint2*)(slab + (size_t)(tok + 1) * PS + col) : make_uint2(0, 0);
        float uc[4] = {__uint_as_float(cu.x << 16), __uint_as_float(cu.x & 0xffff0000u), __uint_as_float(cu.y << 16), __uint_as_float(cu.y & 0xffff0000u)};
        float up[4] = {__uint_as_float(pu.x << 16), __uint_as_float(pu.x & 0xffff0000u), __uint_as_float(pu.y << 16), __uint_as_float(pu.y & 0xffff0000u)};
        float un[4] = {__uint_as_float(nu.x << 16), __uint_as_float(nu.x & 0xffff0000u), __uint_as_float(nu.y << 16), __uint_as_float(nu.y & 0xffff0000u)};
#pragma unroll
        for (int e = 0; e < 4; ++e) ts[sgi][e] = uc[e] + mu[sgi * 256 + c4 + e] * (up[e] - uc[e]) + mu[896 + sgi * 256 + c4 + e] * (un[e] - uc[e]);
      }
      float4 yv;
      {
        const uint2 f0 = *(const uint2*)(rwy + (size_t)tok * 256 + c4), f1 = *(const uint2*)(rwy + (size_t)TT * 256 + (size_t)tok * 256 + c4);
        yv.x = __uint_as_float(f0.x << 16) + __uint_as_float(f1.x << 16);
        yv.y = __uint_as_float(f0.x & 0xffff0000u) + __uint_as_float(f1.x & 0xffff0000u);
        yv.z = __uint_as_float(f0.y << 16) + __uint_as_float(f1.y << 16);
        yv.w = __uint_as_float(f0.y & 0xffff0000u) + __uint_as_float(f1.y & 0xffff0000u);
      }
      float y[4] = {yv.x, yv.y, yv.z, yv.w};
      float sm = y[0] + y[1] + y[2] + y[3];
      sm += __shfl_xor(sm, 1); sm += __shfl_xor(sm, 2); sm += __shfl_xor(sm, 4); sm += __shfl_xor(sm, 8);
      const float mean = sm * (1.f / 64.f);
      float sq = 0.f;
#pragma unroll
      for (int e = 0; e < 4; ++e) sq += (y[e] - mean) * (y[e] - mean);
      sq += __shfl_xor(sq, 1); sq += __shfl_xor(sq, 2); sq += __shfl_xor(sq, 4); sq += __shfl_xor(sq, 8);
      const float rstd = rsqrtf(sq * (1.f / 64.f) + 64e-5f);
      uint2 al0 = *(const uint2*)(rwl + (size_t)tok * 1024 + 256 + c4);
      uint2 al1 = *(const uint2*)(rwl + (size_t)tok * 1024 + 512 + 256 + c4);
      float a0l[4] = {__uint_as_float(al0.x << 16), __uint_as_float(al0.x & 0xffff0000u), __uint_as_float(al0.y << 16), __uint_as_float(al0.y & 0xffff0000u)};
      float a1l[4] = {__uint_as_float(al1.x << 16), __uint_as_float(al1.x & 0xffff0000u), __uint_as_float(al1.y << 16), __uint_as_float(al1.y & 0xffff0000u)};
      float bs = 0.f;
#pragma unroll
      for (int e = 0; e < 4; ++e) {
        const int ch = c4 + e;
        const float a0 = a0l[e];
        const float a1 = a1l[e];
        const float ka = p->in[I_RWKA][l * 256 + ch];
        const float ksum = ts[1][e] * (2.f + (a0 + a1 - 2.f) * ka);
        bs += ts[0][e] * ksum * p->in[I_RWRK][l * 256 + ch];
      }
      bs += __shfl_xor(bs, 1); bs += __shfl_xor(bs, 2); bs += __shfl_xor(bs, 4); bs += __shfl_xor(bs, 8);
      float outv[4];
#pragma unroll
      for (int e = 0; e < 4; ++e) {
        const int ch = c4 + e;
        const float yn = (y[e] - mean) * rstd * p->in[I_RWLNW][l * 256 + ch] + p->in[I_RWLNB][l * 256 + ch];
        outv[e] = (yn + bs * ts[2][e]) * g[e];
      }
      uint2 o2; o2.x = pack2(outv[0], outv[1]); o2.y = pack2(outv[2], outv[3]);
      *(uint2*)(cat + (size_t)tok * 1024 + 768 + c4) = o2;
    }
}

__device__ __attribute__((always_inline)) void combine_pass(PC p, int l, int ntok, unsigned char* smem) {
  const int tid = TID(), wave = tid >> 6, lane = tid & 63;
  float* sg = (float*)smem + wave * 192;
  const u16* slab = (const u16*)(p->ws + OFF_SLAB);
  const u16* rwl = (const u16*)(p->ws + OFF_RWL);
  const u16* dno = (const u16*)(p->ws + OFF_DNO);
  const u16* rwy = (const u16*)(p->ws + OFF_RWY);
  u16* cat = (u16*)(p->ws + OFF_H);
  const float* mu = p->in[I_RWMU] + l * 2 * 896;
  const float* gup = p->in[I_RWGUP] + (size_t)l * 64 * 256;
  const int c4 = lane * 4;
  __syncthreads();
  for (int tok0 = (BID() * 8 + wave) * 3; tok0 < ntok; tok0 += NBLK() * 8 * 3) {
#pragma unroll
    for (int tt = 0; tt < 3; ++tt) {
      const int tok = min(tok0 + tt, ntok - 1);
      int base, n;
      if (tok < TL) { base = (tok >> 11) << 11; n = 2048; } else { base = TL + (((tok - TL) >> 8) << 8); n = 256; }
      const int pos = tok - base;
      const int col = RW_OFF + 832 + lane;
      float u = bf2f(slab[(size_t)tok * PS + col]);
      float pv = pos > 0 ? bf2f(slab[(size_t)(tok - 1) * PS + col]) : 0.f;
      float nx = pos < n - 1 ? bf2f(slab[(size_t)(tok + 1) * PS + col]) : 0.f;
      float sv = u + mu[832 + lane] * (pv - u) + mu[896 + 832 + lane] * (nx - u);
      sg[tt * 64 + lane] = sigmoidf_(sv);
    }
    float g[3][4];
#pragma unroll
    for (int tt = 0; tt < 3; ++tt)
#pragma unroll
      for (int e = 0; e < 4; ++e) g[tt][e] = 0.f;
#pragma unroll 4
    for (int j = 0; j < 64; ++j) {
      const float4 gw = *(const float4*)(gup + j * 256 + c4);
#pragma unroll
      for (int tt = 0; tt < 3; ++tt) {
        const float sj = sg[tt * 64 + j];
        g[tt][0] = fmaf(sj, gw.x, g[tt][0]); g[tt][1] = fmaf(sj, gw.y, g[tt][1]); g[tt][2] = fmaf(sj, gw.z, g[tt][2]); g[tt][3] = fmaf(sj, gw.w, g[tt][3]);
      }
    }
#pragma unroll
    for (int tt = 0; tt < 3; ++tt)
      if (tok0 + tt < ntok) combine_token(p, l, tok0 + tt, g[tt], slab, rwl, dno, rwy, cat, mu, c4);
  }
}

#ifndef XB_ALL_RELEASE
#define XB_ALL_RELEASE 0
#endif
#define XB_TMO      128
#define XB_XCNT(j)  (256  + 64 * (j))
#define XB_XSUB(j)  (1280 + 64 * (j))
#define XB_XGEN(j)  (2304 + 64 * (j))
#define XB_TOP      3328
#define XB_TOPGEN   3392
#define XB_SPIN_CAP (1u << 18)
#define LAS __attribute__((address_space(3)))
DEV unsigned xb_ld(unsigned* p) { return __hip_atomic_load(p, __ATOMIC_RELAXED, __HIP_MEMORY_SCOPE_AGENT); }
DEV unsigned xb_add(unsigned* p, unsigned v) { return __hip_atomic_fetch_add(p, v, __ATOMIC_RELAXED, __HIP_MEMORY_SCOPE_AGENT); }
DEV unsigned xb_xcc_id() { return (unsigned)__builtin_amdgcn_s_getreg((3 << 11) | 20) & 0xFu; }
#define XB_SPIN(cond, bar) do { unsigned _sp = 0; while (cond) { __builtin_amdgcn_s_sleep(1); \
    if ((++_sp & 255u) == 0u) { if (xb_ld(&(bar)[XB_TMO])) break; if (_sp > XB_SPIN_CAP) { atomicAdd(&(bar)[XB_TMO], 1u); break; } } } } while (0)
struct XcdBarrier { unsigned* bar; unsigned x; volatile LAS unsigned* st; };
DEV XcdBarrier xcd_barrier_post(unsigned* bar, volatile LAS unsigned* st) {
  XcdBarrier b; b.bar = bar; b.x = xb_xcc_id(); b.st = st;
  if (threadIdx.x == 0) (void)xb_add(&bar[XB_XCNT(b.x)], 1u);
  return b;
}
DEV void xcd_barrier_complete(unsigned* bar, unsigned x, unsigned& nloc, unsigned& nx) {
  const unsigned G = gridDim.x * gridDim.y * gridDim.z;
  unsigned sum, cnt, mine, sp = 0u;
  for (;;) {
    sum = 0u; cnt = 0u; mine = 0u;
#pragma unroll
    for (unsigned j = 0; j < 16; ++j) { const unsigned c = xb_ld(&bar[XB_XCNT(j)]); sum += c; cnt += (c > 0u) ? 1u : 0u; mine = (j == x) ? c : mine; }
    if (sum == G) break;
    __builtin_amdgcn_s_sleep(1);
    if ((++sp & 255u) == 0u) { if (xb_ld(&bar[XB_TMO])) break; if (sp > XB_SPIN_CAP) { atomicAdd(&bar[XB_TMO], 1u); break; } }
  }
  nloc = mine > 0u ? mine : 1u; nx = cnt > 0u ? cnt : 1u;
}
DEV void xcd_barrier(const XcdBarrier& b) {
  asm volatile("s_waitcnt vmcnt(0)" ::: "memory");
  __syncthreads();
  if (threadIdx.x == 0) {
    unsigned* bar = b.bar;
    __builtin_amdgcn_s_waitcnt(0);
#if XB_ALL_RELEASE
    __builtin_amdgcn_fence(__ATOMIC_RELEASE, "agent");
    asm volatile("s_waitcnt vmcnt(0)" ::: "memory");
#endif
    unsigned nloc = b.st[0], nx = b.st[1];
    if (nloc == 0u) { xcd_barrier_complete(bar, b.x, nloc, nx); b.st[0] = nloc; b.st[1] = nx; }
    const unsigned old = xb_add(&bar[XB_XSUB(b.x)], 1u);
    const unsigned gen = old / nloc;
    if (old + 1u == (gen + 1u) * nloc) {
      __builtin_amdgcn_fence(__ATOMIC_RELEASE, "agent");
      asm volatile("s_waitcnt vmcnt(0)" ::: "memory");
      const unsigned og = xb_add(&bar[XB_TOP], 1u);
      const unsigned tg = og / nx;
      if (og + 1u == (tg + 1u) * nx) xb_add(&bar[XB_TOPGEN], 1u);
      else XB_SPIN(xb_ld(&bar[XB_TOPGEN]) == tg, bar);
      __builtin_amdgcn_fence(__ATOMIC_ACQUIRE, "agent");
      xb_add(&bar[XB_XGEN(b.x)], 1u);
      asm volatile("s_waitcnt vmcnt(0)" ::: "memory");
    } else {
      XB_SPIN(xb_ld(&bar[XB_XGEN(b.x)]) == gen, bar);
      __builtin_amdgcn_fence(__ATOMIC_ACQUIRE, "agent");
      asm volatile("s_waitcnt vmcnt(0)" ::: "memory");
    }
  }
  __syncthreads();
}

DEV void ctr_barrier(unsigned* ctr, unsigned& epoch) {
  asm volatile("s_waitcnt vmcnt(0)" ::: "memory");
  __syncthreads();
  if (threadIdx.x == 0) {
    __builtin_amdgcn_fence(__ATOMIC_RELEASE, "agent");
    asm volatile("s_waitcnt vmcnt(0)" ::: "memory");
    epoch += 1;
    const unsigned target = epoch * gridDim.x;
    (void)xb_add(ctr, 1u);
    unsigned sp = 0;
    while (xb_ld(ctr) < target) { __builtin_amdgcn_s_sleep(1); if (++sp > (1u << 24)) break; }
    __builtin_amdgcn_fence(__ATOMIC_ACQUIRE, "agent");
    asm volatile("s_waitcnt vmcnt(0)" ::: "memory");
  }
  __syncthreads();
}
#ifndef USE_CTR_BARRIER
#define USE_CTR_BARRIER 0
#endif
#if USE_CTR_BARRIER
#define GBAR() ctr_barrier((unsigned*)(launder(pk)->ws + OFF_BAR), gb_epoch)
#else
#define GBAR() xcd_barrier(xb)
#endif

__global__ void __launch_bounds__(512) fwd_megakernel(P p_unused) {
  cg::grid_group grid = cg::this_grid();
  PC pk = (PC)__builtin_amdgcn_kernarg_segment_ptr();
  __shared__ __attribute__((aligned(16))) unsigned char smem[SMEM_BYTES];
  __shared__ int s_task;
  __shared__ uint4 xb_words;
  if (threadIdx.x == 0) xb_words = make_uint4(0u, 0u, 0u, 0u);
  __syncthreads();
  const XcdBarrier xb = xcd_barrier_post((unsigned*)(launder(pk)->ws + OFF_BAR), (volatile LAS unsigned*)&xb_words);
  unsigned gb_epoch = 0;
  __shared__ int s_vbid;
  if (threadIdx.x == 0) s_vbid = (int)xb_add((unsigned*)(launder(pk)->ws + OFF_CNT) + 16 + xb.x, 1u) * 8 + (int)xb.x;
  const int tid = TID();
  const int nb = NBLK(), bid = BID();

  {
    LOADP();
    for (int rep = 0; rep <= PROBE_P0; ++rep) {
      for (int t = bid; t < 144 + 144; t += nb) {
        if (t < 144) task_mod(p, t, smem);
        else task_filter(p, t - 144, smem);
      }
      convert_all(p, 0, smem);
    }
  }
  grid.sync();
  int vbid;
  {
    unsigned* bar = (unsigned*)(launder(pk)->ws + OFF_BAR);
    bool ok = (gridDim.x == 256);
    for (int j = 0; j < 16; ++j) { const unsigned c = xb_ld(&bar[XB_XCNT(j)]); ok = ok && (c == (j < 8 ? 32u : 0u)); }
    vbid = ok ? s_vbid : -1;
    vbid = __builtin_amdgcn_readfirstlane(vbid);
  }

#pragma unroll 1
  for (int l = 0; l < 2; ++l) {
    const bool need_ctx = (l == 0);
    {
      LOADP();
      if (l == 1) convert_all(p, 1, smem);
      for (int rep = 0; rep <= PROBE_ADALN; ++rep) adaln_pass(p, l, 0, (l == 0) ? p->in[I_X] : p->out, (l == 0) ? p->in[I_CTX] : (const float*)(p->ws + OFF_XC), TT);
    }
    GBAR();
    {
      LOADP();
      Epi e{}; e.outb = (u16*)(p->ws + OFF_ACT);
      for (int rep = 0; rep <= PROBE_GEMM; ++rep) gemm_phase_big<0>((const u16*)(p->ws + OFF_H), 1024, (const u16*)(p->ws + OFF_WGU), 1024, TT, 5632, e, smem);
    }
    GBAR();
    {
      LOADP();
      float* xc = (float*)(p->ws + OFF_XC);
      Epi e{}; e.xs_lat = (l == 0) ? p->in[I_X] : p->out; e.xs_ctx = (l == 0) ? p->in[I_CTX] : xc; e.xd_lat = p->out; e.xd_ctx = xc;
      e.gate = (const float*)(p->ws + OFF_MOD) + (size_t)l * 9 * 9216 + 2 * 1024; e.coef = 0.5f;
      gemm_phase_big<1>((const u16*)(p->ws + OFF_ACT), DFF, (const u16*)(p->ws + OFF_WDN), DFF, TL, 1024, e, smem);
      gemm_phase<1, 64>((const u16*)(p->ws + OFF_ACT), DFF, (const u16*)(p->ws + OFF_WDN), DFF, TC, 1024, e, smem, vbid, TL);
    }
    GBAR();
    {
      LOADP();
      for (int rep = 0; rep <= PROBE_ADALN; ++rep) adaln_pass(p, l, 1, p->out, (const float*)(p->ws + OFF_XC), TT);
    }
    GBAR();
    {
      LOADP();
      Epi e{}; e.outb = (u16*)(p->ws + OFF_SLAB);
      for (int rep = 0; rep <= PROBE_GEMM; ++rep) gemm_phase_big<2>((const u16*)(p->ws + OFF_H), 1024, (const u16*)(p->ws + OFF_WIN), 1024, TT, PS, e, smem);
    }
    GBAR();
    {
      LOADP();
      for (int rep = 0; rep <= PROBE_PREP; ++rep) for (int t = bid; t < TT / 32; t += nb) prep_task(p, l, t, smem);
    }
    GBAR();
    if (bid < 64) { LOADP(); dn_scan_unit(p, l, bid, smem); }
    else if (bid < 192) { LOADP(); rw_scan_unit(p, l, bid - 64, smem); }
    {
      const int n_hy = need_ctx ? 512 : 256;
      const int n_na = need_ctx ? 512 + 64 : 512;
      const int ntask = n_hy + n_na;
      while (true) {
        LOADP();
        __syncthreads();
        if (tid == 0) s_task = atomicAdd((int*)(p->ws + OFF_CNT) + l * 4, 1);
        __syncthreads();
        const int t = s_task;
        if (t >= ntask) break;
        if (t < n_hy) hyena_task(p, l, 0, t, smem);
        else na_task(p, l, t - n_hy, smem);
      }
    }
    GBAR();
#if PROBE_SCAN
    for (int rep = 0; rep < PROBE_SCAN; ++rep) {
      if (bid < 64) { if (!(PROBE_MODE & 8)) { LOADP(); dn_scan_unit(p, l, bid, smem, PROBE_MODE & 6); } }
      else if (bid < 192) { if (!(PROBE_MODE & 16)) { LOADP(); rw_scan_unit(p, l, bid - 64, smem, PROBE_MODE & 6); } }
      GBAR();
    }
#endif
    for (int rep = 0; rep <= PROBE_M2; ++rep) {
    {
      LOADP();
      const int n_hy = need_ctx ? 512 : 256;
      for (int t = bid; t < n_hy; t += nb) hyena_task(p, l, 1, t, smem);
    }
    {
      LOADP();
      combine_pass(p, l, need_ctx ? TT : TL, smem);
    }
    }
    GBAR();
    {
      LOADP();
      float* xc = (float*)(p->ws + OFF_XC);
      Epi e{}; e.xs_lat = p->out; e.xs_ctx = xc; e.xd_lat = p->out; e.xd_ctx = xc;
      e.gate = (const float*)(p->ws + OFF_MOD) + (size_t)l * 9 * 9216 + 5 * 1024; e.coef = 1.0f;
      gemm_phase_big<1>((const u16*)(p->ws + OFF_H), 1024, (const u16*)(p->ws + OFF_WOUT), 1024, TL, 1024, e, smem);
      if (need_ctx) gemm_phase<1, 64>((const u16*)(p->ws + OFF_H), 1024, (const u16*)(p->ws + OFF_WOUT), 1024, TC, 1024, e, smem, vbid, TL);
    }
    GBAR();
    {
      LOADP();
      for (int rep = 0; rep <= PROBE_ADALN; ++rep) adaln_pass(p, l, 2, p->out, (const float*)(p->ws + OFF_XC), need_ctx ? TT : TL);
    }
    GBAR();
    {
      LOADP();
      Epi e{}; e.outb = (u16*)(p->ws + OFF_ACT);
      for (int rep = 0; rep <= PROBE_GEMM; ++rep) gemm_phase_big<0>((const u16*)(p->ws + OFF_H), 1024, (const u16*)(p->ws + OFF_WGU) + (size_t)5632 * 1024, 1024, need_ctx ? TT : TL, 5632, e, smem);
    }
    GBAR();
    {
      LOADP();
      float* xc = (float*)(p->ws + OFF_XC);
      Epi e{}; e.xs_lat = p->out; e.xs_ctx = xc; e.xd_lat = p->out; e.xd_ctx = xc;
      e.gate = (const float*)(p->ws + OFF_MOD) + (size_t)l * 9 * 9216 + 8 * 1024; e.coef = 0.5f;
      gemm_phase_big<1>((const u16*)(p->ws + OFF_ACT), DFF, (const u16*)(p->ws + OFF_WDN) + (size_t)1024 * DFF, DFF, TL, 1024, e, smem);
      if (need_ctx) gemm_phase<1, 64>((const u16*)(p->ws + OFF_ACT), DFF, (const u16*)(p->ws + OFF_WDN) + (size_t)1024 * DFF, DFF, TC, 1024, e, smem, vbid, TL);
    }
    GBAR();
    for (int rep = 0; rep < PROBE_SYNC; ++rep) GBAR();
  }
}

extern "C" void kernel_launch(void* const* d_in, const int* in_sizes, int n_in, void* d_out, int out_size, void* d_ws, size_t ws_size,
                              hipStream_t stream) {
  P p{};
  for (int i = 0; i < 37; ++i) p.in[i] = (const float*)d_in[i];
  p.out = (float*)d_out;
  p.ws = (unsigned char*)d_ws;
  p.pad_ = 0;
  static int grid_blocks = 0;
  if (!grid_blocks) {
    int dev = 0, cus = 0, per_cu = 0;
    hipGetDevice(&dev);
    hipDeviceGetAttribute(&cus, hipDeviceAttributeMultiprocessorCount, dev);
    hipOccupancyMaxActiveBlocksPerMultiprocessor(&per_cu, fwd_megakernel, 512, 0);
    if (per_cu < 1) per_cu = 1;
    grid_blocks = cus;
    if (ws_size < WS_TOTAL) fprintf(stderr, "workspace too small: %zu < %zu\n", ws_size, (size_t)WS_TOTAL);
  }
  hipMemsetAsync((unsigned char*)d_ws + OFF_CNT, 0, 256 + 14080, stream);
  void* args[] = {&p};
  hipError_t e = hipLaunchCooperativeKernel((void*)fwd_megakernel, dim3(grid_blocks), dim3(512), args, 0, stream);
  if (e != hipSuccess) fprintf(stderr, "cooperative launch failed: %s (grid %d)\n", hipGetErrorString(e), grid_blocks);
}
```

```cpp
#include <hip/hip_runtime.h>
#include <hip/hip_cooperative_groups.h>
#include <cstdio>
#include <cstdint>
namespace cg = cooperative_groups;

typedef unsigned short u16;
typedef short bf16x8 __attribute__((ext_vector_type(8)));
typedef short bf16x4 __attribute__((ext_vector_type(4)));
typedef float f32x4 __attribute__((ext_vector_type(4)));
typedef unsigned u32x4 __attribute__((ext_vector_type(4)));
typedef float f32x16 __attribute__((ext_vector_type(16)));
#define DEV __device__ __forceinline__

constexpr int TL = 16384, TC = 2048, TT = 18432, DM = 1024, DFF = 2816, PS = 3584;
constexpr int NA_OFF = 768, DN_OFF = 1536, RW_OFF = 2576;
constexpr int SMEM_BYTES = 147456;
#ifndef PROBE_SCAN
#define PROBE_SCAN 0
#endif
#ifndef PROBE_MODE
#define PROBE_MODE 6
#endif
#ifndef PROBE_GEMM
#define PROBE_GEMM 0
#endif
#ifndef PROBE_SYNC
#define PROBE_SYNC 0
#endif
#ifndef PROBE_P0
#define PROBE_P0 0
#endif
#ifndef PROBE_ADALN
#define PROBE_ADALN 0
#endif
#ifndef PROBE_PREP
#define PROBE_PREP 0
#endif
#ifndef PROBE_M2
#define PROBE_M2 0
#endif

constexpr size_t OFF_WGU = 0;
constexpr size_t OFF_WDN = OFF_WGU + (size_t)2 * 5632 * 1024 * 2;
constexpr size_t OFF_WIN = OFF_WDN + (size_t)2 * 1024 * 2816 * 2;
constexpr size_t OFF_WOUT = OFF_WIN + (size_t)3584 * 1024 * 2;
constexpr size_t OFF_XC = OFF_WOUT + (size_t)1024 * 1024 * 2;
constexpr size_t OFF_H = OFF_XC + (size_t)TC * 1024 * 4;
constexpr size_t OFF_MOD = OFF_H + (size_t)TT * 1024 * 2;
constexpr size_t FILT_LAYER = ((size_t)512 * 4096 + (size_t)512 * 512) * 2;
constexpr size_t OFF_FILT = OFF_MOD + (size_t)2 * 9 * 9216 * 4;
constexpr size_t OFF_FPART = OFF_FILT + 2 * FILT_LAYER;
constexpr size_t OFF_CNT = OFF_FPART + (size_t)2 * 72 * 1024 * 4;
constexpr size_t OFF_BAR = OFF_CNT + 256;
constexpr size_t BAR_BYTES = 3456 * 4;
constexpr size_t OFF_R1 = OFF_BAR + 14080;
constexpr size_t OFF_SLAB = OFF_R1;
constexpr size_t OFF_ACT = OFF_R1;
constexpr size_t OFF_HYZ = OFF_SLAB + (size_t)TT * PS * 2;
constexpr size_t OFF_HXT = OFF_HYZ + (size_t)TT * 256 * 2;
constexpr size_t OFF_DNO = OFF_HXT + (size_t)TT * 768 * 2;
constexpr size_t OFF_RWY = OFF_DNO + (size_t)TT * 256 * 4;
constexpr size_t OFF_RWL = OFF_RWY + (size_t)TT * 256 * 4;
constexpr size_t WS_TOTAL = OFF_RWL + (size_t)TT * 1024 * 2;

struct P {
  const float* in[37];
  float* out;
  unsigned char* ws;
  size_t pad_;
};
enum { I_X = 0, I_C, I_CTX, I_CCTX, I_WMOD, I_BMOD, I_NORMW, I_WGU, I_WDOWN, I_WIN, I_WOUT, I_HYCONV, I_HYW1, I_HYB1, I_HYW2,
       I_HYB2, I_HYW3, I_HYFREQ, I_HYBIAS, I_NAQN, I_NAKN, I_NARPB, I_DNCONV, I_DNALOG, I_DNDT, I_DNNORM, I_RWMU, I_RWW0,
       I_RWWUP, I_RWA0, I_RWAUP, I_RWGUP, I_RWKK, I_RWKA, I_RWRK, I_RWLNW, I_RWLNB };

typedef const P __attribute__((address_space(4)))* PC;
DEV PC launder(PC q) { asm volatile("" : "+s"(q)); return q; }
#define LOADP() PC p = launder(pk)

DEV u16 f2bf(float f) { unsigned u = __float_as_uint(f); u += 0x7fffu + ((u >> 16) & 1u); return (u16)(u >> 16); }
DEV float bf2f(u16 h) { return __uint_as_float(((unsigned)h) << 16); }
DEV float sigmoidf_(float x) { return __builtin_amdgcn_rcpf(1.f + __expf(-x)); }
DEV float siluf_(float x) { return x * __builtin_amdgcn_rcpf(1.f + __expf(-x)); }
DEV float softplusf_(float x) { return x > 20.f ? x : log1pf(__expf(x)); }
DEV float wave_sum(float v) {
#pragma unroll
  for (int o = 32; o > 0; o >>= 1) v += __shfl_xor(v, o);
  return v;
}
DEV float allred_rows(float x) {
  auto r = __builtin_amdgcn_permlane32_swap(__float_as_uint(x), __float_as_uint(x), false, false);
  float y = __uint_as_float(r[0]) + __uint_as_float(r[1]);
  auto r2 = __builtin_amdgcn_permlane16_swap(__float_as_uint(y), __float_as_uint(y), false, false);
  return __uint_as_float(r2[0]) + __uint_as_float(r2[1]);
}
DEV float allmax_rows(float x) {
  auto r = __builtin_amdgcn_permlane32_swap(__float_as_uint(x), __float_as_uint(x), false, false);
  float y = fmaxf(__uint_as_float(r[0]), __uint_as_float(r[1]));
  auto r2 = __builtin_amdgcn_permlane16_swap(__float_as_uint(y), __float_as_uint(y), false, false);
  return fmaxf(__uint_as_float(r2[0]), __uint_as_float(r2[1]));
}
DEV void unpack8(uint4 v, float* f) {
  f[0] = __uint_as_float(v.x << 16); f[1] = __uint_as_float(v.x & 0xffff0000u);
  f[2] = __uint_as_float(v.y << 16); f[3] = __uint_as_float(v.y & 0xffff0000u);
  f[4] = __uint_as_float(v.z << 16); f[5] = __uint_as_float(v.z & 0xffff0000u);
  f[6] = __uint_as_float(v.w << 16); f[7] = __uint_as_float(v.w & 0xffff0000u);
}
DEV unsigned pack2(float a, float b) { return (unsigned)f2bf(a) | ((unsigned)f2bf(b) << 16); }

DEV int TID() { int t = threadIdx.x; asm volatile("" : "+v"(t)); return t; }
DEV int BID() { int t = blockIdx.x; asm volatile("" : "+s"(t)); return t; }
DEV int NBLK() { int t = gridDim.x; asm volatile("" : "+s"(t)); return t; }
DEV int step_tok(int b, int dir, int s, int& pos, int& n) {
  if (s < 256) { n = 256; pos = dir ? 255 - s : s; return TL + b * 256 + pos; }
  n = 2048; pos = dir ? 2047 - (s - 256) : (s - 256); return b * 2048 + pos;
}

__device__ __attribute__((always_inline)) void task_mod(PC p, int task, unsigned char* smem) {
  float* sc = (float*)smem;
  float* part = (float*)(smem + 36864);
  const int tid = TID();
  for (int i = tid; i < 9 * 1024; i += 512) {
    int r = i >> 10, k = i & 1023;
    float v = (r < 8) ? p->in[I_C][r * 1024 + k] : p->in[I_CCTX][k];
    sc[i] = siluf_(v);
  }
  __syncthreads();
  const int l = task / 72, jj = tid & 127, j = (task % 72) * 128 + jj, kp = tid >> 7;
  const float* w = p->in[I_WMOD] + (size_t)l * 1024 * 9216 + j;
  float acc[9];
#pragma unroll
  for (int r = 0; r < 9; ++r) acc[r] = 0.f;
#pragma unroll 8
  for (int k = kp * 256; k < kp * 256 + 256; ++k) {
    float wv = w[(size_t)k * 9216];
#pragma unroll
    for (int r = 0; r < 9; ++r) acc[r] = fmaf(sc[r * 1024 + k], wv, acc[r]);
  }
#pragma unroll
  for (int r = 0; r < 9; ++r) part[(kp * 9 + r) * 128 + jj] = acc[r];
  __syncthreads();
  float* mod = (float*)(p->ws + OFF_MOD);
  for (int i = tid; i < 9 * 128; i += 512) {
    int r = i >> 7, c = i & 127;
    float s = part[(0 * 9 + r) * 128 + c] + part[(1 * 9 + r) * 128 + c] + part[(2 * 9 + r) * 128 + c] + part[(3 * 9 + r) * 128 + c];
    int jg = (task % 72) * 128 + c;
    mod[(size_t)(l * 9 + r) * 9216 + jg] = s + p->in[I_BMOD][l * 9216 + jg];
  }
  __syncthreads();
}

__device__ __attribute__((always_inline)) void task_filter(PC p, int task, unsigned char* smem) {
  float* z = (float*)smem;
  float* h1 = z + 32 * 34;
  float* h2t = h1 + 32 * 64;
  const int tid = TID();
  const int l = task / 72, ck = task % 72;
  const int ty = ck >= 64, n = ty ? 256 : 2048, chunk = ty ? ck - 64 : ck;
  const float* w1 = p->in[I_HYW1] + l * 33 * 64;
  const float* b1 = p->in[I_HYB1] + l * 64;
  const float* w2 = p->in[I_HYW2] + l * 64 * 64;
  const float* b2 = p->in[I_HYB2] + l * 64;
  const float* w3 = p->in[I_HYW3] + (size_t)l * 64 * 1024;
  const float* fr = p->in[I_HYFREQ] + l * 64;
  for (int i = tid; i < 32 * 33; i += 512) {
    int li = i / 33, e = i % 33;
    int lag = chunk * 32 + li;
    float v;
    if (e == 0) v = (float)lag / (float)(n - 1);
    else {
      float ang = (6.283185307179586f * (float)lag) / (float)n;
      int jb = (e - 1) & 15;
      float band = 1e-4f + (float)jb * ((15.f - 1e-4f) / 15.f);
      float a = band * ang;
      v = (e <= 16) ? cosf(a) : -sinf(a);
    }
    z[li * 34 + e] = v;
  }
  __syncthreads();
  for (int i = tid; i < 32 * 64; i += 512) {
    int li = i >> 6, m = i & 63;
    float s = b1[m];
    for (int e = 0; e < 33; ++e) s = fmaf(z[li * 34 + e], w1[e * 64 + m], s);
    h1[li * 64 + m] = sinf(fr[m] * s);
  }
  __syncthreads();
  for (int i = tid; i < 32 * 64; i += 512) {
    int li = i >> 6, m = i & 63;
    float s = b2[m];
    for (int e = 0; e < 64; ++e) s = fmaf(h1[li * 64 + e], w2[e * 64 + m], s);
    h2t[m * 32 + li] = sinf(fr[m] * s);
  }
  __syncthreads();
  u16* filt = (u16*)(p->ws + OFF_FILT + (size_t)l * FILT_LAYER) + (ty ? (size_t)512 * 4096 : 0);
  float* fpart = (float*)(p->ws + OFF_FPART) + (size_t)(l * 72 + ck) * 1024;
  const float min_decay = -4.605170185988091f / 1.5f, max_decay = -4.605170185988091f / 0.3f;
#pragma unroll 1
  for (int half = 0; half < 2; ++half) {
    const int o = tid + half * 512;
    float acc[32];
#pragma unroll
    for (int i = 0; i < 32; ++i) acc[i] = 0.f;
#pragma unroll 1
    for (int m0 = 0; m0 < 64; m0 += 8) {
      float wv8[8];
#pragma unroll
      for (int j = 0; j < 8; ++j) wv8[j] = w3[(m0 + j) * 1024 + o];
#pragma unroll
      for (int j = 0; j < 8; ++j) {
        const float wv = wv8[j];
#pragma unroll
        for (int q = 0; q < 8; ++q) {
          float4 hv = *(const float4*)(h2t + (m0 + j) * 32 + q * 4);
          acc[q * 4 + 0] = fmaf(hv.x, wv, acc[q * 4 + 0]);
          acc[q * 4 + 1] = fmaf(hv.y, wv, acc[q * 4 + 1]);
          acc[q * 4 + 2] = fmaf(hv.z, wv, acc[q * 4 + 2]);
          acc[q * 4 + 3] = fmaf(hv.w, wv, acc[q * 4 + 3]);
        }
      }
    }
    const int dir = o >> 9, oc = o & 511;
    const float delta = fabsf(min_decay + (float)oc * ((max_decay - min_decay) / 511.f));
    float asum = 0.f;
    u16* frow = filt + (size_t)oc * (2 * n);
#pragma unroll
    for (int li = 0; li < 32; ++li) {
      int lag = chunk * 32 + li;
      float t = (float)lag / (float)(n - 1);
      float v = acc[li] * __expf(-t * delta);
      if (dir == 0) { frow[n - 1 + lag] = f2bf(v); asum += fabsf(v); }
      else if (lag >= 1) { frow[n - 1 - lag] = f2bf(v); asum += fabsf(v); }
    }
    fpart[o] = asum;
  }
  __syncthreads();
}

DEV void lds_barrier() { asm volatile("s_waitcnt lgkmcnt(0)\n\ts_barrier" ::: "memory"); }
constexpr int NCONV_TILES = 2816 + 1408 + 896 + 256;
struct ConvDesc { const float* src; u16* dst; int K, N, ndt, kt, mode; };
DEV ConvDesc conv_desc(PC p, int l, int t) {
  ConvDesc d;
  if (t < 2816) {
    int f = t / 1408, r = t % 1408;
    d.src = p->in[I_WGU] + (size_t)(l * 2 + f) * 1024 * 5632; d.K = 1024; d.N = 5632; d.dst = (u16*)(p->ws + OFF_WGU) + (size_t)f * 5632 * 1024; d.ndt = r / 16; d.kt = r % 16; d.mode = 1;
  } else if (t < 2816 + 1408) {
    t -= 2816;
    int f = t / 704, r = t % 704;
    d.src = p->in[I_WDOWN] + (size_t)(l * 2 + f) * 2816 * 1024; d.K = 2816; d.N = 1024; d.dst = (u16*)(p->ws + OFF_WDN) + (size_t)f * 1024 * 2816; d.ndt = r / 44; d.kt = r % 44; d.mode = 0;
  } else if (t < 2816 + 1408 + 896) {
    t -= 2816 + 1408;
    d.src = p->in[I_WIN] + (size_t)l * 1024 * 3472; d.K = 1024; d.N = 3472; d.dst = (u16*)(p->ws + OFF_WIN); d.ndt = t / 16; d.kt = t % 16; d.mode = 2;
  } else {
    t -= 2816 + 1408 + 896;
    d.src = p->in[I_WOUT] + (size_t)l * 1024 * 1024; d.K = 1024; d.N = 1024; d.dst = (u16*)(p->ws + OFF_WOUT); d.ndt = t / 16; d.kt = t % 16; d.mode = 0;
  }
  return d;
}
DEV void conv_load(const ConvDesc& d, float* v) {
  const int tid = TID();
  const int nn = tid & 63, nd = d.ndt * 64 + nn;
  int col;
  if (d.mode == 1) { int g = nd >> 5, r = nd & 31; col = (r < 16) ? g * 16 + r : DFF + g * 16 + (r - 16); }
  else if (d.mode == 2) col = (nd < 3472) ? nd : 0;
  else col = nd;
  const float* sp = d.src + (size_t)(d.kt * 64 + (tid >> 6)) * d.N + col;
#pragma unroll
  for (int i = 0; i < 8; ++i) v[i] = sp[(size_t)(i * 8) * d.N];
}
DEV void conv_store(const ConvDesc& d, const float* v, unsigned char* smem) {
  float* tile = (float*)smem;
  const int tid = TID();
  const int nn0 = tid & 63;
  const bool pad = (d.mode == 2) && (d.ndt * 64 + nn0 >= 3472);
#pragma unroll
  for (int i = 0; i < 8; ++i) tile[((tid >> 6) + i * 8) * 65 + nn0] = pad ? 0.f : v[i];
  lds_barrier();
  {
    int nn = tid >> 3, kc = tid & 7;
    uint4 o;
    o.x = pack2(tile[(kc * 8 + 0) * 65 + nn], tile[(kc * 8 + 1) * 65 + nn]);
    o.y = pack2(tile[(kc * 8 + 2) * 65 + nn], tile[(kc * 8 + 3) * 65 + nn]);
    o.z = pack2(tile[(kc * 8 + 4) * 65 + nn], tile[(kc * 8 + 5) * 65 + nn]);
    o.w = pack2(tile[(kc * 8 + 6) * 65 + nn], tile[(kc * 8 + 7) * 65 + nn]);
    *(uint4*)(d.dst + (size_t)(d.ndt * 64 + nn) * d.K + d.kt * 64 + kc * 8) = o;
  }
  lds_barrier();
}
__device__ __attribute__((always_inline)) void convert_all(PC p, int l, unsigned char* smem) {
  const int nb = NBLK();
  int t = BID();
  if (t >= NCONV_TILES) return;
  __syncthreads();
  float cur[8], nxt[8];
  conv_load(conv_desc(p, l, t), cur);
#pragma unroll 1
  for (; t < NCONV_TILES; t += nb) {
    const int tn = (t + nb < NCONV_TILES) ? t + nb : t;
    conv_load(conv_desc(p, l, tn), nxt);
    conv_store(conv_desc(p, l, t), cur, smem);
#pragma unroll
    for (int i = 0; i < 8; ++i) cur[i] = nxt[i];
  }
  __syncthreads();
}

__device__ __attribute__((always_inline)) void adaln_pass(PC p, int l, int sub, const float* xlat, const float* xctx, int ntok) {
  const int lane = TID() & 63, wave = TID() >> 6;
  const float* nw = p->in[I_NORMW] + (l * 3 + sub) * 1024;
  const float* mod = (const float*)(p->ws + OFF_MOD) + (size_t)l * 9 * 9216;
  u16* H = (u16*)(p->ws + OFF_H);
  for (int tok = BID() * 8 + wave; tok < ntok; tok += NBLK() * 8) {
    const float* src = tok < TL ? xlat + (size_t)tok * 1024 : xctx + (size_t)(tok - TL) * 1024;
    const int r = tok < TL ? (tok >> 11) : 8;
    const float* sh = mod + (size_t)r * 9216 + (3 * sub) * 1024;
    const float* sc = sh + 1024;
    float4 v[4];
    float ss = 0.f;
#pragma unroll
    for (int i = 0; i < 4; ++i) {
      v[i] = *(const float4*)(src + i * 256 + lane * 4);
      ss += v[i].x * v[i].x + v[i].y * v[i].y + v[i].z * v[i].z + v[i].w * v[i].w;
    }
    ss = wave_sum(ss);
    const float rinv = rsqrtf(ss * (1.f / 1024.f) + 1e-6f);
#pragma unroll
    for (int i = 0; i < 4; ++i) {
      const int c = i * 256 + lane * 4;
      float4 w4 = *(const float4*)(nw + c), s4 = *(const float4*)(sc + c), h4 = *(const float4*)(sh + c);
      float a = v[i].x * rinv * w4.x * (1.f + s4.x) + h4.x;
      float b = v[i].y * rinv * w4.y * (1.f + s4.y) + h4.y;
      float c2 = v[i].z * rinv * w4.z * (1.f + s4.z) + h4.z;
      float d = v[i].w * rinv * w4.w * (1.f + s4.w) + h4.w;
      uint2 o; o.x = pack2(a, b); o.y = pack2(c2, d);
      *(uint2*)(H + (size_t)tok * 1024 + c) = o;
    }
  }
}

struct Epi {
  u16* outb; const float* xs_lat; const float* xs_ctx; float* xd_lat; float* xd_ctx; const float* gate; float coef;
};
template <int MODE, int BM = 256>
__device__ __attribute__((always_inline)) void gemm_phase(const u16* __restrict__ A, int lda, const u16* __restrict__ Bt, int K, int M, int N, Epi e, unsigned char* smem, int vbid, int row0 = 0, int col0 = 0) {
  constexpr int BUF = (256 + 128) * 72;
  constexpr int MI = BM / 64;
  constexpr int WM = BM / 4;
  u16* L = (u16*)smem;
  const int tid = TID(), lane = tid & 63, wave = tid >> 6, wm = wave >> 1, wn = wave & 1;
  const int nMt = M / BM, nNt = N / 128, ntiles = nMt * nNt, nk = K / 64;
  const int lrow = tid >> 3, lch = tid & 7;
  const int fr = lane & 15, fq = lane >> 4;
  const int nb_ = NBLK();
  const bool swz = (vbid >= 0) && (nb_ == 256) && (nMt % 8 == 0) && (nNt % 4 == 0);
  int bid_ = swz ? vbid : BID();
  asm volatile("" : "+s"(bid_));
  const int nPM = nMt >> 3, npatch = nPM * (nNt >> 2);
  for (int it = 0;; ++it) {
    int mt, nt;
    if (swz) {
      const int pi = it * 8 + (bid_ & 7);
      if (pi >= npatch) break;
      mt = (pi % nPM) * 8 + ((bid_ >> 3) & 7);
      nt = (pi / nPM) * 4 + (bid_ >> 6);
    } else {
      const int tile = bid_ + it * nb_;
      if (tile >= ntiles) break;
      mt = tile % nMt; nt = tile / nMt;
    }
    const int m0 = row0 + mt * BM, n0 = col0 + nt * 128;
    f32x4 acc[MI][4];
#pragma unroll
    for (int i = 0; i < MI; ++i)
#pragma unroll
      for (int j = 0; j < 4; ++j) acc[i][j] = (f32x4){0.f, 0.f, 0.f, 0.f};
    const u16* Ap = A + (size_t)(m0 + lrow) * lda + lch * 8;
    const u16* Bp = Bt + (size_t)(n0 + lrow) * K + lch * 8;
    u32x4 ra0[MI], rb0[2], ra1[MI], rb1[2];
#define G_LOAD(RA, RB, KT) do { const int ko_ = (KT) * 64; \
      _Pragma("unroll") for (int i = 0; i < MI; ++i) RA[i] = *(const u32x4*)(Ap + (size_t)(i * 64) * lda + ko_); \
      _Pragma("unroll") for (int i = 0; i < 2; ++i) RB[i] = *(const u32x4*)(Bp + (size_t)(i * 64) * K + ko_); } while (0)
#define L_STORE(RA, RB, BUFI) do { u16* W_ = L + (BUFI) * BUF; \
      _Pragma("unroll") for (int i = 0; i < MI; ++i) *(u32x4*)(W_ + (lrow + i * 64) * 72 + lch * 8) = RA[i]; \
      _Pragma("unroll") for (int i = 0; i < 2; ++i) *(u32x4*)(W_ + 256 * 72 + (lrow + i * 64) * 72 + lch * 8) = RB[i]; } while (0)
#define FRAGS(AF, BF, BUFI, KS) do { const u16* As = L + (BUFI) * BUF; const u16* Bs = As + 256 * 72; \
      _Pragma("unroll") for (int mi = 0; mi < MI; ++mi) AF[mi] = *(const bf16x8*)(As + (wm * WM + mi * 16 + fr) * 72 + (KS) * 32 + fq * 8); \
      _Pragma("unroll") for (int ni = 0; ni < 4; ++ni) BF[ni] = *(const bf16x8*)(Bs + (wn * 64 + ni * 16 + fr) * 72 + (KS) * 32 + fq * 8); } while (0)
#define MMA16(AF, BF) do { \
      _Pragma("unroll") for (int mi = 0; mi < MI; ++mi) \
        _Pragma("unroll") for (int ni = 0; ni < 4; ++ni) acc[mi][ni] = __builtin_amdgcn_mfma_f32_16x16x32_bf16(BF[ni], AF[mi], acc[mi][ni], 0, 0, 0); } while (0)
#define KSTEP(BUFI, RA, RB, NBUFI) do { \
      bf16x8 af0[MI], bf0[4], af1[MI], bf1[4]; \
      FRAGS(af0, bf0, BUFI, 0); \
      __builtin_amdgcn_sched_barrier(0); \
      FRAGS(af1, bf1, BUFI, 1); \
      MMA16(af0, bf0); \
      if (MI >= 3) { _Pragma("unroll") for (int q_ = 0; q_ < MI * 2; ++q_) { __builtin_amdgcn_sched_group_barrier(0x008, 2, 0); __builtin_amdgcn_sched_group_barrier(0x100, 1, 0); } } \
      if (MI == 3) __builtin_amdgcn_sched_group_barrier(0x100, 1, 0); \
      __builtin_amdgcn_sched_barrier(0); \
      L_STORE(RA, RB, NBUFI); \
      MMA16(af1, bf1); \
      if (MI >= 3) { _Pragma("unroll") for (int q_ = 0; q_ < MI + 2; ++q_) { __builtin_amdgcn_sched_group_barrier(0x008, 2, 0); __builtin_amdgcn_sched_group_barrier(0x200, 1, 0); } \
        __builtin_amdgcn_sched_group_barrier(0x008, (MI >= 3) ? MI * 4 - 2 * (MI + 2) : 0, 0); } \
      __builtin_amdgcn_sched_barrier(0); \
      } while (0)
    G_LOAD(ra0, rb0, 0);
    G_LOAD(ra1, rb1, 1);
    __syncthreads();
    L_STORE(ra0, rb0, 0);
    __syncthreads();
    for (int kt = 0; kt < nk; kt += 2) {
      G_LOAD(ra0, rb0, min(kt + 2, nk - 1));
      KSTEP(0, ra1, rb1, 1);
      lds_barrier();
      G_LOAD(ra1, rb1, min(kt + 3, nk - 1));
      KSTEP(1, ra0, rb0, 0);
      lds_barrier();
    }
    asm volatile("s_waitcnt vmcnt(0)" ::: "memory");
#undef FRAGS
#undef MMA16
#undef KSTEP
#undef G_LOAD
#undef L_STORE
    if (MODE == 0) {
#pragma unroll
      for (int mi = 0; mi < MI; ++mi) {
        const int tok = m0 + wm * WM + mi * 16 + fr;
#pragma unroll
        for (int np = 0; np < 2; ++np) {
          const int ffc = ((n0 + wn * 64) >> 1) + np * 16 + fq * 4;
          const f32x4 g = acc[mi][np * 2], u = acc[mi][np * 2 + 1];
          uint2 o;
          o.x = pack2(siluf_(g[0]) * u[0], siluf_(g[1]) * u[1]);
          o.y = pack2(siluf_(g[2]) * u[2], siluf_(g[3]) * u[3]);
          *(uint2*)(e.outb + (size_t)tok * DFF + ffc) = o;
        }
      }
    } else if (MODE == 1) {
#pragma unroll
      for (int mi = 0; mi < MI; ++mi) {
        const int tok = m0 + wm * WM + mi * 16 + fr;
        const bool isctx = tok >= TL;
        const int r = isctx ? 8 : (tok >> 11);
        const float* xs = isctx ? e.xs_ctx + (size_t)(tok - TL) * 1024 : e.xs_lat + (size_t)tok * 1024;
        float* xd = isctx ? e.xd_ctx + (size_t)(tok - TL) * 1024 : e.xd_lat + (size_t)tok * 1024;
        const float* g = e.gate + (size_t)r * 9216;
#pragma unroll
        for (int ni = 0; ni < 4; ++ni) {
          const int col = n0 + wn * 64 + ni * 16 + fq * 4;
          const float4 gv = *(const float4*)(g + col);
          const float4 xv = *(const float4*)(xs + col);
          float4 o;
          o.x = xv.x + gv.x * e.coef * acc[mi][ni][0];
          o.y = xv.y + gv.y * e.coef * acc[mi][ni][1];
          o.z = xv.z + gv.z * e.coef * acc[mi][ni][2];
          o.w = xv.w + gv.w * e.coef * acc[mi][ni][3];
          *(float4*)(xd + col) = o;
        }
        __builtin_amdgcn_sched_barrier(0);
      }
    } else {
#pragma unroll
      for (int mi = 0; mi < MI; ++mi) {
        const int tok = m0 + wm * WM + mi * 16 + fr;
#pragma unroll
        for (int ni = 0; ni < 4; ++ni) {
          const int col = n0 + wn * 64 + ni * 16 + fq * 4;
          uint2 o;
          o.x = pack2(acc[mi][ni][0], acc[mi][ni][1]);
          o.y = pack2(acc[mi][ni][2], acc[mi][ni][3]);
          *(uint2*)(e.outb + (size_t)tok * PS + col) = o;
        }
      }
    }
  }
}

template <int MODE>
__device__ __attribute__((always_inline)) void gemm_phase_big(const u16* __restrict__ A, int lda, const u16* __restrict__ Bt, int K, int M, int N, Epi e, unsigned char* smem, int tile_limit = 1 << 30) {
  constexpr int BUF = 512 * 72;
  u16* L = (u16*)smem;
  const int tid = TID(), lane = tid & 63, wave = tid >> 6, wm = wave >> 1, wn = wave & 1;
  const int nMt = M / 256, nNt = N / 256, ntiles = nMt * nNt, nk = K / 64;
  const int lrow = tid >> 3, lch = tid & 7;
  const int fr = lane & 15, fq = lane >> 4;
  const int nb_ = NBLK();
  const int tend = min(ntiles, tile_limit);
  for (int tile = BID(); tile < tend; tile += nb_) {
    const int mt = tile % nMt, nt = tile / nMt;
    const int m0 = mt * 256, n0 = nt * 256;
    f32x4 acc[4][8];
#pragma unroll
    for (int i = 0; i < 4; ++i)
#pragma unroll
      for (int j = 0; j < 8; ++j) acc[i][j] = (f32x4){0.f, 0.f, 0.f, 0.f};
    const u16* Ap = A + (size_t)(m0 + lrow) * lda + lch * 8;
    const u16* Bp = Bt + (size_t)(n0 + lrow) * K + lch * 8;
    u32x4 ra[4], rb[4];
#define G_LOADB(KT) do { const int ko_ = (KT) * 64; \
      _Pragma("unroll") for (int i = 0; i < 4; ++i) ra[i] = *(const u32x4*)(Ap + (size_t)(i * 64) * lda + ko_); \
      _Pragma("unroll") for (int i = 0; i < 4; ++i) rb[i] = *(const u32x4*)(Bp + (size_t)(i * 64) * K + ko_); } while (0)
#define L_STOREB(BUFI) do { u16* W_ = L + (BUFI) * BUF; \
      _Pragma("unroll") for (int i = 0; i < 4; ++i) *(u32x4*)(W_ + (lrow + i * 64) * 72 + lch * 8) = ra[i]; \
      _Pragma("unroll") for (int i = 0; i < 4; ++i) *(u32x4*)(W_ + 256 * 72 + (lrow + i * 64) * 72 + lch * 8) = rb[i]; } while (0)
    G_LOADB(0);
    __syncthreads();
    L_STOREB(0);
    G_LOADB(min(1, nk - 1));
    __syncthreads();
#define FRAGSB(KS) do { \
        _Pragma("unroll") for (int mi = 0; mi < 4; ++mi) af[mi] = *(const bf16x8*)(As + (wm * 64 + mi * 16 + fr) * 72 + (KS) * 32 + fq * 8); \
        _Pragma("unroll") for (int ni = 0; ni < 8; ++ni) bfr[ni] = *(const bf16x8*)(Bs + (wn * 128 + ni * 16 + fr) * 72 + (KS) * 32 + fq * 8); } while (0)
#define MMAB() do { \
        _Pragma("unroll") for (int ni = 0; ni < 8; ++ni) \
          _Pragma("unroll") for (int mi = 0; mi < 4; ++mi) acc[mi][ni] = __builtin_amdgcn_mfma_f32_16x16x32_bf16(bfr[ni], af[mi], acc[mi][ni], 0, 0, 0); } while (0)
    for (int kt = 0; kt < nk; ++kt) {
      const u16* As = L + (kt & 1) * BUF;
      const u16* Bs = As + 256 * 72;
      bf16x8 af[4], bfr[8];
      FRAGSB(0);
      __builtin_amdgcn_sched_barrier(0);
      MMAB();
      L_STOREB((kt + 1) & 1);
#pragma unroll
      for (int q_ = 0; q_ < 8; ++q_) { __builtin_amdgcn_sched_group_barrier(0x008, 4, 0); __builtin_amdgcn_sched_group_barrier(0x200, 1, 0); }
      __builtin_amdgcn_sched_barrier(0);
      G_LOADB(min(kt + 2, nk - 1));
      FRAGSB(1);
      __builtin_amdgcn_sched_barrier(0);
      MMAB();
      __builtin_amdgcn_sched_barrier(0);
      lds_barrier();
    }
#undef FRAGSB
#undef MMAB
    asm volatile("s_waitcnt vmcnt(0)" ::: "memory");
#undef G_LOADB
#undef L_STOREB
    if (MODE == 0) {
#pragma unroll
      for (int mi = 0; mi < 4; ++mi) {
        const int tok = m0 + wm * 64 + mi * 16 + fr;
#pragma unroll
        for (int np = 0; np < 4; ++np) {
          const int ffc = ((n0 + wn * 128) >> 1) + np * 16 + fq * 4;
          const f32x4 g = acc[mi][np * 2], u = acc[mi][np * 2 + 1];
          uint2 o;
          o.x = pack2(siluf_(g[0]) * u[0], siluf_(g[1]) * u[1]);
          o.y = pack2(siluf_(g[2]) * u[2], siluf_(g[3]) * u[3]);
          *(uint2*)(e.outb + (size_t)tok * DFF + ffc) = o;
        }
      }
    } else if (MODE == 1) {
#pragma unroll
      for (int mi = 0; mi < 4; ++mi) {
        const int tok = m0 + wm * 64 + mi * 16 + fr;
        const bool isctx = tok >= TL;
        const int r = isctx ? 8 : (tok >> 11);
        const float* xs = isctx ? e.xs_ctx + (size_t)(tok - TL) * 1024 : e.xs_lat + (size_t)tok * 1024;
        float* xd = isctx ? e.xd_ctx + (size_t)(tok - TL) * 1024 : e.xd_lat + (size_t)tok * 1024;
        const float* g = e.gate + (size_t)r * 9216;
#pragma unroll
        for (int ni = 0; ni < 8; ++ni) {
          const int col = n0 + wn * 128 + ni * 16 + fq * 4;
          const float4 gv = *(const float4*)(g + col);
          const float4 xv = *(const float4*)(xs + col);
          float4 o;
          o.x = xv.x + gv.x * e.coef * acc[mi][ni][0];
          o.y = xv.y + gv.y * e.coef * acc[mi][ni][1];
          o.z = xv.z + gv.z * e.coef * acc[mi][ni][2];
          o.w = xv.w + gv.w * e.coef * acc[mi][ni][3];
          *(float4*)(xd + col) = o;
        }
        __builtin_amdgcn_sched_barrier(0);
      }
    } else {
#pragma unroll
      for (int mi = 0; mi < 4; ++mi) {
        const int tok = m0 + wm * 64 + mi * 16 + fr;
#pragma unroll
        for (int ni = 0; ni < 8; ++ni) {
          const int col = n0 + wn * 128 + ni * 16 + fq * 4;
          uint2 o;
          o.x = pack2(acc[mi][ni][0], acc[mi][ni][1]);
          o.y = pack2(acc[mi][ni][2], acc[mi][ni][3]);
          *(uint2*)(e.outb + (size_t)tok * PS + col) = o;
        }
      }
    }
  }
}

__device__ __attribute__((always_inline)) void prep_task(PC p, int l, int task, unsigned char* smem) {
  float* raw = (float*)smem;
  float* sv = raw + 34 * 64;
  const int tid = TID();
  const u16* slab = (const u16*)(p->ws + OFF_SLAB);
  const int tok0 = task * 32;
  int base, n;
  if (tok0 < TL) { base = (tok0 >> 11) << 11; n = 2048; } else { base = TL + (((tok0 - TL) >> 8) << 8); n = 256; }
  const int pos0 = tok0 - base;
  for (int i = tid; i < 34 * 64; i += 512) {
    int rr = i >> 6, j = i & 63, pos = pos0 - 1 + rr;
    raw[i] = (pos >= 0 && pos < n) ? bf2f(slab[(size_t)(base + pos) * PS + RW_OFF + 768 + j]) : 0.f;
  }
  __syncthreads();
  const float* mu = p->in[I_RWMU] + l * 2 * 896;
  for (int i = tid; i < 32 * 64; i += 512) {
    int t = i >> 6, j = i & 63;
    float u = raw[(t + 1) * 64 + j], pv = raw[t * 64 + j], nx = raw[(t + 2) * 64 + j];
    float s = u + mu[768 + j] * (pv - u) + mu[896 + 768 + j] * (nx - u);
    if (j < 32) s = tanhf(s);
    sv[i] = s;
  }
  __syncthreads();
  {
    const int c = tid & 255, d = tid >> 8;
    const float* wup = p->in[I_RWWUP] + (size_t)(l * 2 + d) * 32 * 256 + c;
    const float* aup = p->in[I_RWAUP] + (size_t)(l * 2 + d) * 32 * 256 + c;
    float wu[32], au[32];
#pragma unroll
    for (int j = 0; j < 32; ++j) { wu[j] = wup[j * 256]; au[j] = aup[j * 256]; }
    u16* rwl = (u16*)(p->ws + OFF_RWL);
    const float rw_w0 = p->in[I_RWW0][(l * 2 + d) * 256 + c], rw_a0 = p->in[I_RWA0][(l * 2 + d) * 256 + c];
#pragma unroll 2
    for (int t = 0; t < 32; ++t) {
      float aw = 0.f, aa = 0.f;
#pragma unroll
      for (int q = 0; q < 8; ++q) {
        float4 x = *(const float4*)(sv + t * 64 + q * 4);
        float4 y = *(const float4*)(sv + t * 64 + 32 + q * 4);
        aw = fmaf(x.x, wu[q * 4], aw); aw = fmaf(x.y, wu[q * 4 + 1], aw); aw = fmaf(x.z, wu[q * 4 + 2], aw); aw = fmaf(x.w, wu[q * 4 + 3], aw);
        aa = fmaf(y.x, au[q * 4], aa); aa = fmaf(y.y, au[q * 4 + 1], aa); aa = fmaf(y.z, au[q * 4 + 2], aa); aa = fmaf(y.w, au[q * 4 + 3], aa);
      }
      const float zz = -(rw_w0 + aw);
      const float sp = zz > 20.f ? zz : __logf(1.f + __expf(zz));
      rwl[(size_t)(tok0 + t) * 1024 + d * 512 + c] = f2bf(__expf(-sp - 0.5f));
      rwl[(size_t)(tok0 + t) * 1024 + d * 512 + 256 + c] = f2bf(sigmoidf_(rw_a0 + aa));
    }
  }
  {
    const float* hc = p->in[I_HYCONV] + l * 3 * 768;
    u16* hxt = (u16*)(p->ws + OFF_HXT);
#pragma unroll 1
    for (int cidx = tid; cidx < 768; cidx += 512) {
      const float w0 = hc[cidx], w1 = hc[768 + cidx], w2 = hc[1536 + cidx];
      float pv = pos0 > 0 ? bf2f(slab[(size_t)(tok0 - 1) * PS + cidx]) : 0.f;
      float cur = bf2f(slab[(size_t)tok0 * PS + cidx]);
      unsigned pk[16];
#pragma unroll
      for (int t = 0; t < 32; t += 2) {
        float nx0 = (pos0 + t + 1 < n) ? bf2f(slab[(size_t)(tok0 + t + 1) * PS + cidx]) : 0.f;
        float v0 = w0 * pv + w1 * cur + w2 * nx0;
        float nx1 = (pos0 + t + 2 < n) ? bf2f(slab[(size_t)(tok0 + t + 2) * PS + cidx]) : 0.f;
        float v1 = w0 * cur + w1 * nx0 + w2 * nx1;
        pk[t >> 1] = pack2(v0, v1);
        pv = nx0; cur = nx1;
      }
      uint4* dst = (uint4*)(hxt + (size_t)cidx * TT + tok0);
      dst[0] = make_uint4(pk[0], pk[1], pk[2], pk[3]);
      dst[1] = make_uint4(pk[4], pk[5], pk[6], pk[7]);
      dst[2] = make_uint4(pk[8], pk[9], pk[10], pk[11]);
      dst[3] = make_uint4(pk[12], pk[13], pk[14], pk[15]);
    }
  }
  __syncthreads();
}

typedef float f32x2 __attribute__((ext_vector_type(2)));
DEV float quad_sum(float x) {
  x += __builtin_bit_cast(float, __builtin_amdgcn_update_dpp(0, __builtin_bit_cast(int, x), 0xB1, 0xf, 0xf, true));
  x += __builtin_bit_cast(float, __builtin_amdgcn_update_dpp(0, __builtin_bit_cast(int, x), 0x4E, 0xf, 0xf, true));
  return x;
}
constexpr int DN_STRIDE = 200, RW_STRIDE = 392, CHUNK = 16, NCHUNK = 2304 / CHUNK;
DEV void ld16(f32x2* o, const float* d) {
#pragma unroll
  for (int i = 0; i < 4; ++i) {
    float4 a = *(const float4*)(d + i * 4);
    o[2 * i] = (f32x2){a.x, a.y};
    o[2 * i + 1] = (f32x2){a.z, a.w};
  }
}
struct DnOps { f32x2 q[8], k[8]; float vv, a, be, kq; };
DEV void dn_load(DnOps& o, const float* d, int kp, int col) {
  ld16(o.q, d + kp * 16); ld16(o.k, d + 64 + kp * 16);
  o.vv = d[128 + col]; o.a = d[192]; o.be = d[193]; o.kq = d[194];
}
DEV float dn_step(f32x2* S, const DnOps& c) {
  f32x2 a1 = (f32x2){0.f, 0.f}, a2 = (f32x2){0.f, 0.f};
#pragma unroll
  for (int i = 0; i < 8; ++i) { a1 = __builtin_elementwise_fma(S[i], c.k[i], a1); a2 = __builtin_elementwise_fma(S[i], c.q[i], a2); }
  const float dk = quad_sum(a1.x + a1.y), dq = quad_sum(a2.x + a2.y);
  const float cc = c.be * (c.vv - c.a * dk);
  const f32x2 a2v = (f32x2){c.a, c.a}, c2v = (f32x2){cc, cc};
#pragma unroll
  for (int i = 0; i < 8; ++i) { S[i] = S[i] * a2v; S[i] = __builtin_elementwise_fma(c.k[i], c2v, S[i]); }
  return c.a * dq + cc * c.kq;
}
struct RwOps { f32x2 wr[8], w[8], kd[8], av[8], bv[8]; float vv, s1, s2; };
DEV void rw_load(RwOps& o, const float* d, int kp, int col) {
  ld16(o.wr, d + kp * 16); ld16(o.w, d + 64 + kp * 16); ld16(o.kd, d + 128 + kp * 16); ld16(o.av, d + 192 + kp * 16); ld16(o.bv, d + 256 + kp * 16);
  o.vv = d[320 + col]; o.s1 = d[384]; o.s2 = d[385];
}
DEV float rw_step(f32x2* S, const RwOps& c) {
  f32x2 a1 = (f32x2){0.f, 0.f}, a2 = (f32x2){0.f, 0.f};
#pragma unroll
  for (int i = 0; i < 8; ++i) { a1 = __builtin_elementwise_fma(S[i], c.av[i], a1); a2 = __builtin_elementwise_fma(S[i], c.wr[i], a2); }
  const float sa = quad_sum(a1.x + a1.y), yp = quad_sum(a2.x + a2.y);
  const f32x2 sa2 = (f32x2){sa, sa}, v2 = (f32x2){c.vv, c.vv};
#pragma unroll
  for (int i = 0; i < 8; ++i) { S[i] = S[i] * c.w[i]; S[i] = __builtin_elementwise_fma(sa2, c.bv[i], S[i]); S[i] = __builtin_elementwise_fma(v2, c.kd[i], S[i]); }
  return yp + sa * c.s1 + c.vv * c.s2;
}

DEV float wave_allsum_dpp(float x) {
  x += __builtin_bit_cast(float, __builtin_amdgcn_update_dpp(0, __builtin_bit_cast(int, x), 0xB1, 0xf, 0xf, true));
  x += __builtin_bit_cast(float, __builtin_amdgcn_update_dpp(0, __builtin_bit_cast(int, x), 0x4E, 0xf, 0xf, true));
  x += __builtin_bit_cast(float, __builtin_amdgcn_update_dpp(0, __builtin_bit_cast(int, x), 0x124, 0xf, 0xf, true));
  x += __builtin_bit_cast(float, __builtin_amdgcn_update_dpp(0, __builtin_bit_cast(int, x), 0x128, 0xf, 0xf, true));
  return allred_rows(x);
}
DEV float softplus_fast(float x) { return x > 20.f ? x : __logf(1.f + __expf(x)); }

DEV float oct_sum(float x) {
  x += __builtin_bit_cast(float, __builtin_amdgcn_update_dpp(0, __builtin_bit_cast(int, x), 0xB1, 0xf, 0xf, true));
  x += __builtin_bit_cast(float, __builtin_amdgcn_update_dpp(0, __builtin_bit_cast(int, x), 0x4E, 0xf, 0xf, true));
  x += __builtin_bit_cast(float, __builtin_amdgcn_update_dpp(0, __builtin_bit_cast(int, x), 0x141, 0xf, 0xf, true));
  return x;
}
DEV void ld8(f32x2* o, const float* d) {
#pragma unroll
  for (int i = 0; i < 2; ++i) {
    float4 a = *(const float4*)(d + i * 4);
    o[2 * i] = (f32x2){a.x, a.y};
    o[2 * i + 1] = (f32x2){a.z, a.w};
  }
}
struct RwOps8 { f32x2 wr[4], w[4], kd[4], av[4], bv[4]; float vv, s1, s2; };
DEV void rw_load8(RwOps8& o, const float* d, int kp, int row) {
  ld8(o.wr, d + kp * 8); ld8(o.w, d + 64 + kp * 8); ld8(o.kd, d + 128 + kp * 8); ld8(o.av, d + 192 + kp * 8); ld8(o.bv, d + 256 + kp * 8);
  o.vv = d[320 + row]; o.s1 = d[384]; o.s2 = d[385];
}
DEV float rw_step8(f32x2* S, const RwOps8& c) {
  f32x2 a1 = (f32x2){0.f, 0.f}, a2 = (f32x2){0.f, 0.f};
#pragma unroll
  for (int i = 0; i < 4; ++i) { a1 = __builtin_elementwise_fma(S[i], c.av[i], a1); a2 = __builtin_elementwise_fma(S[i], c.wr[i], a2); }
  const float sa = oct_sum(a1.x + a1.y), yp = oct_sum(a2.x + a2.y);
  const f32x2 sa2 = (f32x2){sa, sa}, v2 = (f32x2){c.vv, c.vv};
#pragma unroll
  for (int i = 0; i < 4; ++i) { S[i] = S[i] * c.w[i]; S[i] = __builtin_elementwise_fma(sa2, c.bv[i], S[i]); S[i] = __builtin_elementwise_fma(v2, c.kd[i], S[i]); }
  return yp + sa * c.s1 + c.vv * c.s2;
}

struct DnRaw { uint4 c[3], pv[3], nx[3]; unsigned xa, xb; float fp, fn; };
DEV void dn_prep_load(DnRaw& R, PC p, int b, int hd, int dir, int ci) {
  const int ptid = TID() - 256;
  const u16* slab = (const u16*)(p->ws + OFF_SLAB);
  const int st = (ptid >> 3) & 15, g = ptid & 7;
  int pos, n;
  const int tok = step_tok(b, dir, ci * CHUNK + st, pos, n);
  const int tp = pos > 0 ? tok - 1 : tok, tn = pos < n - 1 ? tok + 1 : tok;
  R.fp = pos > 0 ? 1.f : 0.f; R.fn = pos < n - 1 ? 1.f : 0.f;
#pragma unroll
  for (int v3 = 0; v3 < 3; ++v3) {
    const int col = DN_OFF + v3 * 256 + hd * 64 + g * 8;
    R.c[v3] = *(const uint4*)(slab + (size_t)tok * PS + col);
    R.pv[v3] = *(const uint4*)(slab + (size_t)tp * PS + col);
    R.nx[v3] = *(const uint4*)(slab + (size_t)tn * PS + col);
  }
  int pos2, n2;
  const int tok2 = step_tok(b, dir, ci * CHUNK + (ptid & 15), pos2, n2);
  R.xb = slab[(size_t)tok2 * PS + DN_OFF + 1024 + dir * 8 + hd];
  R.xa = slab[(size_t)tok2 * PS + DN_OFF + 1024 + dir * 8 + 4 + hd];
}
DEV void dn_prep_compute(const DnRaw& R, float* dst, const float* cw, float Aexp, float dtb) {
  const int ptid = TID() - 256;
  if (ptid < 128) {
    const int st = ptid >> 3, g = ptid & 7;
    float res[3][8];
    float ssq = 0.f, ssk = 0.f, qk = 0.f;
#pragma unroll
    for (int v3 = 0; v3 < 3; ++v3) {
      float cur[8], pv[8], nx[8];
      unpack8(R.c[v3], cur); unpack8(R.pv[v3], pv); unpack8(R.nx[v3], nx);
      const float* c0 = cw + v3 * 64 + g * 8;
#pragma unroll
      for (int e = 0; e < 8; ++e) res[v3][e] = siluf_(c0[e] * R.fp * pv[e] + c0[192 + e] * cur[e] + c0[384 + e] * R.fn * nx[e]);
    }
#pragma unroll
    for (int e = 0; e < 8; ++e) { ssq += res[0][e] * res[0][e]; ssk += res[1][e] * res[1][e]; qk += res[0][e] * res[1][e]; }
    ssq += __shfl_xor(ssq, 1); ssq += __shfl_xor(ssq, 2); ssq += __shfl_xor(ssq, 4);
    ssk += __shfl_xor(ssk, 1); ssk += __shfl_xor(ssk, 2); ssk += __shfl_xor(ssk, 4);
    qk += __shfl_xor(qk, 1); qk += __shfl_xor(qk, 2); qk += __shfl_xor(qk, 4);
    const float scq = rsqrtf(ssq + 1e-6f) * 0.125f, sck = rsqrtf(ssk + 1e-6f);
    float* d = dst + st * DN_STRIDE + g * 8;
    *(float4*)d = make_float4(res[0][0] * scq, res[0][1] * scq, res[0][2] * scq, res[0][3] * scq);
    *(float4*)(d + 4) = make_float4(res[0][4] * scq, res[0][5] * scq, res[0][6] * scq, res[0][7] * scq);
    *(float4*)(d + 64) = make_float4(res[1][0] * sck, res[1][1] * sck, res[1][2] * sck, res[1][3] * sck);
    *(float4*)(d + 68) = make_float4(res[1][4] * sck, res[1][5] * sck, res[1][6] * sck, res[1][7] * sck);
    *(float4*)(d + 128) = make_float4(res[2][0], res[2][1], res[2][2], res[2][3]);
    *(float4*)(d + 132) = make_float4(res[2][4], res[2][5], res[2][6], res[2][7]);
    if (g == 0) dst[st * DN_STRIDE + 194] = qk * scq * sck;
  } else if (ptid < 128 + CHUNK) {
    const int st = ptid - 128;
    const float g = -Aexp * softplus_fast(bf2f((u16)R.xa) + dtb);
    dst[st * DN_STRIDE + 192] = __expf(g);
    dst[st * DN_STRIDE + 193] = sigmoidf_(bf2f((u16)R.xb));
  }
}

__device__ __attribute__((always_inline)) void dn_scan_unit(PC p, int l, int unit, unsigned char* smem, const int MODE = 7) {
  const int b = unit >> 3, hd = (unit >> 1) & 3, dir = unit & 1;
  float* buf = (float*)smem;
  float* cw = buf + 2 * CHUNK * DN_STRIDE + 64;
  const int tid = TID(), wave = tid >> 6, lane = tid & 63;
  __syncthreads();
  for (int i = tid; i < 576; i += 512) {
    int tap = i / 192, rem = i % 192, v3 = rem >> 6, d = rem & 63;
    cw[i] = p->in[I_DNCONV][(l * 3 + tap) * 768 + v3 * 256 + hd * 64 + d];
  }
  const float Aexp = __expf(p->in[I_DNALOG][l * 8 + dir * 4 + hd]);
  const float dtb = p->in[I_DNDT][l * 8 + dir * 4 + hd];
  u16* dno = (u16*)(p->ws + OFF_DNO) + (size_t)dir * TT * 256;
  __syncthreads();
  f32x2 S[8];
#pragma unroll
  for (int j = 0; j < 8; ++j) S[j] = (f32x2){0.f, 0.f};
  const int kp = lane & 3, col = (wave & 3) * 16 + (lane >> 2);
  DnRaw R0, R1;
  if (wave >= 4) {
    dn_prep_load(R0, p, b, hd, dir, 0); dn_prep_compute(R0, buf, cw, Aexp, dtb);
    dn_prep_load(R0, p, b, hd, dir, 1); dn_prep_load(R1, p, b, hd, dir, 2);
  }
  __syncthreads();
#define DN_SCAN_CHUNK(CI) do { \
      const float* bb = buf + ((CI) & 1) * CHUNK * DN_STRIDE; \
      int pos, n; \
      const int tok0 = step_tok(b, dir, (CI) * CHUNK, pos, n); \
      const int tstep = dir ? -1 : 1; \
      u16* op = dno + (size_t)tok0 * 256 + hd * 64 + col; \
      DnOps A, B; \
      dn_load(A, bb, kp, col); \
      _Pragma("unroll 1") for (int st = 0; st < CHUNK; st += 2) { \
        dn_load(B, bb + (st + 1) * DN_STRIDE, kp, col); \
        const float o0 = dn_step(S, A); \
        if ((MODE & 1) && kp == 0) op[(ptrdiff_t)(st * tstep) * 256] = f2bf(o0); sink += o0; \
        dn_load(A, bb + (st + 2) * DN_STRIDE, kp, col); \
        const float o1 = dn_step(S, B); \
        if ((MODE & 1) && kp == 0) op[(ptrdiff_t)((st + 1) * tstep) * 256] = f2bf(o1); sink += o1; \
      } } while (0)
  float sink = 0.f;
  if (wave >= 4 && !(MODE & 2)) {
#pragma unroll 1
    for (int ci = 0; ci < NCHUNK; ci += 2) { lds_barrier(); lds_barrier(); }
  } else if (wave < 4 && !(MODE & 4)) {
#pragma unroll 1
    for (int ci = 0; ci < NCHUNK; ci += 2) { lds_barrier(); lds_barrier(); }
  } else if (wave >= 4) {
#pragma unroll 1
    for (int ci = 0; ci < NCHUNK; ci += 2) {
      dn_prep_compute(R0, buf + CHUNK * DN_STRIDE, cw, Aexp, dtb);
      dn_prep_load(R0, p, b, hd, dir, min(ci + 3, NCHUNK - 1));
      lds_barrier();
      if (ci + 2 < NCHUNK) dn_prep_compute(R1, buf, cw, Aexp, dtb);
      dn_prep_load(R1, p, b, hd, dir, min(ci + 4, NCHUNK - 1));
      lds_barrier();
    }
  } else {
#pragma unroll 1
    for (int ci = 0; ci < NCHUNK; ci += 2) {
      DN_SCAN_CHUNK(ci);
      lds_barrier();
      DN_SCAN_CHUNK(ci + 1);
      lds_barrier();
    }
    if (!(MODE & 1) && sink == 12345.678f) dno[col] = f2bf(sink);
  }
  asm volatile("s_waitcnt vmcnt(0)" ::: "memory");
  __syncthreads();
}

struct RwRaw { unsigned u[3][6]; unsigned wl[4], al[4]; unsigned vmask; };
DEV void rw_prep_load(RwRaw& R, PC p, int b, int hd, int dir, int ci, int pw) {
  const int lane = TID() & 63;
  const u16* slab = (const u16*)(p->ws + OFF_SLAB);
  const u16* rwl = (const u16*)(p->ws + OFF_RWL);
  const int ch = hd * 64 + lane;
  int pos0, n;
  const int tokc = step_tok(b, dir, ci * CHUNK, pos0, n);
  const int base = tokc - pos0;
  const int plo = dir ? pos0 - (pw * 4 + 3) : pos0 + pw * 4;
  unsigned vm = 0;
#pragma unroll
  for (int i = 0; i < 6; ++i) {
    const int pos = plo - 1 + i;
    const int posc = min(max(pos, 0), n - 1);
    vm |= (pos == posc ? 1u : 0u) << i;
#pragma unroll
    for (int sg = 0; sg < 3; ++sg) R.u[sg][i] = slab[(size_t)(base + posc) * PS + RW_OFF + sg * 256 + ch];
  }
  R.vmask = vm;
#pragma unroll
  for (int q = 0; q < 4; ++q) {
    const int pos = dir ? pos0 - (pw * 4 + q) : pos0 + pw * 4 + q;
    R.wl[q] = rwl[(size_t)(base + pos) * 1024 + dir * 512 + ch];
    R.al[q] = rwl[(size_t)(base + pos) * 1024 + dir * 512 + 256 + ch];
  }
}
struct RwConst { float m0[3], m1[3], kk_w, ka_w, w0, a0; };
DEV void rw_const_load(RwConst& C, PC p, int l, int hd, int dir) {
  const int lane = TID() & 63;
  const int ch = hd * 64 + lane;
  const float* mu = p->in[I_RWMU] + l * 2 * 896;
  C.kk_w = p->in[I_RWKK][l * 256 + ch]; C.ka_w = p->in[I_RWKA][l * 256 + ch];
  C.w0 = p->in[I_RWW0][(l * 2 + dir) * 256 + ch]; C.a0 = p->in[I_RWA0][(l * 2 + dir) * 256 + ch];
#pragma unroll
  for (int sg = 0; sg < 3; ++sg) { C.m0[sg] = mu[sg * 256 + ch]; C.m1[sg] = mu[896 + sg * 256 + ch]; }
}
DEV void rw_prep_compute(const RwRaw& R, const RwConst& C, int dir, float* dst, int pw) {
  const int lane = TID() & 63;
  const float kk_w = C.kk_w, ka_w = C.ka_w, w0 = C.w0, a0 = C.a0;
  float m0[3], m1[3];
#pragma unroll
  for (int sg = 0; sg < 3; ++sg) { m0[sg] = C.m0[sg]; m1[sg] = C.m1[sg]; }
  float uf[3][6];
#pragma unroll
  for (int sg = 0; sg < 3; ++sg)
#pragma unroll
    for (int i = 0; i < 6; ++i) uf[sg][i] = ((R.vmask >> i) & 1u) ? __uint_as_float(R.u[sg][i] << 16) : 0.f;
#pragma unroll
  for (int q = 0; q < 4; ++q) {
    const int st = pw * 4 + q;
    const int ic = dir ? 4 - q : 1 + q;
    float ts[3];
#pragma unroll
    for (int sg = 0; sg < 3; ++sg) {
      const float u = uf[sg][ic], pv = uf[sg][ic - 1], nx = uf[sg][ic + 1];
      ts[sg] = u + m0[sg] * (pv - u) + m1[sg] * (nx - u);
    }
    const float r = ts[0], k = ts[1], v = ts[2];
    const float kr = k * kk_w;
    const float w = __expf(-__uint_as_float(R.wl[q] << 16));
    const float a = __uint_as_float(R.al[q] << 16);
    const float kd = k * (1.f + (a - 1.f) * ka_w);
    const float ss = wave_allsum_dpp(kr * kr), t1 = wave_allsum_dpp(kr * a * r), t2 = wave_allsum_dpp(kd * r);
    const float rn = rsqrtf(ss + 1e-6f);
    const float kk = kr * rn;
    float* d = dst + st * RW_STRIDE;
    d[lane] = w * r; d[64 + lane] = w; d[128 + lane] = kd; d[192 + lane] = -kk; d[256 + lane] = kk * a; d[320 + lane] = v;
    if (lane == 0) { d[384] = t1 * rn; d[385] = t2; }
  }
}

__device__ __attribute__((always_inline)) void rw_scan_unit(PC p, int l, int hunit, unsigned char* smem, const int MODE = 7) {
  const int unit = hunit >> 1, half = hunit & 1;
  const int b = unit >> 3, hd = (unit >> 1) & 3, dir = unit & 1;
  float* buf = (float*)smem;
  const int tid = TID(), wave = tid >> 6, lane = tid & 63;
  u16* rwy = (u16*)(p->ws + OFF_RWY) + (size_t)dir * TT * 256;
  __syncthreads();
  f32x2 S[8];
#pragma unroll
  for (int j = 0; j < 8; ++j) S[j] = (f32x2){0.f, 0.f};
  const bool is_scan = wave < 4;
  const bool is_prep = wave >= 4;
  const int pw = wave & 3;
  const int kp = lane & 7, col = half * 32 + (wave & 3) * 8 + (lane >> 3);
  RwRaw R0, R1;
  RwConst C;
  rw_const_load(C, p, l, hd, dir);
  if (is_prep) {
    rw_prep_load(R0, p, b, hd, dir, 0, pw); rw_prep_compute(R0, C, dir, buf, pw);
    rw_prep_load(R0, p, b, hd, dir, 1, pw); rw_prep_load(R1, p, b, hd, dir, 2, pw);
  }
  __syncthreads();
#define RW_SCAN_CHUNK(CI) do { \
      const float* bb = buf + ((CI) & 1) * CHUNK * RW_STRIDE; \
      int pos, n; \
      const int tok0 = step_tok(b, dir, (CI) * CHUNK, pos, n); \
      const int tstep = dir ? -1 : 1; \
      u16* op = rwy + (size_t)tok0 * 256 + hd * 64 + col; \
      RwOps8 A, B; \
      rw_load8(A, bb, kp, col); \
      _Pragma("unroll 1") for (int st = 0; st < CHUNK; st += 2) { \
        rw_load8(B, bb + (st + 1) * RW_STRIDE, kp, col); \
        const float y0 = rw_step8(S, A); \
        if ((MODE & 1) && kp == 0) op[(ptrdiff_t)(st * tstep) * 256] = f2bf(y0); sink += y0; \
        rw_load8(A, bb + (st + 2) * RW_STRIDE, kp, col); \
        const float y1 = rw_step8(S, B); \
        if ((MODE & 1) && kp == 0) op[(ptrdiff_t)((st + 1) * tstep) * 256] = f2bf(y1); sink += y1; \
      } } while (0)
  float sink = 0.f;
  if ((is_prep && !(MODE & 2)) || (is_scan && !(MODE & 4))) {
#pragma unroll 1
    for (int ci = 0; ci < NCHUNK; ci += 2) { lds_barrier(); lds_barrier(); }
  } else if (is_prep) {
#pragma unroll 1
    for (int ci = 0; ci < NCHUNK; ci += 2) {
      rw_prep_compute(R0, C, dir, buf + CHUNK * RW_STRIDE, pw);
      rw_prep_load(R0, p, b, hd, dir, min(ci + 3, NCHUNK - 1), pw);
      lds_barrier();
      if (ci + 2 < NCHUNK) rw_prep_compute(R1, C, dir, buf, pw);
      rw_prep_load(R1, p, b, hd, dir, min(ci + 4, NCHUNK - 1), pw);
      lds_barrier();
    }
  } else if (is_scan) {
#pragma unroll 1
    for (int ci = 0; ci < NCHUNK; ci += 2) {
      RW_SCAN_CHUNK(ci);
      lds_barrier();
      RW_SCAN_CHUNK(ci + 1);
      lds_barrier();
    }
    if (!(MODE & 1) && sink == 12345.678f) rwy[col] = f2bf(sink);
  } else {
#pragma unroll 1
    for (int ci = 0; ci < NCHUNK; ci += 2) { lds_barrier(); lds_barrier(); }
  }
  asm volatile("s_waitcnt vmcnt(0)" ::: "memory");
  __syncthreads();
}

constexpr int USTR = 2248;
__device__ __attribute__((always_inline)) void hyena_task(PC p, int l, int order, int task, unsigned char* smem) {
  const int tid = TID(), wave = tid >> 6, lane = tid & 63;
  const int ty = task >> 8, ch = task & 255, n = ty ? 256 : 2048;
  const int oc = order * 256 + ch;
  u16* F = (u16*)smem;
  u16* Ts = F + 4096 * 8;
  u16* Us = Ts + 4096;
  const int seq0 = ty ? TL : 0;
  __syncthreads();
  {
    const u16* filt = (const u16*)(p->ws + OFF_FILT + (size_t)l * FILT_LAYER) + (ty ? (size_t)512 * 4096 : 0) + (size_t)oc * (2 * n);
    for (int i = tid * 8; i < 2 * n; i += 512 * 8) *(uint4*)(Ts + i) = *(const uint4*)(filt + i);
    const u16* Usrc = (const u16*)(p->ws + (order == 0 ? OFF_HXT : OFF_HYZ)) + (size_t)ch * TT + seq0;
    const int nch = (n + 192) / 8;
    for (int idx = tid; idx < 8 * nch; idx += 512) {
      const int b = idx / nch, c8 = idx % nch, s = c8 * 8 - 96;
      uint4 v = make_uint4(0, 0, 0, 0);
      if (s >= 0 && s < n) v = *(const uint4*)(Usrc + (size_t)b * n + s);
      *(uint4*)(Us + b * USTR + c8 * 8) = v;
    }
  }
  __syncthreads();
  for (int E = tid; E < 2 * n; E += 512) {
    unsigned w[4];
#pragma unroll
    for (int q = 0; q < 4; ++q) {
      const int x0 = E - 2 * q, x1 = E - 2 * q - 1;
      const unsigned lo = (x0 >= 0 && x0 <= 2 * n - 2) ? Ts[x0] : 0u;
      const unsigned hi = (x1 >= 0 && x1 <= 2 * n - 2) ? Ts[x1] : 0u;
      w[q] = lo | (hi << 16);
    }
    *(uint4*)(F + E * 8) = make_uint4(w[0], w[1], w[2], w[3]);
  }
  float asum = 0.f;
  {
    const float* fp = (const float*)(p->ws + OFF_FPART) + (size_t)(l * 72 + (ty ? 64 : 0)) * 1024 + oc;
    const int nck = ty ? 8 : 64;
    for (int c = 0; c < nck; ++c) asum += fp[c * 1024] + fp[c * 1024 + 512];
  }
  const float inv = 1.f / asum;
  __syncthreads();
  const int ntile = n >> 7;
  if (wave < ntile) {
    const bool two = (wave + 8) < ntile;
    f32x16 acc0, acc1;
#pragma unroll
    for (int i = 0; i < 16; ++i) { acc0[i] = 0.f; acc1[i] = 0.f; }
    const int m = lane & 31, kh = lane >> 5, dl = m >> 3, bb = m & 7;
    const u16* Bp = Us + bb * USTR + 8 * kh + 32 * dl;
    const int T0 = wave * 128;
    const int nsteps = (n + 96) / 16;
    const u16* Ap = F + (size_t)(T0 + 96 + n - 1 + m - 8 * kh) * 8;
#pragma unroll 2
    for (int st = 0; st < nsteps; ++st) {
      const bf16x8 bfrag = *(const bf16x8*)(Bp + st * 16);
      const bf16x8 a0 = *(const bf16x8*)(Ap - st * 128);
      acc0 = __builtin_amdgcn_mfma_f32_32x32x16_bf16(a0, bfrag, acc0, 0, 0, 0);
      if (two) {
        const bf16x8 a1 = *(const bf16x8*)(Ap - st * 128 + 1024 * 8);
        acc1 = __builtin_amdgcn_mfma_f32_32x32x16_bf16(a1, bfrag, acc1, 0, 0, 0);
      }
    }
    const float bias = p->in[I_HYBIAS][l * 512 + oc];
    const u16* gsrc = (const u16*)(p->ws + OFF_HXT) + (size_t)((order == 0 ? 256 : 512) + ch) * TT;
    const u16* usrc = (const u16*)(p->ws + (order == 0 ? OFF_HXT : OFF_HYZ)) + (size_t)ch * TT;
#pragma unroll
    for (int tsel = 0; tsel < 2; ++tsel) {
      if (tsel == 1 && !two) break;
      const int Tb = T0 + tsel * 1024;
#pragma unroll
      for (int rq = 0; rq < 4; ++rq) {
        const int t = Tb + 32 * dl + 8 * rq + 4 * kh;
        const size_t tok = (size_t)seq0 + (size_t)bb * n + t;
        const uint2 gx = *(const uint2*)(gsrc + tok);
        const uint2 ux = *(const uint2*)(usrc + tok);
        const float g[4] = {__uint_as_float(gx.x << 16), __uint_as_float(gx.x & 0xffff0000u), __uint_as_float(gx.y << 16), __uint_as_float(gx.y & 0xffff0000u)};
        const float u[4] = {__uint_as_float(ux.x << 16), __uint_as_float(ux.x & 0xffff0000u), __uint_as_float(ux.y << 16), __uint_as_float(ux.y & 0xffff0000u)};
        float o[4];
#pragma unroll
        for (int e = 0; e < 4; ++e) {
          const float y = (tsel == 0 ? acc0[rq * 4 + e] : acc1[rq * 4 + e]) * inv;
          o[e] = g[e] * (y + u[e] * bias);
        }
        if (order == 0) {
          uint2 ov; ov.x = pack2(o[0], o[1]); ov.y = pack2(o[2], o[3]);
          *(uint2*)((u16*)(p->ws + OFF_HYZ) + (size_t)ch * TT + tok) = ov;
        } else {
          u16* cat = (u16*)(p->ws + OFF_H);
#pragma unroll
          for (int e = 0; e < 4; ++e) cat[(tok + e) * 1024 + ch] = f2bf(o[e]);
        }
      }
    }
  }
}

__device__ __attribute__((always_inline)) void na_task(PC p, int l, int task, unsigned char* smem) {
  u16* Qs = (u16*)smem;
  u16* Ks = Qs + 128 * 72;
  u16* Vt = Ks + 64 * 72;
  float* rpbs = (float*)(Vt + 64 * 72);
  const int tid = TID(), wave = tid >> 6, lane = tid & 63;
  const int grp = wave >> 2, w4 = wave & 3;
  const u16* slab = (const u16*)(p->ws + OFF_SLAB);
  int b, hd, r0 = 0, u0 = 0, nloc = 0, qbase0, qbase1;
  const bool local = task < 512;
  if (local) {
    b = task >> 6; hd = (task >> 4) & 3; r0 = (task & 15) * 2;
    u0 = min(max(r0 - 4, 0), 24);
    nloc = min(max(r0 + 1 - 4, 0), 24) + 8 - u0;
    qbase0 = b * 2048 + r0 * 64; qbase1 = qbase0 + 64;
  } else {
    const int t2 = task - 512; b = t2 >> 3; hd = (t2 >> 1) & 3;
    qbase0 = TL + b * 256 + (t2 & 1) * 128; qbase1 = qbase0 + 64;
  }
  const int nchunks = nloc + 4;
  const int r = r0 + grp;
  const int rs = min(max(r - 4, 0), 24);
  const int qtok0 = grp ? qbase1 : qbase0;
  const float* qn = p->in[I_NAQN] + l * 64;
  const float* kn = p->in[I_NAKN] + l * 64;
  __syncthreads();
  {
    const int q = tid >> 2, dq = tid & 3;
    const int qt = (q < 64 ? qbase0 : qbase1) + (q & 63);
    float v[16];
    unpack8(*(const uint4*)(slab + (size_t)qt * PS + NA_OFF + hd * 64 + dq * 16), v);
    unpack8(*(const uint4*)(slab + (size_t)qt * PS + NA_OFF + hd * 64 + dq * 16 + 8), v + 8);
    float ss = 0.f;
#pragma unroll
    for (int e = 0; e < 16; ++e) ss += v[e] * v[e];
    ss += __shfl_xor(ss, 1); ss += __shfl_xor(ss, 2);
    const float rinv = rsqrtf(ss * (1.f / 64.f) + 1e-6f);
    uint4 o0, o1;
    o0.x = pack2(v[0] * rinv * qn[dq * 16 + 0], v[1] * rinv * qn[dq * 16 + 1]);
    o0.y = pack2(v[2] * rinv * qn[dq * 16 + 2], v[3] * rinv * qn[dq * 16 + 3]);
    o0.z = pack2(v[4] * rinv * qn[dq * 16 + 4], v[5] * rinv * qn[dq * 16 + 5]);
    o0.w = pack2(v[6] * rinv * qn[dq * 16 + 6], v[7] * rinv * qn[dq * 16 + 7]);
    o1.x = pack2(v[8] * rinv * qn[dq * 16 + 8], v[9] * rinv * qn[dq * 16 + 9]);
    o1.y = pack2(v[10] * rinv * qn[dq * 16 + 10], v[11] * rinv * qn[dq * 16 + 11]);
    o1.z = pack2(v[12] * rinv * qn[dq * 16 + 12], v[13] * rinv * qn[dq * 16 + 13]);
    o1.w = pack2(v[14] * rinv * qn[dq * 16 + 14], v[15] * rinv * qn[dq * 16 + 15]);
    *(uint4*)(Qs + q * 72 + dq * 16) = o0;
    *(uint4*)(Qs + q * 72 + dq * 16 + 8) = o1;
    for (int i = tid; i < 15 * 31; i += 512) rpbs[i] = p->in[I_NARPB][(size_t)(l * 4 + hd) * 15 * 31 + i];
  }
  const int fr = lane & 15, fq = lane >> 4;
  const int qc = w4 * 16 + fr;
  const int cs = min(max(qc - 8, 0), 48);
  float m = -1e30f, lsum = 0.f;
  f32x4 o[4];
#pragma unroll
  for (int i = 0; i < 4; ++i) o[i] = (f32x4){0.f, 0.f, 0.f, 0.f};
  bf16x8 bq[2];
  uint4 kraw, vraw;
  const int skey = tid >> 3, sdc = tid & 7;
#define NA_KTOK(CI) (((CI) < nloc) ? b * 2048 + (u0 + (CI)) * 64 : TL + b * 256 + ((CI) - nloc) * 64)
  {
    const int kt0 = NA_KTOK(0);
    kraw = *(const uint4*)(slab + (size_t)(kt0 + skey) * PS + NA_OFF + 256 + hd * 64 + sdc * 8);
    vraw = *(const uint4*)(slab + (size_t)(kt0 + skey) * PS + NA_OFF + 512 + hd * 64 + sdc * 8);
  }
#pragma unroll 1
  for (int ci = 0; ci < nchunks; ++ci) {
    __syncthreads();
    const bool lc = ci < nloc;
    const int rr = u0 + ci;
    const bool active = !lc || (rr >= rs && rr < rs + 8);
    {
      const int key = skey, dc = sdc;
      float v[8];
      unpack8(kraw, v);
      float ss = 0.f;
#pragma unroll
      for (int e = 0; e < 8; ++e) ss += v[e] * v[e];
      ss += __shfl_xor(ss, 1); ss += __shfl_xor(ss, 2); ss += __shfl_xor(ss, 4);
      const float rinv = rsqrtf(ss * (1.f / 64.f) + 1e-6f);
      uint4 ov;
      ov.x = pack2(v[0] * rinv * kn[dc * 8 + 0], v[1] * rinv * kn[dc * 8 + 1]);
      ov.y = pack2(v[2] * rinv * kn[dc * 8 + 2], v[3] * rinv * kn[dc * 8 + 3]);
      ov.z = pack2(v[4] * rinv * kn[dc * 8 + 4], v[5] * rinv * kn[dc * 8 + 5]);
      ov.w = pack2(v[6] * rinv * kn[dc * 8 + 6], v[7] * rinv * kn[dc * 8 + 7]);
      *(uint4*)(Ks + key * 72 + dc * 8) = ov;
      const unsigned w4[4] = {vraw.x, vraw.y, vraw.z, vraw.w};
#pragma unroll
      for (int e = 0; e < 4; ++e) {
        Vt[(dc * 8 + 2 * e) * 72 + key] = (u16)(w4[e] & 0xffffu);
        Vt[(dc * 8 + 2 * e + 1) * 72 + key] = (u16)(w4[e] >> 16);
      }
    }
    __syncthreads();
    if (ci + 1 < nchunks) {
      const int kt1 = NA_KTOK(ci + 1);
      kraw = *(const uint4*)(slab + (size_t)(kt1 + skey) * PS + NA_OFF + 256 + hd * 64 + sdc * 8);
      vraw = *(const uint4*)(slab + (size_t)(kt1 + skey) * PS + NA_OFF + 512 + hd * 64 + sdc * 8);
    }
    if (ci == 0) {
      bq[0] = *(const bf16x8*)(Qs + (grp * 64 + w4 * 16 + fr) * 72 + fq * 8);
      bq[1] = *(const bf16x8*)(Qs + (grp * 64 + w4 * 16 + fr) * 72 + 32 + fq * 8);
    }
    if (active) {
      f32x4 s[4];
#pragma unroll
      for (int mt = 0; mt < 4; ++mt) {
        s[mt] = (f32x4){0.f, 0.f, 0.f, 0.f};
#pragma unroll
        for (int ks = 0; ks < 2; ++ks) {
          bf16x8 a = *(const bf16x8*)(Ks + (mt * 16 + fr) * 72 + ks * 32 + fq * 8);
          s[mt] = __builtin_amdgcn_mfma_f32_16x16x32_bf16(a, bq[ks], s[mt], 0, 0, 0);
        }
      }
      float cmax = -1e30f;
#pragma unroll
      for (int mt = 0; mt < 4; ++mt)
#pragma unroll
        for (int j = 0; j < 4; ++j) {
          float v = s[mt][j] * 0.125f;
          if (lc) {
            const int kc = mt * 16 + fq * 4 + j;
            const bool ok = (kc >= cs) && (kc < cs + 16);
            int dcol = min(max(kc - qc, -15), 15);
            v = ok ? v + rpbs[(rr - r + 7) * 31 + dcol + 15] : -1e30f;
          }
          s[mt][j] = v;
          cmax = fmaxf(cmax, v);
        }
      cmax = allmax_rows(cmax);
      const float mnew = fmaxf(m, cmax);
      const float alpha = __expf(m - mnew);
      m = mnew;
      float ps = 0.f;
#pragma unroll
      for (int mt = 0; mt < 4; ++mt)
#pragma unroll
        for (int j = 0; j < 4; ++j) { float pp = __expf(s[mt][j] - mnew); s[mt][j] = pp; ps += pp; }
      lsum = lsum * alpha + ps;
#pragma unroll
      for (int dt = 0; dt < 4; ++dt) o[dt] *= alpha;
      bf16x8 pb[2];
#pragma unroll
      for (int h2 = 0; h2 < 2; ++h2) {
#pragma unroll
        for (int e = 0; e < 4; ++e) {
          pb[h2][e] = (short)f2bf(s[2 * h2][e]);
          pb[h2][4 + e] = (short)f2bf(s[2 * h2 + 1][e]);
        }
      }
#pragma unroll
      for (int dt = 0; dt < 4; ++dt)
#pragma unroll
        for (int h2 = 0; h2 < 2; ++h2) {
          bf16x4 va = *(const bf16x4*)(Vt + (dt * 16 + fr) * 72 + (2 * h2) * 16 + fq * 4);
          bf16x4 vb = *(const bf16x4*)(Vt + (dt * 16 + fr) * 72 + (2 * h2 + 1) * 16 + fq * 4);
          bf16x8 a = __builtin_shufflevector(va, vb, 0, 1, 2, 3, 4, 5, 6, 7);
          o[dt] = __builtin_amdgcn_mfma_f32_16x16x32_bf16(a, pb[h2], o[dt], 0, 0, 0);
        }
    }
  }
  {
    lsum = allred_rows(lsum);
    const float inv = 1.f / lsum;
    u16* cat = (u16*)(p->ws + OFF_H);
    const int tok = qtok0 + w4 * 16 + fr;
#pragma unroll
    for (int dt = 0; dt < 4; ++dt) {
      uint2 ov;
      ov.x = pack2(o[dt][0] * inv, o[dt][1] * inv);
      ov.y = pack2(o[dt][2] * inv, o[dt][3] * inv);
      *(uint2*)(cat + (size_t)tok * 1024 + 256 + hd * 64 + dt * 16 + fq * 4) = ov;
    }
  }
}

DEV void combine_token(PC p, int l, int tok, const float* g, const u16* slab, const u16* rwl, const u16* dno, const u16* rwy, u16* cat, const float* mu, int c4) {
    int base, n;
    if (tok < TL) { base = (tok >> 11) << 11; n = 2048; } else { base = TL + (((tok - TL) >> 8) << 8); n = 256; }
    const int pos = tok - base;
    {
      float4 ov;
      {
        const uint2 f0 = *(const uint2*)(dno + (size_t)tok * 256 + c4), f1 = *(const uint2*)(dno + (size_t)TT * 256 + (size_t)tok * 256 + c4);
        ov.x = __uint_as_float(f0.x << 16) + __uint_as_float(f1.x << 16);
        ov.y = __uint_as_float(f0.x & 0xffff0000u) + __uint_as_float(f1.x & 0xffff0000u);
        ov.z = __uint_as_float(f0.y << 16) + __uint_as_float(f1.y << 16);
        ov.w = __uint_as_float(f0.y & 0xffff0000u) + __uint_as_float(f1.y & 0xffff0000u);
      }
      float ss = ov.x * ov.x + ov.y * ov.y + ov.z * ov.z + ov.w * ov.w;
      ss += __shfl_xor(ss, 1); ss += __shfl_xor(ss, 2); ss += __shfl_xor(ss, 4); ss += __shfl_xor(ss, 8);
      const float rinv = rsqrtf(ss * (1.f / 64.f) + 1e-6f);
      const float* nw = p->in[I_DNNORM] + l * 64 + (c4 & 63);
      uint2 zz = *(const uint2*)(slab + (size_t)tok * PS + DN_OFF + 768 + c4);
      float z0 = __uint_as_float(zz.x << 16), z1 = __uint_as_float(zz.x & 0xffff0000u), z2 = __uint_as_float(zz.y << 16), z3 = __uint_as_float(zz.y & 0xffff0000u);
      uint2 o2;
      o2.x = pack2(ov.x * rinv * nw[0] * siluf_(z0), ov.y * rinv * nw[1] * siluf_(z1));
      o2.y = pack2(ov.z * rinv * nw[2] * siluf_(z2), ov.w * rinv * nw[3] * siluf_(z3));
      *(uint2*)(cat + (size_t)tok * 1024 + 512 + c4) = o2;
    }
    {
      float ts[3][4];
#pragma unroll
      for (int sgi = 0; sgi < 3; ++sgi) {
        const int col = RW_OFF + sgi * 256 + c4;
        uint2 cu = *(const uint2*)(slab + (size_t)tok * PS + col);
        uint2 pu = pos > 0 ? *(const uint2*)(slab + (size_t)(tok - 1) * PS + col) : make_uint2(0, 0);
        uint2 nu = pos < n - 1 ? *(const uint2*)(slab + (size_t)(tok + 1) * PS + col) : make_uint2(0, 0);
        float uc[4] = {__uint_as_float(cu.x << 16), __uint_as_float(cu.x & 0xffff0000u), __uint_as_float(cu.y << 16), __uint_as_float(cu.y & 0xffff0000u)};
        float up[4] = {__uint_as_float(pu.x << 16), __uint_as_float(pu.x & 0xffff0000u), __uint_as_float(pu.y << 16), __uint_as_float(pu.y & 0xffff0000u)};
        float un[4] = {__uint_as_float(nu.x << 16), __uint_as_float(nu.x & 0xffff0000u), __uint_as_float(nu.y << 16), __uint_as_float(nu.y & 0xffff0000u)};
#pragma unroll
        for (int e = 0; e < 4; ++e) ts[sgi][e] = uc[e] + mu[sgi * 256 + c4 + e] * (up[e] - uc[e]) + mu[896 + sgi * 256 + c4 + e] * (un[e] - uc[e]);
      }
      float4 yv;
      {
        const uint2 f0 = *(const uint2*)(rwy + (size_t)tok * 256 + c4), f1 = *(const uint2*)(rwy + (size_t)TT * 256 + (size_t)tok * 256 + c4);
        yv.x = __uint_as_float(f0.x << 16) + __uint_as_float(f1.x << 16);
        yv.y = __uint_as_float(f0.x & 0xffff0000u) + __uint_as_float(f1.x & 0xffff0000u);
        yv.z = __uint_as_float(f0.y << 16) + __uint_as_float(f1.y << 16);
        yv.w = __uint_as_float(f0.y & 0xffff0000u) + __uint_as_float(f1.y & 0xffff0000u);
      }
      float y[4] = {yv.x, yv.y, yv.z, yv.w};
      float sm = y[0] + y[1] + y[2] + y[3];
      sm += __shfl_xor(sm, 1); sm += __shfl_xor(sm, 2); sm += __shfl_xor(sm, 4); sm += __shfl_xor(sm, 8);
      const float mean = sm * (1.f / 64.f);
      float sq = 0.f;
#pragma unroll
      for (int e = 0; e < 4; ++e) sq += (y[e] - mean) * (y[e] - mean);
      sq += __shfl_xor(sq, 1); sq += __shfl_xor(sq, 2); sq += __shfl_xor(sq, 4); sq += __shfl_xor(sq, 8);
      const float rstd = rsqrtf(sq * (1.f / 64.f) + 64e-5f);
      uint2 al0 = *(const uint2*)(rwl + (size_t)tok * 1024 + 256 + c4);
      uint2 al1 = *(const uint2*)(rwl + (size_t)tok * 1024 + 512 + 256 + c4);
      float a0l[4] = {__uint_as_float(al0.x << 16), __uint_as_float(al0.x & 0xffff0000u), __uint_as_float(al0.y << 16), __uint_as_float(al0.y & 0xffff0000u)};
      float a1l[4] = {__uint_as_float(al1.x << 16), __uint_as_float(al1.x & 0xffff0000u), __uint_as_float(al1.y << 16), __uint_as_float(al1.y & 0xffff0000u)};
      float bs = 0.f;
#pragma unroll
      for (int e = 0; e < 4; ++e) {
        const int ch = c4 + e;
        const float a0 = a0l[e];
        const float a1 = a1l[e];
        const float ka = p->in[I_RWKA][l * 256 + ch];
        const float ksum = ts[1][e] * (2.f + (a0 + a1 - 2.f) * ka);
        bs += ts[0][e] * ksum * p->in[I_RWRK][l * 256 + ch];
      }
      bs += __shfl_xor(bs, 1); bs += __shfl_xor(bs, 2); bs += __shfl_xor(bs, 4); bs += __shfl_xor(bs, 8);
      float outv[4];
#pragma unroll
      for (int e = 0; e < 4; ++e) {
        const int ch = c4 + e;
        const float yn = (y[e] - mean) * rstd * p->in[I_RWLNW][l * 256 + ch] + p->in[I_RWLNB][l * 256 + ch];
        outv[e] = (yn + bs * ts[2][e]) * g[e];
      }
      uint2 o2; o2.x = pack2(outv[0], outv[1]); o2.y = pack2(outv[2], outv[3]);
      *(uint2*)(cat + (size_t)tok * 1024 + 768 + c4) = o2;
    }
}

__device__ __attribute__((always_inline)) void combine_pass(PC p, int l, int ntok, unsigned char* smem) {
  const int tid = TID(), wave = tid >> 6, lane = tid & 63;
  float* sg = (float*)smem + wave * 192;
  const u16* slab = (const u16*)(p->ws + OFF_SLAB);
  const u16* rwl = (const u16*)(p->ws + OFF_RWL);
  const u16* dno = (const u16*)(p->ws + OFF_DNO);
  const u16* rwy = (const u16*)(p->ws + OFF_RWY);
  u16* cat = (u16*)(p->ws + OFF_H);
  const float* mu = p->in[I_RWMU] + l * 2 * 896;
  const float* gup = p->in[I_RWGUP] + (size_t)l * 64 * 256;
  const int c4 = lane * 4;
  __syncthreads();
  for (int tok0 = (BID() * 8 + wave) * 3; tok0 < ntok; tok0 += NBLK() * 8 * 3) {
#pragma unroll
    for (int tt = 0; tt < 3; ++tt) {
      const int tok = min(tok0 + tt, ntok - 1);
      int base, n;
      if (tok < TL) { base = (tok >> 11) << 11; n = 2048; } else { base = TL + (((tok - TL) >> 8) << 8); n = 256; }
      const int pos = tok - base;
      const int col = RW_OFF + 832 + lane;
      float u = bf2f(slab[(size_t)tok * PS + col]);
      float pv = pos > 0 ? bf2f(slab[(size_t)(tok - 1) * PS + col]) : 0.f;
      float nx = pos < n - 1 ? bf2f(slab[(size_t)(tok + 1) * PS + col]) : 0.f;
      float sv = u + mu[832 + lane] * (pv - u) + mu[896 + 832 + lane] * (nx - u);
      sg[tt * 64 + lane] = sigmoidf_(sv);
    }
    float g[3][4];
#pragma unroll
    for (int tt = 0; tt < 3; ++tt)
#pragma unroll
      for (int e = 0; e < 4; ++e) g[tt][e] = 0.f;
#pragma unroll 4
    for (int j = 0; j < 64; ++j) {
      const float4 gw = *(const float4*)(gup + j * 256 + c4);
#pragma unroll
      for (int tt = 0; tt < 3; ++tt) {
        const float sj = sg[tt * 64 + j];
        g[tt][0] = fmaf(sj, gw.x, g[tt][0]); g[tt][1] = fmaf(sj, gw.y, g[tt][1]); g[tt][2] = fmaf(sj, gw.z, g[tt][2]); g[tt][3] = fmaf(sj, gw.w, g[tt][3]);
      }
    }
#pragma unroll
    for (int tt = 0; tt < 3; ++tt)
      if (tok0 + tt < ntok) combine_token(p, l, tok0 + tt, g[tt], slab, rwl, dno, rwy, cat, mu, c4);
  }
}

#ifndef XB_ALL_RELEASE
#define XB_ALL_RELEASE 0
#endif
#define XB_TMO      128
#define XB_XCNT(j)  (256  + 64 * (j))
#define XB_XSUB(j)  (1280 + 64 * (j))
#define XB_XGEN(j)  (2304 + 64 * (j))
#define XB_TOP      3328
#define XB_TOPGEN   3392
#define XB_SPIN_CAP (1u << 18)
#define LAS __attribute__((address_space(3)))
DEV unsigned xb_ld(unsigned* p) { return __hip_atomic_load(p, __ATOMIC_RELAXED, __HIP_MEMORY_SCOPE_AGENT); }
DEV unsigned xb_add(unsigned* p, unsigned v) { return __hip_atomic_fetch_add(p, v, __ATOMIC_RELAXED, __HIP_MEMORY_SCOPE_AGENT); }
DEV unsigned xb_xcc_id() { return (unsigned)__builtin_amdgcn_s_getreg((3 << 11) | 20) & 0xFu; }
#define XB_SPIN(cond, bar) do { unsigned _sp = 0; while (cond) { __builtin_amdgcn_s_sleep(1); \
    if ((++_sp & 255u) == 0u) { if (xb_ld(&(bar)[XB_TMO])) break; if (_sp > XB_SPIN_CAP) { atomicAdd(&(bar)[XB_TMO], 1u); break; } } } } while (0)
struct XcdBarrier { unsigned* bar; unsigned x; volatile LAS unsigned* st; };
DEV XcdBarrier xcd_barrier_post(unsigned* bar, volatile LAS unsigned* st) {
  XcdBarrier b; b.bar = bar; b.x = xb_xcc_id(); b.st = st;
  if (threadIdx.x == 0) (void)xb_add(&bar[XB_XCNT(b.x)], 1u);
  return b;
}
DEV void xcd_barrier_complete(unsigned* bar, unsigned x, unsigned& nloc, unsigned& nx) {
  const unsigned G = gridDim.x * gridDim.y * gridDim.z;
  unsigned sum, cnt, mine, sp = 0u;
  for (;;) {
    sum = 0u; cnt = 0u; mine = 0u;
#pragma unroll
    for (unsigned j = 0; j < 16; ++j) { const unsigned c = xb_ld(&bar[XB_XCNT(j)]); sum += c; cnt += (c > 0u) ? 1u : 0u; mine = (j == x) ? c : mine; }
    if (sum == G) break;
    __builtin_amdgcn_s_sleep(1);
    if ((++sp & 255u) == 0u) { if (xb_ld(&bar[XB_TMO])) break; if (sp > XB_SPIN_CAP) { atomicAdd(&bar[XB_TMO], 1u); break; } }
  }
  nloc = mine > 0u ? mine : 1u; nx = cnt > 0u ? cnt : 1u;
}
DEV void xcd_barrier(const XcdBarrier& b) {
  asm volatile("s_waitcnt vmcnt(0)" ::: "memory");
  __syncthreads();
  if (threadIdx.x == 0) {
    unsigned* bar = b.bar;
    __builtin_amdgcn_s_waitcnt(0);
#if XB_ALL_RELEASE
    __builtin_amdgcn_fence(__ATOMIC_RELEASE, "agent");
    asm volatile("s_waitcnt vmcnt(0)" ::: "memory");
#endif
    unsigned nloc = b.st[0], nx = b.st[1];
    if (nloc == 0u) { xcd_barrier_complete(bar, b.x, nloc, nx); b.st[0] = nloc; b.st[1] = nx; }
    const unsigned old = xb_add(&bar[XB_XSUB(b.x)], 1u);
    const unsigned gen = old / nloc;
    if (old + 1u == (gen + 1u) * nloc) {
      __builtin_amdgcn_fence(__ATOMIC_RELEASE, "agent");
      asm volatile("s_waitcnt vmcnt(0)" ::: "memory");
      const unsigned og = xb_add(&bar[XB_TOP], 1u);
      const unsigned tg = og / nx;
      if (og + 1u == (tg + 1u) * nx) xb_add(&bar[XB_TOPGEN], 1u);
      else XB_SPIN(xb_ld(&bar[XB_TOPGEN]) == tg, bar);
      __builtin_amdgcn_fence(__ATOMIC_ACQUIRE, "agent");
      xb_add(&bar[XB_XGEN(b.x)], 1u);
      asm volatile("s_waitcnt vmcnt(0)" ::: "memory");
    } else {
      XB_SPIN(xb_ld(&bar[XB_XGEN(b.x)]) == gen, bar);
      __builtin_amdgcn_fence(__ATOMIC_ACQUIRE, "agent");
      asm volatile("s_waitcnt vmcnt(0)" ::: "memory");
    }
  }
  __syncthreads();
}

DEV void ctr_barrier(unsigned* ctr, unsigned& epoch) {
  asm volatile("s_waitcnt vmcnt(0)" ::: "memory");
  __syncthreads();
  if (threadIdx.x == 0) {
    __builtin_amdgcn_fence(__ATOMIC_RELEASE, "agent");
    asm volatile("s_waitcnt vmcnt(0)" ::: "memory");
    epoch += 1;
    const unsigned target = epoch * gridDim.x;
    (void)xb_add(ctr, 1u);
    unsigned sp = 0;
    while (xb_ld(ctr) < target) { __builtin_amdgcn_s_sleep(1); if (++sp > (1u << 24)) break; }
    __builtin_amdgcn_fence(__ATOMIC_ACQUIRE, "agent");
    asm volatile("s_waitcnt vmcnt(0)" ::: "memory");
  }
  __syncthreads();
}
#ifndef USE_CTR_BARRIER
#define USE_CTR_BARRIER 0
#endif
#if USE_CTR_BARRIER
#define GBAR() ctr_barrier((unsigned*)(launder(pk)->ws + OFF_BAR), gb_epoch)
#else
#define GBAR() xcd_barrier(xb)
#endif

__global__ void __launch_bounds__(512) fwd_megakernel(P p_unused) {
  cg::grid_group grid = cg::this_grid();
  PC pk = (PC)__builtin_amdgcn_kernarg_segment_ptr();
  __shared__ __attribute__((aligned(16))) unsigned char smem[SMEM_BYTES];
  __shared__ int s_task;
  __shared__ uint4 xb_words;
  if (threadIdx.x == 0) xb_words = make_uint4(0u, 0u, 0u, 0u);
  __syncthreads();
  const XcdBarrier xb = xcd_barrier_post((unsigned*)(launder(pk)->ws + OFF_BAR), (volatile LAS unsigned*)&xb_words);
  unsigned gb_epoch = 0;
  __shared__ int s_vbid;
  if (threadIdx.x == 0) s_vbid = (int)xb_add((unsigned*)(launder(pk)->ws + OFF_CNT) + 16 + xb.x, 1u) * 8 + (int)xb.x;
  const int tid = TID();
  const int nb = NBLK(), bid = BID();

  {
    LOADP();
    for (int rep = 0; rep <= PROBE_P0; ++rep) {
      for (int t = bid; t < 144 + 144; t += nb) {
        if (t < 144) task_mod(p, t, smem);
        else task_filter(p, t - 144, smem);
      }
      convert_all(p, 0, smem);
    }
  }
  grid.sync();
  int vbid;
  {
    unsigned* bar = (unsigned*)(launder(pk)->ws + OFF_BAR);
    bool ok = (gridDim.x == 256);
    for (int j = 0; j < 16; ++j) { const unsigned c = xb_ld(&bar[XB_XCNT(j)]); ok = ok && (c == (j < 8 ? 32u : 0u)); }
    vbid = ok ? s_vbid : -1;
    vbid = __builtin_amdgcn_readfirstlane(vbid);
  }

#pragma unroll 1
  for (int l = 0; l < 2; ++l) {
    const bool need_ctx = (l == 0);
    {
      LOADP();
      if (l == 1) convert_all(p, 1, smem);
      for (int rep = 0; rep <= PROBE_ADALN; ++rep) adaln_pass(p, l, 0, (l == 0) ? p->in[I_X] : p->out, (l == 0) ? p->in[I_CTX] : (const float*)(p->ws + OFF_XC), TT);
    }
    GBAR();
    {
      LOADP();
      Epi e{}; e.outb = (u16*)(p->ws + OFF_ACT);
      for (int rep = 0; rep <= PROBE_GEMM; ++rep) {
        gemm_phase_big<0>((const u16*)(p->ws + OFF_H), 1024, (const u16*)(p->ws + OFF_WGU), 1024, TT, 5632, e, smem, 1536);
        gemm_phase<0, 128>((const u16*)(p->ws + OFF_H), 1024, (const u16*)(p->ws + OFF_WGU), 1024, 48 * 256, 256, e, smem, vbid, 24 * 256, 21 * 256);
      }
    }
    GBAR();
    {
      LOADP();
      float* xc = (float*)(p->ws + OFF_XC);
      Epi e{}; e.xs_lat = (l == 0) ? p->in[I_X] : p->out; e.xs_ctx = (l == 0) ? p->in[I_CTX] : xc; e.xd_lat = p->out; e.xd_ctx = xc;
      e.gate = (const float*)(p->ws + OFF_MOD) + (size_t)l * 9 * 9216 + 2 * 1024; e.coef = 0.5f;
      gemm_phase_big<1>((const u16*)(p->ws + OFF_ACT), DFF, (const u16*)(p->ws + OFF_WDN), DFF, TL, 1024, e, smem);
      gemm_phase<1, 64>((const u16*)(p->ws + OFF_ACT), DFF, (const u16*)(p->ws + OFF_WDN), DFF, TC, 1024, e, smem, vbid, TL);
    }
    GBAR();
    {
      LOADP();
      for (int rep = 0; rep <= PROBE_ADALN; ++rep) adaln_pass(p, l, 1, p->out, (const float*)(p->ws + OFF_XC), TT);
    }
    GBAR();
    {
      LOADP();
      Epi e{}; e.outb = (u16*)(p->ws + OFF_SLAB);
      for (int rep = 0; rep <= PROBE_GEMM; ++rep) gemm_phase_big<2>((const u16*)(p->ws + OFF_H), 1024, (const u16*)(p->ws + OFF_WIN), 1024, TT, PS, e, smem);
    }
    GBAR();
    {
      LOADP();
      for (int rep = 0; rep <= PROBE_PREP; ++rep) for (int t = bid; t < TT / 32; t += nb) prep_task(p, l, t, smem);
    }
    GBAR();
    if (bid < 64) { LOADP(); dn_scan_unit(p, l, bid, smem); }
    else if (bid < 192) { LOADP(); rw_scan_unit(p, l, bid - 64, smem); }
    {
      const int n_hy = need_ctx ? 512 : 256;
      const int n_na = need_ctx ? 512 + 64 : 512;
      const int ntask = n_hy + n_na;
      while (true) {
        LOADP();
        __syncthreads();
        if (tid == 0) s_task = atomicAdd((int*)(p->ws + OFF_CNT) + l * 4, 1);
        __syncthreads();
        const int t = s_task;
        if (t >= ntask) break;
        if (t < n_hy) hyena_task(p, l, 0, t, smem);
        else na_task(p, l, t - n_hy, smem);
      }
    }
    GBAR();
#if PROBE_SCAN
    for (int rep = 0; rep < PROBE_SCAN; ++rep) {
      if (bid < 64) { if (!(PROBE_MODE & 8)) { LOADP(); dn_scan_unit(p, l, bid, smem, PROBE_MODE & 6); } }
      else if (bid < 192) { if (!(PROBE_MODE & 16)) { LOADP(); rw_scan_unit(p, l, bid - 64, smem, PROBE_MODE & 6); } }
      GBAR();
    }
#endif
    for (int rep = 0; rep <= PROBE_M2; ++rep) {
    {
      LOADP();
      const int n_hy = need_ctx ? 512 : 256;
      for (int t = bid; t < n_hy; t += nb) hyena_task(p, l, 1, t, smem);
    }
    {
      LOADP();
      combine_pass(p, l, need_ctx ? TT : TL, smem);
    }
    }
    GBAR();
    {
      LOADP();
      float* xc = (float*)(p->ws + OFF_XC);
      Epi e{}; e.xs_lat = p->out; e.xs_ctx = xc; e.xd_lat = p->out; e.xd_ctx = xc;
      e.gate = (const float*)(p->ws + OFF_MOD) + (size_t)l * 9 * 9216 + 5 * 1024; e.coef = 1.0f;
      gemm_phase_big<1>((const u16*)(p->ws + OFF_H), 1024, (const u16*)(p->ws + OFF_WOUT), 1024, TL, 1024, e, smem);
      if (need_ctx) gemm_phase<1, 64>((const u16*)(p->ws + OFF_H), 1024, (const u16*)(p->ws + OFF_WOUT), 1024, TC, 1024, e, smem, vbid, TL);
    }
    GBAR();
    {
      LOADP();
      for (int rep = 0; rep <= PROBE_ADALN; ++rep) adaln_pass(p, l, 2, p->out, (const float*)(p->ws + OFF_XC), need_ctx ? TT : TL);
    }
    GBAR();
    {
      LOADP();
      Epi e{}; e.outb = (u16*)(p->ws + OFF_ACT);
      for (int rep = 0; rep <= PROBE_GEMM; ++rep) {
        const u16* W2 = (const u16*)(p->ws + OFF_WGU) + (size_t)5632 * 1024;
        if (need_ctx) {
          gemm_phase_big<0>((const u16*)(p->ws + OFF_H), 1024, W2, 1024, TT, 5632, e, smem, 1536);
          gemm_phase<0, 128>((const u16*)(p->ws + OFF_H), 1024, W2, 1024, 48 * 256, 256, e, smem, vbid, 24 * 256, 21 * 256);
        } else {
          gemm_phase_big<0>((const u16*)(p->ws + OFF_H), 1024, W2, 1024, TL, 5632, e, smem, 1280);
          gemm_phase<0, 256>((const u16*)(p->ws + OFF_H), 1024, W2, 1024, TL, 512, e, smem, vbid, 0, 20 * 256);
        }
      }
    }
    GBAR();
    {
      LOADP();
      float* xc = (float*)(p->ws + OFF_XC);
      Epi e{}; e.xs_lat = p->out; e.xs_ctx = xc; e.xd_lat = p->out; e.xd_ctx = xc;
      e.gate = (const float*)(p->ws + OFF_MOD) + (size_t)l * 9 * 9216 + 8 * 1024; e.coef = 0.5f;
      gemm_phase_big<1>((const u16*)(p->ws + OFF_ACT), DFF, (const u16*)(p->ws + OFF_WDN) + (size_t)1024 * DFF, DFF, TL, 1024, e, smem);
      if (need_ctx) gemm_phase<1, 64>((const u16*)(p->ws + OFF_ACT), DFF, (const u16*)(p->ws + OFF_WDN) + (size_t)1024 * DFF, DFF, TC, 1024, e, smem, vbid, TL);
    }
    GBAR();
    for (int rep = 0; rep < PROBE_SYNC; ++rep) GBAR();
  }
}

extern "C" void kernel_launch(void* const* d_in, const int* in_sizes, int n_in, void* d_out, int out_size, void* d_ws, size_t ws_size,
                              hipStream_t stream) {
  P p{};
  for (int i = 0; i < 37; ++i) p.in[i] = (const float*)d_in[i];
  p.out = (float*)d_out;
  p.ws = (unsigned char*)d_ws;
  p.pad_ = 0;
  static int grid_blocks = 0;
  if (!grid_blocks) {
    int dev = 0, cus = 0, per_cu = 0;
    hipGetDevice(&dev);
    hipDeviceGetAttribute(&cus, hipDeviceAttributeMultiprocessorCount, dev);
    hipOccupancyMaxActiveBlocksPerMultiprocessor(&per_cu, fwd_megakernel, 512, 0);
    if (per_cu < 1) per_cu = 1;
    grid_blocks = cus;
    if (ws_size < WS_TOTAL) fprintf(stderr, "workspace too small: %zu < %zu\n", ws_size, (size_t)WS_TOTAL);
  }
  hipMemsetAsync((unsigned char*)d_ws + OFF_CNT, 0, 256 + 14080, stream);
  void* args[] = {&p};
  hipError_t e = hipLaunchCooperativeKernel((void*)fwd_megakernel, dim3(grid_blocks), dim3(512), args, 0, stream);
  if (e != hipSuccess) fprintf(stderr, "cooperative launch failed: %s (grid %d)\n", hipGetErrorString(e), grid_blocks);
}
```

```cpp
#include <hip/hip_runtime.h>
#include <hip/hip_cooperative_groups.h>
#include <cstdio>
#include <cstdint>
namespace cg = cooperative_groups;

typedef unsigned short u16;
typedef short bf16x8 __attribute__((ext_vector_type(8)));
typedef short bf16x4 __attribute__((ext_vector_type(4)));
typedef float f32x4 __attribute__((ext_vector_type(4)));
typedef unsigned u32x4 __attribute__((ext_vector_type(4)));
typedef float f32x16 __attribute__((ext_vector_type(16)));
#define DEV __device__ __forceinline__

constexpr int TL = 16384, TC = 2048, TT = 18432, DM = 1024, DFF = 2816, PS = 3584;
constexpr int NA_OFF = 768, DN_OFF = 1536, RW_OFF = 2576;
constexpr int SMEM_BYTES = 147456;
#ifndef PROBE_SCAN
#define PROBE_SCAN 0
#endif
#ifndef PROBE_MODE
#define PROBE_MODE 6
#endif
#ifndef PROBE_GEMM
#define PROBE_GEMM 0
#endif
#ifndef PROBE_SYNC
#define PROBE_SYNC 0
#endif
#ifndef PROBE_P0
#define PROBE_P0 0
#endif
#ifndef PROBE_ADALN
#define PROBE_ADALN 0
#endif
#ifndef PROBE_PREP
#define PROBE_PREP 0
#endif
#ifndef PROBE_M2
#define PROBE_M2 0
#endif

constexpr size_t OFF_WGU = 0;
constexpr size_t OFF_WDN = OFF_WGU + (size_t)2 * 5632 * 1024 * 2;
constexpr size_t OFF_WIN = OFF_WDN + (size_t)2 * 1024 * 2816 * 2;
constexpr size_t OFF_WOUT = OFF_WIN + (size_t)3584 * 1024 * 2;
constexpr size_t OFF_XC = OFF_WOUT + (size_t)1024 * 1024 * 2;
constexpr size_t OFF_H = OFF_XC + (size_t)TC * 1024 * 4;
constexpr size_t OFF_MOD = OFF_H + (size_t)TT * 1024 * 2;
constexpr size_t FILT_LAYER = ((size_t)512 * 4096 + (size_t)512 * 512) * 2;
constexpr size_t OFF_FILT = OFF_MOD + (size_t)2 * 9 * 9216 * 4;
constexpr size_t OFF_FPART = OFF_FILT + 2 * FILT_LAYER;
constexpr size_t OFF_CNT = OFF_FPART + (size_t)2 * 72 * 1024 * 4;
constexpr size_t OFF_BAR = OFF_CNT + 256;
constexpr size_t BAR_BYTES = 3456 * 4;
constexpr size_t OFF_R1 = OFF_BAR + 14080;
constexpr size_t OFF_SLAB = OFF_R1;
constexpr size_t OFF_ACT = OFF_R1;
constexpr size_t OFF_HYZ = OFF_SLAB + (size_t)TT * PS * 2;
constexpr size_t OFF_HXT = OFF_HYZ + (size_t)TT * 256 * 2;
constexpr size_t OFF_DNO = OFF_HXT + (size_t)TT * 768 * 2;
constexpr size_t OFF_RWY = OFF_DNO + (size_t)TT * 256 * 4;
constexpr size_t OFF_RWL = OFF_RWY + (size_t)TT * 256 * 4;
constexpr size_t WS_TOTAL = OFF_RWL + (size_t)TT * 1024 * 2;

struct P {
  const float* in[37];
  float* out;
  unsigned char* ws;
  size_t pad_;
};
enum { I_X = 0, I_C, I_CTX, I_CCTX, I_WMOD, I_BMOD, I_NORMW, I_WGU, I_WDOWN, I_WIN, I_WOUT, I_HYCONV, I_HYW1, I_HYB1, I_HYW2,
       I_HYB2, I_HYW3, I_HYFREQ, I_HYBIAS, I_NAQN, I_NAKN, I_NARPB, I_DNCONV, I_DNALOG, I_DNDT, I_DNNORM, I_RWMU, I_RWW0,
       I_RWWUP, I_RWA0, I_RWAUP, I_RWGUP, I_RWKK, I_RWKA, I_RWRK, I_RWLNW, I_RWLNB };

typedef const P __attribute__((address_space(4)))* PC;
DEV PC launder(PC q) { asm volatile("" : "+s"(q)); return q; }
#define LOADP() PC p = launder(pk)

DEV u16 f2bf(float f) { unsigned u = __float_as_uint(f); u += 0x7fffu + ((u >> 16) & 1u); return (u16)(u >> 16); }
DEV float bf2f(u16 h) { return __uint_as_float(((unsigned)h) << 16); }
DEV float sigmoidf_(float x) { return __builtin_amdgcn_rcpf(1.f + __expf(-x)); }
DEV float siluf_(float x) { return x * __builtin_amdgcn_rcpf(1.f + __expf(-x)); }
DEV float softplusf_(float x) { return x > 20.f ? x : log1pf(__expf(x)); }
DEV float wave_sum(float v) {
#pragma unroll
  for (int o = 32; o > 0; o >>= 1) v += __shfl_xor(v, o);
  return v;
}
DEV float allred_rows(float x) {
  auto r = __builtin_amdgcn_permlane32_swap(__float_as_uint(x), __float_as_uint(x), false, false);
  float y = __uint_as_float(r[0]) + __uint_as_float(r[1]);
  auto r2 = __builtin_amdgcn_permlane16_swap(__float_as_uint(y), __float_as_uint(y), false, false);
  return __uint_as_float(r2[0]) + __uint_as_float(r2[1]);
}
DEV float allmax_rows(float x) {
  auto r = __builtin_amdgcn_permlane32_swap(__float_as_uint(x), __float_as_uint(x), false, false);
  float y = fmaxf(__uint_as_float(r[0]), __uint_as_float(r[1]));
  auto r2 = __builtin_amdgcn_permlane16_swap(__float_as_uint(y), __float_as_uint(y), false, false);
  return fmaxf(__uint_as_float(r2[0]), __uint_as_float(r2[1]));
}
DEV void unpack8(uint4 v, float* f) {
  f[0] = __uint_as_float(v.x << 16); f[1] = __uint_as_float(v.x & 0xffff0000u);
  f[2] = __uint_as_float(v.y << 16); f[3] = __uint_as_float(v.y & 0xffff0000u);
  f[4] = __uint_as_float(v.z << 16); f[5] = __uint_as_float(v.z & 0xffff0000u);
  f[6] = __uint_as_float(v.w << 16); f[7] = __uint_as_float(v.w & 0xffff0000u);
}
DEV unsigned pack2(float a, float b) { return (unsigned)f2bf(a) | ((unsigned)f2bf(b) << 16); }

DEV int TID() { int t = threadIdx.x; asm volatile("" : "+v"(t)); return t; }
DEV int BID() { int t = blockIdx.x; asm volatile("" : "+s"(t)); return t; }
DEV int NBLK() { int t = gridDim.x; asm volatile("" : "+s"(t)); return t; }
DEV int step_tok(int b, int dir, int s, int& pos, int& n) {
  if (s < 256) { n = 256; pos = dir ? 255 - s : s; return TL + b * 256 + pos; }
  n = 2048; pos = dir ? 2047 - (s - 256) : (s - 256); return b * 2048 + pos;
}

__device__ __attribute__((always_inline)) void task_mod(PC p, int task, unsigned char* smem) {
  float* sc = (float*)smem;
  float* part = (float*)(smem + 36864);
  const int tid = TID();
  for (int i = tid; i < 9 * 1024; i += 512) {
    int r = i >> 10, k = i & 1023;
    float v = (r < 8) ? p->in[I_C][r * 1024 + k] : p->in[I_CCTX][k];
    sc[i] = siluf_(v);
  }
  __syncthreads();
  const int l = task / 72, jj = tid & 127, j = (task % 72) * 128 + jj, kp = tid >> 7;
  const float* w = p->in[I_WMOD] + (size_t)l * 1024 * 9216 + j;
  float acc[9];
#pragma unroll
  for (int r = 0; r < 9; ++r) acc[r] = 0.f;
#pragma unroll 8
  for (int k = kp * 256; k < kp * 256 + 256; ++k) {
    float wv = w[(size_t)k * 9216];
#pragma unroll
    for (int r = 0; r < 9; ++r) acc[r] = fmaf(sc[r * 1024 + k], wv, acc[r]);
  }
#pragma unroll
  for (int r = 0; r < 9; ++r) part[(kp * 9 + r) * 128 + jj] = acc[r];
  __syncthreads();
  float* mod = (float*)(p->ws + OFF_MOD);
  for (int i = tid; i < 9 * 128; i += 512) {
    int r = i >> 7, c = i & 127;
    float s = part[(0 * 9 + r) * 128 + c] + part[(1 * 9 + r) * 128 + c] + part[(2 * 9 + r) * 128 + c] + part[(3 * 9 + r) * 128 + c];
    int jg = (task % 72) * 128 + c;
    mod[(size_t)(l * 9 + r) * 9216 + jg] = s + p->in[I_BMOD][l * 9216 + jg];
  }
  __syncthreads();
}

__device__ __attribute__((always_inline)) void task_filter(PC p, int task, unsigned char* smem) {
  float* z = (float*)smem;
  float* h1 = z + 32 * 34;
  float* h2t = h1 + 32 * 64;
  const int tid = TID();
  const int l = task / 72, ck = task % 72;
  const int ty = ck >= 64, n = ty ? 256 : 2048, chunk = ty ? ck - 64 : ck;
  const float* w1 = p->in[I_HYW1] + l * 33 * 64;
  const float* b1 = p->in[I_HYB1] + l * 64;
  const float* w2 = p->in[I_HYW2] + l * 64 * 64;
  const float* b2 = p->in[I_HYB2] + l * 64;
  const float* w3 = p->in[I_HYW3] + (size_t)l * 64 * 1024;
  const float* fr = p->in[I_HYFREQ] + l * 64;
  for (int i = tid; i < 32 * 33; i += 512) {
    int li = i / 33, e = i % 33;
    int lag = chunk * 32 + li;
    float v;
    if (e == 0) v = (float)lag / (float)(n - 1);
    else {
      float ang = (6.283185307179586f * (float)lag) / (float)n;
      int jb = (e - 1) & 15;
      float band = 1e-4f + (float)jb * ((15.f - 1e-4f) / 15.f);
      float a = band * ang;
      v = (e <= 16) ? cosf(a) : -sinf(a);
    }
    z[li * 34 + e] = v;
  }
  __syncthreads();
  for (int i = tid; i < 32 * 64; i += 512) {
    int li = i >> 6, m = i & 63;
    float s = b1[m];
    for (int e = 0; e < 33; ++e) s = fmaf(z[li * 34 + e], w1[e * 64 + m], s);
    h1[li * 64 + m] = sinf(fr[m] * s);
  }
  __syncthreads();
  for (int i = tid; i < 32 * 64; i += 512) {
    int li = i >> 6, m = i & 63;
    float s = b2[m];
    for (int e = 0; e < 64; ++e) s = fmaf(h1[li * 64 + e], w2[e * 64 + m], s);
    h2t[m * 32 + li] = sinf(fr[m] * s);
  }
  __syncthreads();
  u16* filt = (u16*)(p->ws + OFF_FILT + (size_t)l * FILT_LAYER) + (ty ? (size_t)512 * 4096 : 0);
  float* fpart = (float*)(p->ws + OFF_FPART) + (size_t)(l * 72 + ck) * 1024;
  const float min_decay = -4.605170185988091f / 1.5f, max_decay = -4.605170185988091f / 0.3f;
#pragma unroll 1
  for (int half = 0; half < 2; ++half) {
    const int o = tid + half * 512;
    float acc[32];
#pragma unroll
    for (int i = 0; i < 32; ++i) acc[i] = 0.f;
#pragma unroll 1
    for (int m0 = 0; m0 < 64; m0 += 8) {
      float wv8[8];
#pragma unroll
      for (int j = 0; j < 8; ++j) wv8[j] = w3[(m0 + j) * 1024 + o];
#pragma unroll
      for (int j = 0; j < 8; ++j) {
        const float wv = wv8[j];
#pragma unroll
        for (int q = 0; q < 8; ++q) {
          float4 hv = *(const float4*)(h2t + (m0 + j) * 32 + q * 4);
          acc[q * 4 + 0] = fmaf(hv.x, wv, acc[q * 4 + 0]);
          acc[q * 4 + 1] = fmaf(hv.y, wv, acc[q * 4 + 1]);
          acc[q * 4 + 2] = fmaf(hv.z, wv, acc[q * 4 + 2]);
          acc[q * 4 + 3] = fmaf(hv.w, wv, acc[q * 4 + 3]);
        }
      }
    }
    const int dir = o >> 9, oc = o & 511;
    const float delta = fabsf(min_decay + (float)oc * ((max_decay - min_decay) / 511.f));
    float asum = 0.f;
    u16* frow = filt + (size_t)oc * (2 * n);
#pragma unroll
    for (int li = 0; li < 32; ++li) {
      int lag = chunk * 32 + li;
      float t = (float)lag / (float)(n - 1);
      float v = acc[li] * __expf(-t * delta);
      if (dir == 0) { frow[n - 1 + lag] = f2bf(v); asum += fabsf(v); }
      else if (lag >= 1) { frow[n - 1 - lag] = f2bf(v); asum += fabsf(v); }
    }
    fpart[o] = asum;
  }
  __syncthreads();
}

DEV void lds_barrier() { asm volatile("s_waitcnt lgkmcnt(0)\n\ts_barrier" ::: "memory"); }
constexpr int NCONV_TILES = 2816 + 1408 + 896 + 256;
struct ConvDesc { const float* src; u16* dst; int K, N, ndt, kt, mode; };
DEV ConvDesc conv_desc(PC p, int l, int t) {
  ConvDesc d;
  if (t < 2816) {
    int f = t / 1408, r = t % 1408;
    d.src = p->in[I_WGU] + (size_t)(l * 2 + f) * 1024 * 5632; d.K = 1024; d.N = 5632; d.dst = (u16*)(p->ws + OFF_WGU) + (size_t)f * 5632 * 1024; d.ndt = r / 16; d.kt = r % 16; d.mode = 1;
  } else if (t < 2816 + 1408) {
    t -= 2816;
    int f = t / 704, r = t % 704;
    d.src = p->in[I_WDOWN] + (size_t)(l * 2 + f) * 2816 * 1024; d.K = 2816; d.N = 1024; d.dst = (u16*)(p->ws + OFF_WDN) + (size_t)f * 1024 * 2816; d.ndt = r / 44; d.kt = r % 44; d.mode = 0;
  } else if (t < 2816 + 1408 + 896) {
    t -= 2816 + 1408;
    d.src = p->in[I_WIN] + (size_t)l * 1024 * 3472; d.K = 1024; d.N = 3472; d.dst = (u16*)(p->ws + OFF_WIN); d.ndt = t / 16; d.kt = t % 16; d.mode = 2;
  } else {
    t -= 2816 + 1408 + 896;
    d.src = p->in[I_WOUT] + (size_t)l * 1024 * 1024; d.K = 1024; d.N = 1024; d.dst = (u16*)(p->ws + OFF_WOUT); d.ndt = t / 16; d.kt = t % 16; d.mode = 0;
  }
  return d;
}
DEV void conv_load(const ConvDesc& d, float* v) {
  const int tid = TID();
  const int nn = tid & 63, nd = d.ndt * 64 + nn;
  int col;
  if (d.mode == 1) { int g = nd >> 5, r = nd & 31; col = (r < 16) ? g * 16 + r : DFF + g * 16 + (r - 16); }
  else if (d.mode == 2) col = (nd < 3472) ? nd : 0;
  else col = nd;
  const float* sp = d.src + (size_t)(d.kt * 64 + (tid >> 6)) * d.N + col;
#pragma unroll
  for (int i = 0; i < 8; ++i) v[i] = sp[(size_t)(i * 8) * d.N];
}
DEV void conv_store(const ConvDesc& d, const float* v, unsigned char* smem) {
  float* tile = (float*)smem;
  const int tid = TID();
  const int nn0 = tid & 63;
  const bool pad = (d.mode == 2) && (d.ndt * 64 + nn0 >= 3472);
#pragma unroll
  for (int i = 0; i < 8; ++i) tile[((tid >> 6) + i * 8) * 65 + nn0] = pad ? 0.f : v[i];
  lds_barrier();
  {
    int nn = tid >> 3, kc = tid & 7;
    uint4 o;
    o.x = pack2(tile[(kc * 8 + 0) * 65 + nn], tile[(kc * 8 + 1) * 65 + nn]);
    o.y = pack2(tile[(kc * 8 + 2) * 65 + nn], tile[(kc * 8 + 3) * 65 + nn]);
    o.z = pack2(tile[(kc * 8 + 4) * 65 + nn], tile[(kc * 8 + 5) * 65 + nn]);
    o.w = pack2(tile[(kc * 8 + 6) * 65 + nn], tile[(kc * 8 + 7) * 65 + nn]);
    *(uint4*)(d.dst + (size_t)(d.ndt * 64 + nn) * d.K + d.kt * 64 + kc * 8) = o;
  }
  lds_barrier();
}
__device__ __attribute__((always_inline)) void convert_all(PC p, int l, unsigned char* smem) {
  const int nb = NBLK();
  int t = BID();
  if (t >= NCONV_TILES) return;
  __syncthreads();
  float cur[8], nxt[8];
  conv_load(conv_desc(p, l, t), cur);
#pragma unroll 1
  for (; t < NCONV_TILES; t += nb) {
    const int tn = (t + nb < NCONV_TILES) ? t + nb : t;
    conv_load(conv_desc(p, l, tn), nxt);
    conv_store(conv_desc(p, l, t), cur, smem);
#pragma unroll
    for (int i = 0; i < 8; ++i) cur[i] = nxt[i];
  }
  __syncthreads();
}

__device__ __attribute__((always_inline)) void adaln_pass(PC p, int l, int sub, const float* xlat, const float* xctx, int ntok) {
  const int lane = TID() & 63, wave = TID() >> 6;
  const float* nw = p->in[I_NORMW] + (l * 3 + sub) * 1024;
  const float* mod = (const float*)(p->ws + OFF_MOD) + (size_t)l * 9 * 9216;
  u16* H = (u16*)(p->ws + OFF_H);
  for (int tok = BID() * 8 + wave; tok < ntok; tok += NBLK() * 8) {
    const float* src = tok < TL ? xlat + (size_t)tok * 1024 : xctx + (size_t)(tok - TL) * 1024;
    const int r = tok < TL ? (tok >> 11) : 8;
    const float* sh = mod + (size_t)r * 9216 + (3 * sub) * 1024;
    const float* sc = sh + 1024;
    float4 v[4];
    float ss = 0.f;
#pragma unroll
    for (int i = 0; i < 4; ++i) {
      v[i] = *(const float4*)(src + i * 256 + lane * 4);
      ss += v[i].x * v[i].x + v[i].y * v[i].y + v[i].z * v[i].z + v[i].w * v[i].w;
    }
    ss = wave_sum(ss);
    const float rinv = rsqrtf(ss * (1.f / 1024.f) + 1e-6f);
#pragma unroll
    for (int i = 0; i < 4; ++i) {
      const int c = i * 256 + lane * 4;
      float4 w4 = *(const float4*)(nw + c), s4 = *(const float4*)(sc + c), h4 = *(const float4*)(sh + c);
      float a = v[i].x * rinv * w4.x * (1.f + s4.x) + h4.x;
      float b = v[i].y * rinv * w4.y * (1.f + s4.y) + h4.y;
      float c2 = v[i].z * rinv * w4.z * (1.f + s4.z) + h4.z;
      float d = v[i].w * rinv * w4.w * (1.f + s4.w) + h4.w;
      uint2 o; o.x = pack2(a, b); o.y = pack2(c2, d);
      *(uint2*)(H + (size_t)tok * 1024 + c) = o;
    }
  }
}

struct Epi {
  u16* outb; const float* xs_lat; const float* xs_ctx; float* xd_lat; float* xd_ctx; const float* gate; float coef;
};
template <int MODE, int BM = 256>
__device__ __attribute__((always_inline)) void gemm_phase(const u16* __restrict__ A, int lda, const u16* __restrict__ Bt, int K, int M, int N, Epi e, unsigned char* smem, int vbid, int row0 = 0, int col0 = 0) {
  constexpr int BUF = (256 + 128) * 72;
  constexpr int MI = BM / 64;
  constexpr int WM = BM / 4;
  u16* L = (u16*)smem;
  const int tid = TID(), lane = tid & 63, wave = tid >> 6, wm = wave >> 1, wn = wave & 1;
  const int nMt = M / BM, nNt = N / 128, ntiles = nMt * nNt, nk = K / 64;
  const int lrow = tid >> 3, lch = tid & 7;
  const int fr = lane & 15, fq = lane >> 4;
  const int nb_ = NBLK();
  const bool swz = (vbid >= 0) && (nb_ == 256) && (nMt % 8 == 0) && (nNt % 4 == 0);
  int bid_ = swz ? vbid : BID();
  asm volatile("" : "+s"(bid_));
  const int nPM = nMt >> 3, npatch = nPM * (nNt >> 2);
  for (int it = 0;; ++it) {
    int mt, nt;
    if (swz) {
      const int pi = it * 8 + (bid_ & 7);
      if (pi >= npatch) break;
      mt = (pi % nPM) * 8 + ((bid_ >> 3) & 7);
      nt = (pi / nPM) * 4 + (bid_ >> 6);
    } else {
      const int tile = bid_ + it * nb_;
      if (tile >= ntiles) break;
      mt = tile % nMt; nt = tile / nMt;
    }
    const int m0 = row0 + mt * BM, n0 = col0 + nt * 128;
    f32x4 acc[MI][4];
#pragma unroll
    for (int i = 0; i < MI; ++i)
#pragma unroll
      for (int j = 0; j < 4; ++j) acc[i][j] = (f32x4){0.f, 0.f, 0.f, 0.f};
    const u16* Ap = A + (size_t)(m0 + lrow) * lda + lch * 8;
    const u16* Bp = Bt + (size_t)(n0 + lrow) * K + lch * 8;
    u32x4 ra0[MI], rb0[2], ra1[MI], rb1[2];
#define G_LOAD(RA, RB, KT) do { const int ko_ = (KT) * 64; \
      _Pragma("unroll") for (int i = 0; i < MI; ++i) RA[i] = *(const u32x4*)(Ap + (size_t)(i * 64) * lda + ko_); \
      _Pragma("unroll") for (int i = 0; i < 2; ++i) RB[i] = *(const u32x4*)(Bp + (size_t)(i * 64) * K + ko_); } while (0)
#define L_STORE(RA, RB, BUFI) do { u16* W_ = L + (BUFI) * BUF; \
      _Pragma("unroll") for (int i = 0; i < MI; ++i) *(u32x4*)(W_ + (lrow + i * 64) * 72 + lch * 8) = RA[i]; \
      _Pragma("unroll") for (int i = 0; i < 2; ++i) *(u32x4*)(W_ + 256 * 72 + (lrow + i * 64) * 72 + lch * 8) = RB[i]; } while (0)
#define FRAGS(AF, BF, BUFI, KS) do { const u16* As = L + (BUFI) * BUF; const u16* Bs = As + 256 * 72; \
      _Pragma("unroll") for (int mi = 0; mi < MI; ++mi) AF[mi] = *(const bf16x8*)(As + (wm * WM + mi * 16 + fr) * 72 + (KS) * 32 + fq * 8); \
      _Pragma("unroll") for (int ni = 0; ni < 4; ++ni) BF[ni] = *(const bf16x8*)(Bs + (wn * 64 + ni * 16 + fr) * 72 + (KS) * 32 + fq * 8); } while (0)
#define MMA16(AF, BF) do { \
      _Pragma("unroll") for (int mi = 0; mi < MI; ++mi) \
        _Pragma("unroll") for (int ni = 0; ni < 4; ++ni) acc[mi][ni] = __builtin_amdgcn_mfma_f32_16x16x32_bf16(BF[ni], AF[mi], acc[mi][ni], 0, 0, 0); } while (0)
#define KSTEP(BUFI, RA, RB, NBUFI) do { \
      bf16x8 af0[MI], bf0[4], af1[MI], bf1[4]; \
      FRAGS(af0, bf0, BUFI, 0); \
      __builtin_amdgcn_sched_barrier(0); \
      FRAGS(af1, bf1, BUFI, 1); \
      MMA16(af0, bf0); \
      if (MI >= 3) { _Pragma("unroll") for (int q_ = 0; q_ < MI * 2; ++q_) { __builtin_amdgcn_sched_group_barrier(0x008, 2, 0); __builtin_amdgcn_sched_group_barrier(0x100, 1, 0); } } \
      if (MI == 3) __builtin_amdgcn_sched_group_barrier(0x100, 1, 0); \
      __builtin_amdgcn_sched_barrier(0); \
      L_STORE(RA, RB, NBUFI); \
      MMA16(af1, bf1); \
      if (MI >= 3) { _Pragma("unroll") for (int q_ = 0; q_ < MI + 2; ++q_) { __builtin_amdgcn_sched_group_barrier(0x008, 2, 0); __builtin_amdgcn_sched_group_barrier(0x200, 1, 0); } \
        __builtin_amdgcn_sched_group_barrier(0x008, (MI >= 3) ? MI * 4 - 2 * (MI + 2) : 0, 0); } \
      __builtin_amdgcn_sched_barrier(0); \
      } while (0)
    G_LOAD(ra0, rb0, 0);
    G_LOAD(ra1, rb1, 1);
    __syncthreads();
    L_STORE(ra0, rb0, 0);
    __syncthreads();
    for (int kt = 0; kt < nk; kt += 2) {
      G_LOAD(ra0, rb0, min(kt + 2, nk - 1));
      KSTEP(0, ra1, rb1, 1);
      lds_barrier();
      G_LOAD(ra1, rb1, min(kt + 3, nk - 1));
      KSTEP(1, ra0, rb0, 0);
      lds_barrier();
    }
    asm volatile("s_waitcnt vmcnt(0)" ::: "memory");
#undef FRAGS
#undef MMA16
#undef KSTEP
#undef G_LOAD
#undef L_STORE
    if (MODE == 0) {
#pragma unroll
      for (int mi = 0; mi < MI; ++mi) {
        const int tok = m0 + wm * WM + mi * 16 + fr;
#pragma unroll
        for (int np = 0; np < 2; ++np) {
          const int ffc = ((n0 + wn * 64) >> 1) + np * 16 + fq * 4;
          const f32x4 g = acc[mi][np * 2], u = acc[mi][np * 2 + 1];
          uint2 o;
          o.x = pack2(siluf_(g[0]) * u[0], siluf_(g[1]) * u[1]);
          o.y = pack2(siluf_(g[2]) * u[2], siluf_(g[3]) * u[3]);
          *(uint2*)(e.outb + (size_t)tok * DFF + ffc) = o;
        }
      }
    } else if (MODE == 1) {
#pragma unroll
      for (int mi = 0; mi < MI; ++mi) {
        const int tok = m0 + wm * WM + mi * 16 + fr;
        const bool isctx = tok >= TL;
        const int r = isctx ? 8 : (tok >> 11);
        const float* xs = isctx ? e.xs_ctx + (size_t)(tok - TL) * 1024 : e.xs_lat + (size_t)tok * 1024;
        float* xd = isctx ? e.xd_ctx + (size_t)(tok - TL) * 1024 : e.xd_lat + (size_t)tok * 1024;
        const float* g = e.gate + (size_t)r * 9216;
#pragma unroll
        for (int ni = 0; ni < 4; ++ni) {
          const int col = n0 + wn * 64 + ni * 16 + fq * 4;
          const float4 gv = *(const float4*)(g + col);
          const float4 xv = *(const float4*)(xs + col);
          float4 o;
          o.x = xv.x + gv.x * e.coef * acc[mi][ni][0];
          o.y = xv.y + gv.y * e.coef * acc[mi][ni][1];
          o.z = xv.z + gv.z * e.coef * acc[mi][ni][2];
          o.w = xv.w + gv.w * e.coef * acc[mi][ni][3];
          *(float4*)(xd + col) = o;
        }
        __builtin_amdgcn_sched_barrier(0);
      }
    } else {
#pragma unroll
      for (int mi = 0; mi < MI; ++mi) {
        const int tok = m0 + wm * WM + mi * 16 + fr;
#pragma unroll
        for (int ni = 0; ni < 4; ++ni) {
          const int col = n0 + wn * 64 + ni * 16 + fq * 4;
          uint2 o;
          o.x = pack2(acc[mi][ni][0], acc[mi][ni][1]);
          o.y = pack2(acc[mi][ni][2], acc[mi][ni][3]);
          *(uint2*)(e.outb + (size_t)tok * PS + col) = o;
        }
      }
    }
  }
}

template <int MODE>
__device__ __attribute__((always_inline)) void gemm_phase_big(const u16* __restrict__ A, int lda, const u16* __restrict__ Bt, int K, int M, int N, Epi e, unsigned char* smem, int tile_limit = 1 << 30) {
  constexpr int BUF = 512 * 72;
  u16* L = (u16*)smem;
  const int tid = TID(), lane = tid & 63, wave = tid >> 6, wm = wave >> 1, wn = wave & 1;
  const int nMt = M / 256, nNt = N / 256, ntiles = nMt * nNt, nk = K / 64;
  const int lrow = tid >> 3, lch = tid & 7;
  const int fr = lane & 15, fq = lane >> 4;
  const int nb_ = NBLK();
  const int tend = min(ntiles, tile_limit);
  for (int tile = BID(); tile < tend; tile += nb_) {
    const int mt = tile % nMt, nt = tile / nMt;
    const int m0 = mt * 256, n0 = nt * 256;
    f32x4 acc[4][8];
#pragma unroll
    for (int i = 0; i < 4; ++i)
#pragma unroll
      for (int j = 0; j < 8; ++j) acc[i][j] = (f32x4){0.f, 0.f, 0.f, 0.f};
    const u16* Ap = A + (size_t)(m0 + lrow) * lda + lch * 8;
    const u16* Bp = Bt + (size_t)(n0 + lrow) * K + lch * 8;
    u32x4 ra[4], rb[4];
#define G_LOADB(KT) do { const int ko_ = (KT) * 64; \
      _Pragma("unroll") for (int i = 0; i < 4; ++i) ra[i] = *(const u32x4*)(Ap + (size_t)(i * 64) * lda + ko_); \
      _Pragma("unroll") for (int i = 0; i < 4; ++i) rb[i] = *(const u32x4*)(Bp + (size_t)(i * 64) * K + ko_); } while (0)
#define L_STOREB(BUFI) do { u16* W_ = L + (BUFI) * BUF; \
      _Pragma("unroll") for (int i = 0; i < 4; ++i) *(u32x4*)(W_ + (lrow + i * 64) * 72 + lch * 8) = ra[i]; \
      _Pragma("unroll") for (int i = 0; i < 4; ++i) *(u32x4*)(W_ + 256 * 72 + (lrow + i * 64) * 72 + lch * 8) = rb[i]; } while (0)
    G_LOADB(0);
    __syncthreads();
    L_STOREB(0);
    G_LOADB(min(1, nk - 1));
    __syncthreads();
#define FRAGSB(KS) do { \
        _Pragma("unroll") for (int mi = 0; mi < 4; ++mi) af[mi] = *(const bf16x8*)(As + (wm * 64 + mi * 16 + fr) * 72 + (KS) * 32 + fq * 8); \
        _Pragma("unroll") for (int ni = 0; ni < 8; ++ni) bfr[ni] = *(const bf16x8*)(Bs + (wn * 128 + ni * 16 + fr) * 72 + (KS) * 32 + fq * 8); } while (0)
#define MMAB() do { \
        _Pragma("unroll") for (int ni = 0; ni < 8; ++ni) \
          _Pragma("unroll") for (int mi = 0; mi < 4; ++mi) acc[mi][ni] = __builtin_amdgcn_mfma_f32_16x16x32_bf16(bfr[ni], af[mi], acc[mi][ni], 0, 0, 0); } while (0)
    for (int kt = 0; kt < nk; ++kt) {
      const u16* As = L + (kt & 1) * BUF;
      const u16* Bs = As + 256 * 72;
      bf16x8 af[4], bfr[8];
      FRAGSB(0);
      __builtin_amdgcn_sched_barrier(0);
      MMAB();
      L_STOREB((kt + 1) & 1);
#pragma unroll
      for (int q_ = 0; q_ < 8; ++q_) { __builtin_amdgcn_sched_group_barrier(0x008, 4, 0); __builtin_amdgcn_sched_group_barrier(0x200, 1, 0); }
      __builtin_amdgcn_sched_barrier(0);
      G_LOADB(min(kt + 2, nk - 1));
      FRAGSB(1);
      __builtin_amdgcn_sched_barrier(0);
      MMAB();
      __builtin_amdgcn_sched_barrier(0);
      lds_barrier();
    }
#undef FRAGSB
#undef MMAB
    asm volatile("s_waitcnt vmcnt(0)" ::: "memory");
#undef G_LOADB
#undef L_STOREB
    if (MODE == 0) {
#pragma unroll
      for (int mi = 0; mi < 4; ++mi) {
        const int tok = m0 + wm * 64 + mi * 16 + fr;
#pragma unroll
        for (int np = 0; np < 4; ++np) {
          const int ffc = ((n0 + wn * 128) >> 1) + np * 16 + fq * 4;
          const f32x4 g = acc[mi][np * 2], u = acc[mi][np * 2 + 1];
          uint2 o;
          o.x = pack2(siluf_(g[0]) * u[0], siluf_(g[1]) * u[1]);
          o.y = pack2(siluf_(g[2]) * u[2], siluf_(g[3]) * u[3]);
          *(uint2*)(e.outb + (size_t)tok * DFF + ffc) = o;
        }
      }
    } else if (MODE == 1) {
#pragma unroll
      for (int mi = 0; mi < 4; ++mi) {
        const int tok = m0 + wm * 64 + mi * 16 + fr;
        const bool isctx = tok >= TL;
        const int r = isctx ? 8 : (tok >> 11);
        const float* xs = isctx ? e.xs_ctx + (size_t)(tok - TL) * 1024 : e.xs_lat + (size_t)tok * 1024;
        float* xd = isctx ? e.xd_ctx + (size_t)(tok - TL) * 1024 : e.xd_lat + (size_t)tok * 1024;
        const float* g = e.gate + (size_t)r * 9216;
#pragma unroll
        for (int ni = 0; ni < 8; ++ni) {
          const int col = n0 + wn * 128 + ni * 16 + fq * 4;
          const float4 gv = *(const float4*)(g + col);
          const float4 xv = *(const float4*)(xs + col);
          float4 o;
          o.x = xv.x + gv.x * e.coef * acc[mi][ni][0];
          o.y = xv.y + gv.y * e.coef * acc[mi][ni][1];
          o.z = xv.z + gv.z * e.coef * acc[mi][ni][2];
          o.w = xv.w + gv.w * e.coef * acc[mi][ni][3];
          *(float4*)(xd + col) = o;
        }
        __builtin_amdgcn_sched_barrier(0);
      }
    } else {
#pragma unroll
      for (int mi = 0; mi < 4; ++mi) {
        const int tok = m0 + wm * 64 + mi * 16 + fr;
#pragma unroll
        for (int ni = 0; ni < 8; ++ni) {
          const int col = n0 + wn * 128 + ni * 16 + fq * 4;
          uint2 o;
          o.x = pack2(acc[mi][ni][0], acc[mi][ni][1]);
          o.y = pack2(acc[mi][ni][2], acc[mi][ni][3]);
          *(uint2*)(e.outb + (size_t)tok * PS + col) = o;
        }
      }
    }
  }
}

template <int NT>
__device__ __attribute__((always_inline)) void prep_task(PC p, int l, int tok0, unsigned char* smem) {
  float* raw = (float*)smem;
  float* sv = raw + (NT + 2) * 64;
  const int tid = TID();
  const u16* slab = (const u16*)(p->ws + OFF_SLAB);
  int base, n;
  if (tok0 < TL) { base = (tok0 >> 11) << 11; n = 2048; } else { base = TL + (((tok0 - TL) >> 8) << 8); n = 256; }
  const int pos0 = tok0 - base;
  for (int i = tid; i < (NT + 2) * 64; i += 512) {
    int rr = i >> 6, j = i & 63, pos = pos0 - 1 + rr;
    raw[i] = (pos >= 0 && pos < n) ? bf2f(slab[(size_t)(base + pos) * PS + RW_OFF + 768 + j]) : 0.f;
  }
  __syncthreads();
  const float* mu = p->in[I_RWMU] + l * 2 * 896;
  for (int i = tid; i < NT * 64; i += 512) {
    int t = i >> 6, j = i & 63;
    float u = raw[(t + 1) * 64 + j], pv = raw[t * 64 + j], nx = raw[(t + 2) * 64 + j];
    float s = u + mu[768 + j] * (pv - u) + mu[896 + 768 + j] * (nx - u);
    if (j < 32) s = tanhf(s);
    sv[i] = s;
  }
  __syncthreads();
  {
    const int c = tid & 255, d = tid >> 8;
    const float* wup = p->in[I_RWWUP] + (size_t)(l * 2 + d) * 32 * 256 + c;
    const float* aup = p->in[I_RWAUP] + (size_t)(l * 2 + d) * 32 * 256 + c;
    float wu[32], au[32];
#pragma unroll
    for (int j = 0; j < 32; ++j) { wu[j] = wup[j * 256]; au[j] = aup[j * 256]; }
    u16* rwl = (u16*)(p->ws + OFF_RWL);
    const float rw_w0 = p->in[I_RWW0][(l * 2 + d) * 256 + c], rw_a0 = p->in[I_RWA0][(l * 2 + d) * 256 + c];
#pragma unroll 2
    for (int t = 0; t < NT; ++t) {
      float aw = 0.f, aa = 0.f;
#pragma unroll
      for (int q = 0; q < 8; ++q) {
        float4 x = *(const float4*)(sv + t * 64 + q * 4);
        float4 y = *(const float4*)(sv + t * 64 + 32 + q * 4);
        aw = fmaf(x.x, wu[q * 4], aw); aw = fmaf(x.y, wu[q * 4 + 1], aw); aw = fmaf(x.z, wu[q * 4 + 2], aw); aw = fmaf(x.w, wu[q * 4 + 3], aw);
        aa = fmaf(y.x, au[q * 4], aa); aa = fmaf(y.y, au[q * 4 + 1], aa); aa = fmaf(y.z, au[q * 4 + 2], aa); aa = fmaf(y.w, au[q * 4 + 3], aa);
      }
      const float zz = -(rw_w0 + aw);
      const float sp = zz > 20.f ? zz : __logf(1.f + __expf(zz));
      rwl[(size_t)(tok0 + t) * 1024 + d * 512 + c] = f2bf(__expf(-sp - 0.5f));
      rwl[(size_t)(tok0 + t) * 1024 + d * 512 + 256 + c] = f2bf(sigmoidf_(rw_a0 + aa));
    }
  }
  {
    const float* hc = p->in[I_HYCONV] + l * 3 * 768;
    u16* hxt = (u16*)(p->ws + OFF_HXT);
#pragma unroll 1
    for (int cidx = tid; cidx < 768; cidx += 512) {
      const float w0 = hc[cidx], w1 = hc[768 + cidx], w2 = hc[1536 + cidx];
      float pv = pos0 > 0 ? bf2f(slab[(size_t)(tok0 - 1) * PS + cidx]) : 0.f;
      float cur = bf2f(slab[(size_t)tok0 * PS + cidx]);
      unsigned pk[NT / 2];
#pragma unroll
      for (int t = 0; t < NT; t += 2) {
        float nx0 = (pos0 + t + 1 < n) ? bf2f(slab[(size_t)(tok0 + t + 1) * PS + cidx]) : 0.f;
        float v0 = w0 * pv + w1 * cur + w2 * nx0;
        float nx1 = (pos0 + t + 2 < n) ? bf2f(slab[(size_t)(tok0 + t + 2) * PS + cidx]) : 0.f;
        float v1 = w0 * cur + w1 * nx0 + w2 * nx1;
        pk[t >> 1] = pack2(v0, v1);
        pv = nx0; cur = nx1;
      }
      uint4* dst = (uint4*)(hxt + (size_t)cidx * TT + tok0);
#pragma unroll
      for (int q = 0; q < NT / 8; ++q) dst[q] = make_uint4(pk[4 * q], pk[4 * q + 1], pk[4 * q + 2], pk[4 * q + 3]);
    }
  }
  __syncthreads();
}

typedef float f32x2 __attribute__((ext_vector_type(2)));
DEV float quad_sum(float x) {
  x += __builtin_bit_cast(float, __builtin_amdgcn_update_dpp(0, __builtin_bit_cast(int, x), 0xB1, 0xf, 0xf, true));
  x += __builtin_bit_cast(float, __builtin_amdgcn_update_dpp(0, __builtin_bit_cast(int, x), 0x4E, 0xf, 0xf, true));
  return x;
}
constexpr int DN_STRIDE = 200, RW_STRIDE = 392, CHUNK = 16, NCHUNK = 2304 / CHUNK;
DEV void ld16(f32x2* o, const float* d) {
#pragma unroll
  for (int i = 0; i < 4; ++i) {
    float4 a = *(const float4*)(d + i * 4);
    o[2 * i] = (f32x2){a.x, a.y};
    o[2 * i + 1] = (f32x2){a.z, a.w};
  }
}
struct DnOps { f32x2 q[8], k[8]; float vv, a, be, kq; };
DEV void dn_load(DnOps& o, const float* d, int kp, int col) {
  ld16(o.q, d + kp * 16); ld16(o.k, d + 64 + kp * 16);
  o.vv = d[128 + col]; o.a = d[192]; o.be = d[193]; o.kq = d[194];
}
DEV float dn_step(f32x2* S, const DnOps& c) {
  f32x2 a1 = (f32x2){0.f, 0.f}, a2 = (f32x2){0.f, 0.f};
#pragma unroll
  for (int i = 0; i < 8; ++i) { a1 = __builtin_elementwise_fma(S[i], c.k[i], a1); a2 = __builtin_elementwise_fma(S[i], c.q[i], a2); }
  const float dk = quad_sum(a1.x + a1.y), dq = quad_sum(a2.x + a2.y);
  const float cc = c.be * (c.vv - c.a * dk);
  const f32x2 a2v = (f32x2){c.a, c.a}, c2v = (f32x2){cc, cc};
#pragma unroll
  for (int i = 0; i < 8; ++i) { S[i] = S[i] * a2v; S[i] = __builtin_elementwise_fma(c.k[i], c2v, S[i]); }
  return c.a * dq + cc * c.kq;
}
struct RwOps { f32x2 wr[8], w[8], kd[8], av[8], bv[8]; float vv, s1, s2; };
DEV void rw_load(RwOps& o, const float* d, int kp, int col) {
  ld16(o.wr, d + kp * 16); ld16(o.w, d + 64 + kp * 16); ld16(o.kd, d + 128 + kp * 16); ld16(o.av, d + 192 + kp * 16); ld16(o.bv, d + 256 + kp * 16);
  o.vv = d[320 + col]; o.s1 = d[384]; o.s2 = d[385];
}
DEV float rw_step(f32x2* S, const RwOps& c) {
  f32x2 a1 = (f32x2){0.f, 0.f}, a2 = (f32x2){0.f, 0.f};
#pragma unroll
  for (int i = 0; i < 8; ++i) { a1 = __builtin_elementwise_fma(S[i], c.av[i], a1); a2 = __builtin_elementwise_fma(S[i], c.wr[i], a2); }
  const float sa = quad_sum(a1.x + a1.y), yp = quad_sum(a2.x + a2.y);
  const f32x2 sa2 = (f32x2){sa, sa}, v2 = (f32x2){c.vv, c.vv};
#pragma unroll
  for (int i = 0; i < 8; ++i) { S[i] = S[i] * c.w[i]; S[i] = __builtin_elementwise_fma(sa2, c.bv[i], S[i]); S[i] = __builtin_elementwise_fma(v2, c.kd[i], S[i]); }
  return yp + sa * c.s1 + c.vv * c.s2;
}

DEV float wave_allsum_dpp(float x) {
  x += __builtin_bit_cast(float, __builtin_amdgcn_update_dpp(0, __builtin_bit_cast(int, x), 0xB1, 0xf, 0xf, true));
  x += __builtin_bit_cast(float, __builtin_amdgcn_update_dpp(0, __builtin_bit_cast(int, x), 0x4E, 0xf, 0xf, true));
  x += __builtin_bit_cast(float, __builtin_amdgcn_update_dpp(0, __builtin_bit_cast(int, x), 0x124, 0xf, 0xf, true));
  x += __builtin_bit_cast(float, __builtin_amdgcn_update_dpp(0, __builtin_bit_cast(int, x), 0x128, 0xf, 0xf, true));
  return allred_rows(x);
}
DEV float softplus_fast(float x) { return x > 20.f ? x : __logf(1.f + __expf(x)); }

DEV float oct_sum(float x) {
  x += __builtin_bit_cast(float, __builtin_amdgcn_update_dpp(0, __builtin_bit_cast(int, x), 0xB1, 0xf, 0xf, true));
  x += __builtin_bit_cast(float, __builtin_amdgcn_update_dpp(0, __builtin_bit_cast(int, x), 0x4E, 0xf, 0xf, true));
  x += __builtin_bit_cast(float, __builtin_amdgcn_update_dpp(0, __builtin_bit_cast(int, x), 0x141, 0xf, 0xf, true));
  return x;
}
DEV void ld8(f32x2* o, const float* d) {
#pragma unroll
  for (int i = 0; i < 2; ++i) {
    float4 a = *(const float4*)(d + i * 4);
    o[2 * i] = (f32x2){a.x, a.y};
    o[2 * i + 1] = (f32x2){a.z, a.w};
  }
}
struct RwOps8 { f32x2 wr[4], w[4], kd[4], av[4], bv[4]; float vv, s1, s2; };
DEV void rw_load8(RwOps8& o, const float* d, int kp, int row) {
  ld8(o.wr, d + kp * 8); ld8(o.w, d + 64 + kp * 8); ld8(o.kd, d + 128 + kp * 8); ld8(o.av, d + 192 + kp * 8); ld8(o.bv, d + 256 + kp * 8);
  o.vv = d[320 + row]; o.s1 = d[384]; o.s2 = d[385];
}
DEV float rw_step8(f32x2* S, const RwOps8& c) {
  f32x2 a1 = (f32x2){0.f, 0.f}, a2 = (f32x2){0.f, 0.f};
#pragma unroll
  for (int i = 0; i < 4; ++i) { a1 = __builtin_elementwise_fma(S[i], c.av[i], a1); a2 = __builtin_elementwise_fma(S[i], c.wr[i], a2); }
  const float sa = oct_sum(a1.x + a1.y), yp = oct_sum(a2.x + a2.y);
  const f32x2 sa2 = (f32x2){sa, sa}, v2 = (f32x2){c.vv, c.vv};
#pragma unroll
  for (int i = 0; i < 4; ++i) { S[i] = S[i] * c.w[i]; S[i] = __builtin_elementwise_fma(sa2, c.bv[i], S[i]); S[i] = __builtin_elementwise_fma(v2, c.kd[i], S[i]); }
  return yp + sa * c.s1 + c.vv * c.s2;
}

struct DnRaw { uint4 c[3], pv[3], nx[3]; unsigned xa, xb; float fp, fn; };
DEV void dn_prep_load(DnRaw& R, PC p, int b, int hd, int dir, int ci) {
  const int ptid = TID() - 256;
  const u16* slab = (const u16*)(p->ws + OFF_SLAB);
  const int st = (ptid >> 3) & 15, g = ptid & 7;
  int pos, n;
  const int tok = step_tok(b, dir, ci * CHUNK + st, pos, n);
  const int tp = pos > 0 ? tok - 1 : tok, tn = pos < n - 1 ? tok + 1 : tok;
  R.fp = pos > 0 ? 1.f : 0.f; R.fn = pos < n - 1 ? 1.f : 0.f;
#pragma unroll
  for (int v3 = 0; v3 < 3; ++v3) {
    const int col = DN_OFF + v3 * 256 + hd * 64 + g * 8;
    R.c[v3] = *(const uint4*)(slab + (size_t)tok * PS + col);
    R.pv[v3] = *(const uint4*)(slab + (size_t)tp * PS + col);
    R.nx[v3] = *(const uint4*)(slab + (size_t)tn * PS + col);
  }
  int pos2, n2;
  const int tok2 = step_tok(b, dir, ci * CHUNK + (ptid & 15), pos2, n2);
  R.xb = slab[(size_t)tok2 * PS + DN_OFF + 1024 + dir * 8 + hd];
  R.xa = slab[(size_t)tok2 * PS + DN_OFF + 1024 + dir * 8 + 4 + hd];
}
DEV void dn_prep_compute(const DnRaw& R, float* dst, const float* cw, float Aexp, float dtb) {
  const int ptid = TID() - 256;
  if (ptid < 128) {
    const int st = ptid >> 3, g = ptid & 7;
    float res[3][8];
    float ssq = 0.f, ssk = 0.f, qk = 0.f;
#pragma unroll
    for (int v3 = 0; v3 < 3; ++v3) {
      float cur[8], pv[8], nx[8];
      unpack8(R.c[v3], cur); unpack8(R.pv[v3], pv); unpack8(R.nx[v3], nx);
      const float* c0 = cw + v3 * 64 + g * 8;
#pragma unroll
      for (int e = 0; e < 8; ++e) res[v3][e] = siluf_(c0[e] * R.fp * pv[e] + c0[192 + e] * cur[e] + c0[384 + e] * R.fn * nx[e]);
    }
#pragma unroll
    for (int e = 0; e < 8; ++e) { ssq += res[0][e] * res[0][e]; ssk += res[1][e] * res[1][e]; qk += res[0][e] * res[1][e]; }
    ssq += __shfl_xor(ssq, 1); ssq += __shfl_xor(ssq, 2); ssq += __shfl_xor(ssq, 4);
    ssk += __shfl_xor(ssk, 1); ssk += __shfl_xor(ssk, 2); ssk += __shfl_xor(ssk, 4);
    qk += __shfl_xor(qk, 1); qk += __shfl_xor(qk, 2); qk += __shfl_xor(qk, 4);
    const float scq = rsqrtf(ssq + 1e-6f) * 0.125f, sck = rsqrtf(ssk + 1e-6f);
    float* d = dst + st * DN_STRIDE + g * 8;
    *(float4*)d = make_float4(res[0][0] * scq, res[0][1] * scq, res[0][2] * scq, res[0][3] * scq);
    *(float4*)(d + 4) = make_float4(res[0][4] * scq, res[0][5] * scq, res[0][6] * scq, res[0][7] * scq);
    *(float4*)(d + 64) = make_float4(res[1][0] * sck, res[1][1] * sck, res[1][2] * sck, res[1][3] * sck);
    *(float4*)(d + 68) = make_float4(res[1][4] * sck, res[1][5] * sck, res[1][6] * sck, res[1][7] * sck);
    *(float4*)(d + 128) = make_float4(res[2][0], res[2][1], res[2][2], res[2][3]);
    *(float4*)(d + 132) = make_float4(res[2][4], res[2][5], res[2][6], res[2][7]);
    if (g == 0) dst[st * DN_STRIDE + 194] = qk * scq * sck;
  } else if (ptid < 128 + CHUNK) {
    const int st = ptid - 128;
    const float g = -Aexp * softplus_fast(bf2f((u16)R.xa) + dtb);
    dst[st * DN_STRIDE + 192] = __expf(g);
    dst[st * DN_STRIDE + 193] = sigmoidf_(bf2f((u16)R.xb));
  }
}

__device__ __attribute__((always_inline)) void dn_scan_unit(PC p, int l, int unit, unsigned char* smem, const int MODE = 7) {
  const int b = unit >> 3, hd = (unit >> 1) & 3, dir = unit & 1;
  float* buf = (float*)smem;
  float* cw = buf + 2 * CHUNK * DN_STRIDE + 64;
  const int tid = TID(), wave = tid >> 6, lane = tid & 63;
  __syncthreads();
  for (int i = tid; i < 576; i += 512) {
    int tap = i / 192, rem = i % 192, v3 = rem >> 6, d = rem & 63;
    cw[i] = p->in[I_DNCONV][(l * 3 + tap) * 768 + v3 * 256 + hd * 64 + d];
  }
  const float Aexp = __expf(p->in[I_DNALOG][l * 8 + dir * 4 + hd]);
  const float dtb = p->in[I_DNDT][l * 8 + dir * 4 + hd];
  u16* dno = (u16*)(p->ws + OFF_DNO) + (size_t)dir * TT * 256;
  __syncthreads();
  f32x2 S[8];
#pragma unroll
  for (int j = 0; j < 8; ++j) S[j] = (f32x2){0.f, 0.f};
  const int kp = lane & 3, col = (wave & 3) * 16 + (lane >> 2);
  DnRaw R0, R1;
  if (wave >= 4) {
    dn_prep_load(R0, p, b, hd, dir, 0); dn_prep_compute(R0, buf, cw, Aexp, dtb);
    dn_prep_load(R0, p, b, hd, dir, 1); dn_prep_load(R1, p, b, hd, dir, 2);
  }
  __syncthreads();
#define DN_SCAN_CHUNK(CI) do { \
      const float* bb = buf + ((CI) & 1) * CHUNK * DN_STRIDE; \
      int pos, n; \
      const int tok0 = step_tok(b, dir, (CI) * CHUNK, pos, n); \
      const int tstep = dir ? -1 : 1; \
      u16* op = dno + (size_t)tok0 * 256 + hd * 64 + col; \
      DnOps A, B; \
      dn_load(A, bb, kp, col); \
      _Pragma("unroll 1") for (int st = 0; st < CHUNK; st += 2) { \
        dn_load(B, bb + (st + 1) * DN_STRIDE, kp, col); \
        const float o0 = dn_step(S, A); \
        if ((MODE & 1) && kp == 0) op[(ptrdiff_t)(st * tstep) * 256] = f2bf(o0); sink += o0; \
        dn_load(A, bb + (st + 2) * DN_STRIDE, kp, col); \
        const float o1 = dn_step(S, B); \
        if ((MODE & 1) && kp == 0) op[(ptrdiff_t)((st + 1) * tstep) * 256] = f2bf(o1); sink += o1; \
      } } while (0)
  float sink = 0.f;
  if (wave >= 4 && !(MODE & 2)) {
#pragma unroll 1
    for (int ci = 0; ci < NCHUNK; ci += 2) { lds_barrier(); lds_barrier(); }
  } else if (wave < 4 && !(MODE & 4)) {
#pragma unroll 1
    for (int ci = 0; ci < NCHUNK; ci += 2) { lds_barrier(); lds_barrier(); }
  } else if (wave >= 4) {
#pragma unroll 1
    for (int ci = 0; ci < NCHUNK; ci += 2) {
      dn_prep_compute(R0, buf + CHUNK * DN_STRIDE, cw, Aexp, dtb);
      dn_prep_load(R0, p, b, hd, dir, min(ci + 3, NCHUNK - 1));
      lds_barrier();
      if (ci + 2 < NCHUNK) dn_prep_compute(R1, buf, cw, Aexp, dtb);
      dn_prep_load(R1, p, b, hd, dir, min(ci + 4, NCHUNK - 1));
      lds_barrier();
    }
  } else {
#pragma unroll 1
    for (int ci = 0; ci < NCHUNK; ci += 2) {
      DN_SCAN_CHUNK(ci);
      lds_barrier();
      DN_SCAN_CHUNK(ci + 1);
      lds_barrier();
    }
    if (!(MODE & 1) && sink == 12345.678f) dno[col] = f2bf(sink);
  }
  asm volatile("s_waitcnt vmcnt(0)" ::: "memory");
  __syncthreads();
}

struct RwRaw { unsigned u[3][6]; unsigned wl[4], al[4]; unsigned vmask; };
DEV void rw_prep_load(RwRaw& R, PC p, int b, int hd, int dir, int ci, int pw) {
  const int lane = TID() & 63;
  const u16* slab = (const u16*)(p->ws + OFF_SLAB);
  const u16* rwl = (const u16*)(p->ws + OFF_RWL);
  const int ch = hd * 64 + lane;
  int pos0, n;
  const int tokc = step_tok(b, dir, ci * CHUNK, pos0, n);
  const int base = tokc - pos0;
  const int plo = dir ? pos0 - (pw * 4 + 3) : pos0 + pw * 4;
  unsigned vm = 0;
#pragma unroll
  for (int i = 0; i < 6; ++i) {
    const int pos = plo - 1 + i;
    const int posc = min(max(pos, 0), n - 1);
    vm |= (pos == posc ? 1u : 0u) << i;
#pragma unroll
    for (int sg = 0; sg < 3; ++sg) R.u[sg][i] = slab[(size_t)(base + posc) * PS + RW_OFF + sg * 256 + ch];
  }
  R.vmask = vm;
#pragma unroll
  for (int q = 0; q < 4; ++q) {
    const int pos = dir ? pos0 - (pw * 4 + q) : pos0 + pw * 4 + q;
    R.wl[q] = rwl[(size_t)(base + pos) * 1024 + dir * 512 + ch];
    R.al[q] = rwl[(size_t)(base + pos) * 1024 + dir * 512 + 256 + ch];
  }
}
struct RwConst { float m0[3], m1[3], kk_w, ka_w, w0, a0; };
DEV void rw_const_load(RwConst& C, PC p, int l, int hd, int dir) {
  const int lane = TID() & 63;
  const int ch = hd * 64 + lane;
  const float* mu = p->in[I_RWMU] + l * 2 * 896;
  C.kk_w = p->in[I_RWKK][l * 256 + ch]; C.ka_w = p->in[I_RWKA][l * 256 + ch];
  C.w0 = p->in[I_RWW0][(l * 2 + dir) * 256 + ch]; C.a0 = p->in[I_RWA0][(l * 2 + dir) * 256 + ch];
#pragma unroll
  for (int sg = 0; sg < 3; ++sg) { C.m0[sg] = mu[sg * 256 + ch]; C.m1[sg] = mu[896 + sg * 256 + ch]; }
}
DEV void rw_prep_compute(const RwRaw& R, const RwConst& C, int dir, float* dst, int pw) {
  const int lane = TID() & 63;
  const float kk_w = C.kk_w, ka_w = C.ka_w, w0 = C.w0, a0 = C.a0;
  float m0[3], m1[3];
#pragma unroll
  for (int sg = 0; sg < 3; ++sg) { m0[sg] = C.m0[sg]; m1[sg] = C.m1[sg]; }
  float uf[3][6];
#pragma unroll
  for (int sg = 0; sg < 3; ++sg)
#pragma unroll
    for (int i = 0; i < 6; ++i) uf[sg][i] = ((R.vmask >> i) & 1u) ? __uint_as_float(R.u[sg][i] << 16) : 0.f;
#pragma unroll
  for (int q = 0; q < 4; ++q) {
    const int st = pw * 4 + q;
    const int ic = dir ? 4 - q : 1 + q;
    float ts[3];
#pragma unroll
    for (int sg = 0; sg < 3; ++sg) {
      const float u = uf[sg][ic], pv = uf[sg][ic - 1], nx = uf[sg][ic + 1];
      ts[sg] = u + m0[sg] * (pv - u) + m1[sg] * (nx - u);
    }
    const float r = ts[0], k = ts[1], v = ts[2];
    const float kr = k * kk_w;
    const float w = __expf(-__uint_as_float(R.wl[q] << 16));
    const float a = __uint_as_float(R.al[q] << 16);
    const float kd = k * (1.f + (a - 1.f) * ka_w);
    const float ss = wave_allsum_dpp(kr * kr), t1 = wave_allsum_dpp(kr * a * r), t2 = wave_allsum_dpp(kd * r);
    const float rn = rsqrtf(ss + 1e-6f);
    const float kk = kr * rn;
    float* d = dst + st * RW_STRIDE;
    d[lane] = w * r; d[64 + lane] = w; d[128 + lane] = kd; d[192 + lane] = -kk; d[256 + lane] = kk * a; d[320 + lane] = v;
    if (lane == 0) { d[384] = t1 * rn; d[385] = t2; }
  }
}

__device__ __attribute__((always_inline)) void rw_scan_unit(PC p, int l, int hunit, unsigned char* smem, const int MODE = 7) {
  const int unit = hunit >> 1, half = hunit & 1;
  const int b = unit >> 3, hd = (unit >> 1) & 3, dir = unit & 1;
  float* buf = (float*)smem;
  const int tid = TID(), wave = tid >> 6, lane = tid & 63;
  u16* rwy = (u16*)(p->ws + OFF_RWY) + (size_t)dir * TT * 256;
  __syncthreads();
  f32x2 S[8];
#pragma unroll
  for (int j = 0; j < 8; ++j) S[j] = (f32x2){0.f, 0.f};
  const bool is_scan = wave < 4;
  const bool is_prep = wave >= 4;
  const int pw = wave & 3;
  const int kp = lane & 7, col = half * 32 + (wave & 3) * 8 + (lane >> 3);
  RwRaw R0, R1;
  RwConst C;
  rw_const_load(C, p, l, hd, dir);
  if (is_prep) {
    rw_prep_load(R0, p, b, hd, dir, 0, pw); rw_prep_compute(R0, C, dir, buf, pw);
    rw_prep_load(R0, p, b, hd, dir, 1, pw); rw_prep_load(R1, p, b, hd, dir, 2, pw);
  }
  __syncthreads();
#define RW_SCAN_CHUNK(CI) do { \
      const float* bb = buf + ((CI) & 1) * CHUNK * RW_STRIDE; \
      int pos, n; \
      const int tok0 = step_tok(b, dir, (CI) * CHUNK, pos, n); \
      const int tstep = dir ? -1 : 1; \
      u16* op = rwy + (size_t)tok0 * 256 + hd * 64 + col; \
      RwOps8 A, B; \
      rw_load8(A, bb, kp, col); \
      _Pragma("unroll 1") for (int st = 0; st < CHUNK; st += 2) { \
        rw_load8(B, bb + (st + 1) * RW_STRIDE, kp, col); \
        const float y0 = rw_step8(S, A); \
        if ((MODE & 1) && kp == 0) op[(ptrdiff_t)(st * tstep) * 256] = f2bf(y0); sink += y0; \
        rw_load8(A, bb + (st + 2) * RW_STRIDE, kp, col); \
        const float y1 = rw_step8(S, B); \
        if ((MODE & 1) && kp == 0) op[(ptrdiff_t)((st + 1) * tstep) * 256] = f2bf(y1); sink += y1; \
      } } while (0)
  float sink = 0.f;
  if ((is_prep && !(MODE & 2)) || (is_scan && !(MODE & 4))) {
#pragma unroll 1
    for (int ci = 0; ci < NCHUNK; ci += 2) { lds_barrier(); lds_barrier(); }
  } else if (is_prep) {
#pragma unroll 1
    for (int ci = 0; ci < NCHUNK; ci += 2) {
      rw_prep_compute(R0, C, dir, buf + CHUNK * RW_STRIDE, pw);
      rw_prep_load(R0, p, b, hd, dir, min(ci + 3, NCHUNK - 1), pw);
      lds_barrier();
      if (ci + 2 < NCHUNK) rw_prep_compute(R1, C, dir, buf, pw);
      rw_prep_load(R1, p, b, hd, dir, min(ci + 4, NCHUNK - 1), pw);
      lds_barrier();
    }
  } else if (is_scan) {
#pragma unroll 1
    for (int ci = 0; ci < NCHUNK; ci += 2) {
      RW_SCAN_CHUNK(ci);
      lds_barrier();
      RW_SCAN_CHUNK(ci + 1);
      lds_barrier();
    }
    if (!(MODE & 1) && sink == 12345.678f) rwy[col] = f2bf(sink);
  } else {
#pragma unroll 1
    for (int ci = 0; ci < NCHUNK; ci += 2) { lds_barrier(); lds_barrier(); }
  }
  asm volatile("s_waitcnt vmcnt(0)" ::: "memory");
  __syncthreads();
}

constexpr int USTR = 2248;
__device__ __attribute__((always_inline)) void hyena_task(PC p, int l, int order, int task, unsigned char* smem) {
  const int tid = TID(), wave = tid >> 6, lane = tid & 63;
  const int ty = task >> 8, ch = task & 255, n = ty ? 256 : 2048;
  const int oc = order * 256 + ch;
  u16* F = (u16*)smem;
  u16* Ts = F + 4096 * 8;
  u16* Us = Ts + 4096;
  const int seq0 = ty ? TL : 0;
  __syncthreads();
  {
    const u16* filt = (const u16*)(p->ws + OFF_FILT + (size_t)l * FILT_LAYER) + (ty ? (size_t)512 * 4096 : 0) + (size_t)oc * (2 * n);
    for (int i = tid * 8; i < 2 * n; i += 512 * 8) *(uint4*)(Ts + i) = *(const uint4*)(filt + i);
    const u16* Usrc = (const u16*)(p->ws + (order == 0 ? OFF_HXT : OFF_HYZ)) + (size_t)ch * TT + seq0;
    const int nch = (n + 192) / 8;
    for (int idx = tid; idx < 8 * nch; idx += 512) {
      const int b = idx / nch, c8 = idx % nch, s = c8 * 8 - 96;
      uint4 v = make_uint4(0, 0, 0, 0);
      if (s >= 0 && s < n) v = *(const uint4*)(Usrc + (size_t)b * n + s);
      *(uint4*)(Us + b * USTR + c8 * 8) = v;
    }
  }
  __syncthreads();
  for (int E = tid; E < 2 * n; E += 512) {
    unsigned w[4];
#pragma unroll
    for (int q = 0; q < 4; ++q) {
      const int x0 = E - 2 * q, x1 = E - 2 * q - 1;
      const unsigned lo = (x0 >= 0 && x0 <= 2 * n - 2) ? Ts[x0] : 0u;
      const unsigned hi = (x1 >= 0 && x1 <= 2 * n - 2) ? Ts[x1] : 0u;
      w[q] = lo | (hi << 16);
    }
    *(uint4*)(F + E * 8) = make_uint4(w[0], w[1], w[2], w[3]);
  }
  float asum = 0.f;
  {
    const float* fp = (const float*)(p->ws + OFF_FPART) + (size_t)(l * 72 + (ty ? 64 : 0)) * 1024 + oc;
    const int nck = ty ? 8 : 64;
    for (int c = 0; c < nck; ++c) asum += fp[c * 1024] + fp[c * 1024 + 512];
  }
  const float inv = 1.f / asum;
  __syncthreads();
  const int ntile = n >> 7;
  if (wave < ntile) {
    const bool two = (wave + 8) < ntile;
    f32x16 acc0, acc1;
#pragma unroll
    for (int i = 0; i < 16; ++i) { acc0[i] = 0.f; acc1[i] = 0.f; }
    const int m = lane & 31, kh = lane >> 5, dl = m >> 3, bb = m & 7;
    const u16* Bp = Us + bb * USTR + 8 * kh + 32 * dl;
    const int T0 = wave * 128;
    const int nsteps = (n + 96) / 16;
    const u16* Ap = F + (size_t)(T0 + 96 + n - 1 + m - 8 * kh) * 8;
#pragma unroll 2
    for (int st = 0; st < nsteps; ++st) {
      const bf16x8 bfrag = *(const bf16x8*)(Bp + st * 16);
      const bf16x8 a0 = *(const bf16x8*)(Ap - st * 128);
      acc0 = __builtin_amdgcn_mfma_f32_32x32x16_bf16(a0, bfrag, acc0, 0, 0, 0);
      if (two) {
        const bf16x8 a1 = *(const bf16x8*)(Ap - st * 128 + 1024 * 8);
        acc1 = __builtin_amdgcn_mfma_f32_32x32x16_bf16(a1, bfrag, acc1, 0, 0, 0);
      }
    }
    const float bias = p->in[I_HYBIAS][l * 512 + oc];
    const u16* gsrc = (const u16*)(p->ws + OFF_HXT) + (size_t)((order == 0 ? 256 : 512) + ch) * TT;
    const u16* usrc = (const u16*)(p->ws + (order == 0 ? OFF_HXT : OFF_HYZ)) + (size_t)ch * TT;
#pragma unroll
    for (int tsel = 0; tsel < 2; ++tsel) {
      if (tsel == 1 && !two) break;
      const int Tb = T0 + tsel * 1024;
#pragma unroll
      for (int rq = 0; rq < 4; ++rq) {
        const int t = Tb + 32 * dl + 8 * rq + 4 * kh;
        const size_t tok = (size_t)seq0 + (size_t)bb * n + t;
        const uint2 gx = *(const uint2*)(gsrc + tok);
        const uint2 ux = *(const uint2*)(usrc + tok);
        const float g[4] = {__uint_as_float(gx.x << 16), __uint_as_float(gx.x & 0xffff0000u), __uint_as_float(gx.y << 16), __uint_as_float(gx.y & 0xffff0000u)};
        const float u[4] = {__uint_as_float(ux.x << 16), __uint_as_float(ux.x & 0xffff0000u), __uint_as_float(ux.y << 16), __uint_as_float(ux.y & 0xffff0000u)};
        float o[4];
#pragma unroll
        for (int e = 0; e < 4; ++e) {
          const float y = (tsel == 0 ? acc0[rq * 4 + e] : acc1[rq * 4 + e]) * inv;
          o[e] = g[e] * (y + u[e] * bias);
        }
        if (order == 0) {
          uint2 ov; ov.x = pack2(o[0], o[1]); ov.y = pack2(o[2], o[3]);
          *(uint2*)((u16*)(p->ws + OFF_HYZ) + (size_t)ch * TT + tok) = ov;
        } else {
          u16* cat = (u16*)(p->ws + OFF_H);
#pragma unroll
          for (int e = 0; e < 4; ++e) cat[(tok + e) * 1024 + ch] = f2bf(o[e]);
        }
      }
    }
  }
}

__device__ __attribute__((always_inline)) void na_task(PC p, int l, int task, unsigned char* smem) {
  u16* Qs = (u16*)smem;
  u16* Ks = Qs + 128 * 72;
  u16* Vt = Ks + 64 * 72;
  float* rpbs = (float*)(Vt + 64 * 72);
  const int tid = TID(), wave = tid >> 6, lane = tid & 63;
  const int grp = wave >> 2, w4 = wave & 3;
  const u16* slab = (const u16*)(p->ws + OFF_SLAB);
  int b, hd, r0 = 0, u0 = 0, nloc = 0, qbase0, qbase1;
  const bool local = task < 512;
  if (local) {
    b = task >> 6; hd = (task >> 4) & 3; r0 = (task & 15) * 2;
    u0 = min(max(r0 - 4, 0), 24);
    nloc = min(max(r0 + 1 - 4, 0), 24) + 8 - u0;
    qbase0 = b * 2048 + r0 * 64; qbase1 = qbase0 + 64;
  } else {
    const int t2 = task - 512; b = t2 >> 3; hd = (t2 >> 1) & 3;
    qbase0 = TL + b * 256 + (t2 & 1) * 128; qbase1 = qbase0 + 64;
  }
  const int nchunks = nloc + 4;
  const int r = r0 + grp;
  const int rs = min(max(r - 4, 0), 24);
  const int qtok0 = grp ? qbase1 : qbase0;
  const float* qn = p->in[I_NAQN] + l * 64;
  const float* kn = p->in[I_NAKN] + l * 64;
  __syncthreads();
  {
    const int q = tid >> 2, dq = tid & 3;
    const int qt = (q < 64 ? qbase0 : qbase1) + (q & 63);
    float v[16];
    unpack8(*(const uint4*)(slab + (size_t)qt * PS + NA_OFF + hd * 64 + dq * 16), v);
    unpack8(*(const uint4*)(slab + (size_t)qt * PS + NA_OFF + hd * 64 + dq * 16 + 8), v + 8);
    float ss = 0.f;
#pragma unroll
    for (int e = 0; e < 16; ++e) ss += v[e] * v[e];
    ss += __shfl_xor(ss, 1); ss += __shfl_xor(ss, 2);
    const float rinv = rsqrtf(ss * (1.f / 64.f) + 1e-6f);
    uint4 o0, o1;
    o0.x = pack2(v[0] * rinv * qn[dq * 16 + 0], v[1] * rinv * qn[dq * 16 + 1]);
    o0.y = pack2(v[2] * rinv * qn[dq * 16 + 2], v[3] * rinv * qn[dq * 16 + 3]);
    o0.z = pack2(v[4] * rinv * qn[dq * 16 + 4], v[5] * rinv * qn[dq * 16 + 5]);
    o0.w = pack2(v[6] * rinv * qn[dq * 16 + 6], v[7] * rinv * qn[dq * 16 + 7]);
    o1.x = pack2(v[8] * rinv * qn[dq * 16 + 8], v[9] * rinv * qn[dq * 16 + 9]);
    o1.y = pack2(v[10] * rinv * qn[dq * 16 + 10], v[11] * rinv * qn[dq * 16 + 11]);
    o1.z = pack2(v[12] * rinv * qn[dq * 16 + 12], v[13] * rinv * qn[dq * 16 + 13]);
    o1.w = pack2(v[14] * rinv * qn[dq * 16 + 14], v[15] * rinv * qn[dq * 16 + 15]);
    *(uint4*)(Qs + q * 72 + dq * 16) = o0;
    *(uint4*)(Qs + q * 72 + dq * 16 + 8) = o1;
    for (int i = tid; i < 15 * 31; i += 512) rpbs[i] = p->in[I_NARPB][(size_t)(l * 4 + hd) * 15 * 31 + i];
  }
  const int fr = lane & 15, fq = lane >> 4;
  const int qc = w4 * 16 + fr;
  const int cs = min(max(qc - 8, 0), 48);
  float m = -1e30f, lsum = 0.f;
  f32x4 o[4];
#pragma unroll
  for (int i = 0; i < 4; ++i) o[i] = (f32x4){0.f, 0.f, 0.f, 0.f};
  bf16x8 bq[2];
  uint4 kraw, vraw;
  const int skey = tid >> 3, sdc = tid & 7;
#define NA_KTOK(CI) (((CI) < nloc) ? b * 2048 + (u0 + (CI)) * 64 : TL + b * 256 + ((CI) - nloc) * 64)
  {
    const int kt0 = NA_KTOK(0);
    kraw = *(const uint4*)(slab + (size_t)(kt0 + skey) * PS + NA_OFF + 256 + hd * 64 + sdc * 8);
    vraw = *(const uint4*)(slab + (size_t)(kt0 + skey) * PS + NA_OFF + 512 + hd * 64 + sdc * 8);
  }
#pragma unroll 1
  for (int ci = 0; ci < nchunks; ++ci) {
    __syncthreads();
    const bool lc = ci < nloc;
    const int rr = u0 + ci;
    const bool active = !lc || (rr >= rs && rr < rs + 8);
    {
      const int key = skey, dc = sdc;
      float v[8];
      unpack8(kraw, v);
      float ss = 0.f;
#pragma unroll
      for (int e = 0; e < 8; ++e) ss += v[e] * v[e];
      ss += __shfl_xor(ss, 1); ss += __shfl_xor(ss, 2); ss += __shfl_xor(ss, 4);
      const float rinv = rsqrtf(ss * (1.f / 64.f) + 1e-6f);
      uint4 ov;
      ov.x = pack2(v[0] * rinv * kn[dc * 8 + 0], v[1] * rinv * kn[dc * 8 + 1]);
      ov.y = pack2(v[2] * rinv * kn[dc * 8 + 2], v[3] * rinv * kn[dc * 8 + 3]);
      ov.z = pack2(v[4] * rinv * kn[dc * 8 + 4], v[5] * rinv * kn[dc * 8 + 5]);
      ov.w = pack2(v[6] * rinv * kn[dc * 8 + 6], v[7] * rinv * kn[dc * 8 + 7]);
      *(uint4*)(Ks + key * 72 + dc * 8) = ov;
      const unsigned w4[4] = {vraw.x, vraw.y, vraw.z, vraw.w};
#pragma unroll
      for (int e = 0; e < 4; ++e) {
        Vt[(dc * 8 + 2 * e) * 72 + key] = (u16)(w4[e] & 0xffffu);
        Vt[(dc * 8 + 2 * e + 1) * 72 + key] = (u16)(w4[e] >> 16);
      }
    }
    __syncthreads();
    if (ci + 1 < nchunks) {
      const int kt1 = NA_KTOK(ci + 1);
      kraw = *(const uint4*)(slab + (size_t)(kt1 + skey) * PS + NA_OFF + 256 + hd * 64 + sdc * 8);
      vraw = *(const uint4*)(slab + (size_t)(kt1 + skey) * PS + NA_OFF + 512 + hd * 64 + sdc * 8);
    }
    if (ci == 0) {
      bq[0] = *(const bf16x8*)(Qs + (grp * 64 + w4 * 16 + fr) * 72 + fq * 8);
      bq[1] = *(const bf16x8*)(Qs + (grp * 64 + w4 * 16 + fr) * 72 + 32 + fq * 8);
    }
    if (active) {
      f32x4 s[4];
#pragma unroll
      for (int mt = 0; mt < 4; ++mt) {
        s[mt] = (f32x4){0.f, 0.f, 0.f, 0.f};
#pragma unroll
        for (int ks = 0; ks < 2; ++ks) {
          bf16x8 a = *(const bf16x8*)(Ks + (mt * 16 + fr) * 72 + ks * 32 + fq * 8);
          s[mt] = __builtin_amdgcn_mfma_f32_16x16x32_bf16(a, bq[ks], s[mt], 0, 0, 0);
        }
      }
      float cmax = -1e30f;
#pragma unroll
      for (int mt = 0; mt < 4; ++mt)
#pragma unroll
        for (int j = 0; j < 4; ++j) {
          float v = s[mt][j] * 0.125f;
          if (lc) {
            const int kc = mt * 16 + fq * 4 + j;
            const bool ok = (kc >= cs) && (kc < cs + 16);
            int dcol = min(max(kc - qc, -15), 15);
            v = ok ? v + rpbs[(rr - r + 7) * 31 + dcol + 15] : -1e30f;
          }
          s[mt][j] = v;
          cmax = fmaxf(cmax, v);
        }
      cmax = allmax_rows(cmax);
      const float mnew = fmaxf(m, cmax);
      const float alpha = __expf(m - mnew);
      m = mnew;
      float ps = 0.f;
#pragma unroll
      for (int mt = 0; mt < 4; ++mt)
#pragma unroll
        for (int j = 0; j < 4; ++j) { float pp = __expf(s[mt][j] - mnew); s[mt][j] = pp; ps += pp; }
      lsum = lsum * alpha + ps;
#pragma unroll
      for (int dt = 0; dt < 4; ++dt) o[dt] *= alpha;
      bf16x8 pb[2];
#pragma unroll
      for (int h2 = 0; h2 < 2; ++h2) {
#pragma unroll
        for (int e = 0; e < 4; ++e) {
          pb[h2][e] = (short)f2bf(s[2 * h2][e]);
          pb[h2][4 + e] = (short)f2bf(s[2 * h2 + 1][e]);
        }
      }
#pragma unroll
      for (int dt = 0; dt < 4; ++dt)
#pragma unroll
        for (int h2 = 0; h2 < 2; ++h2) {
          bf16x4 va = *(const bf16x4*)(Vt + (dt * 16 + fr) * 72 + (2 * h2) * 16 + fq * 4);
          bf16x4 vb = *(const bf16x4*)(Vt + (dt * 16 + fr) * 72 + (2 * h2 + 1) * 16 + fq * 4);
          bf16x8 a = __builtin_shufflevector(va, vb, 0, 1, 2, 3, 4, 5, 6, 7);
          o[dt] = __builtin_amdgcn_mfma_f32_16x16x32_bf16(a, pb[h2], o[dt], 0, 0, 0);
        }
    }
  }
  {
    lsum = allred_rows(lsum);
    const float inv = 1.f / lsum;
    u16* cat = (u16*)(p->ws + OFF_H);
    const int tok = qtok0 + w4 * 16 + fr;
#pragma unroll
    for (int dt = 0; dt < 4; ++dt) {
      uint2 ov;
      ov.x = pack2(o[dt][0] * inv, o[dt][1] * inv);
      ov.y = pack2(o[dt][2] * inv, o[dt][3] * inv);
      *(uint2*)(cat + (size_t)tok * 1024 + 256 + hd * 64 + dt * 16 + fq * 4) = ov;
    }
  }
}

DEV void combine_token(PC p, int l, int tok, const float* g, const u16* slab, const u16* rwl, const u16* dno, const u16* rwy, u16* cat, const float* mu, int c4) {
    int base, n;
    if (tok < TL) { base = (tok >> 11) << 11; n = 2048; } else { base = TL + (((tok - TL) >> 8) << 8); n = 256; }
    const int pos = tok - base;
    {
      float4 ov;
      {
        const uint2 f0 = *(const uint2*)(dno + (size_t)tok * 256 + c4), f1 = *(const uint2*)(dno + (size_t)TT * 256 + (size_t)tok * 256 + c4);
        ov.x = __uint_as_float(f0.x << 16) + __uint_as_float(f1.x << 16);
        ov.y = __uint_as_float(f0.x & 0xffff0000u) + __uint_as_float(f1.x & 0xffff0000u);
        ov.z = __uint_as_float(f0.y << 16) + __uint_as_float(f1.y << 16);
        ov.w = __uint_as_float(f0.y & 0xffff0000u) + __uint_as_float(f1.y & 0xffff0000u);
      }
      float ss = ov.x * ov.x + ov.y * ov.y + ov.z * ov.z + ov.w * ov.w;
      ss += __shfl_xor(ss, 1); ss += __shfl_xor(ss, 2); ss += __shfl_xor(ss, 4); ss += __shfl_xor(ss, 8);
      const float rinv = rsqrtf(ss * (1.f / 64.f) + 1e-6f);
      const float* nw = p->in[I_DNNORM] + l * 64 + (c4 & 63);
      uint2 zz = *(const uint2*)(slab + (size_t)tok * PS + DN_OFF + 768 + c4);
      float z0 = __uint_as_float(zz.x << 16), z1 = __uint_as_float(zz.x & 0xffff0000u), z2 = __uint_as_float(zz.y << 16), z3 = __uint_as_float(zz.y & 0xffff0000u);
      uint2 o2;
      o2.x = pack2(ov.x * rinv * nw[0] * siluf_(z0), ov.y * rinv * nw[1] * siluf_(z1));
      o2.y = pack2(ov.z * rinv * nw[2] * siluf_(z2), ov.w * rinv * nw[3] * siluf_(z3));
      *(uint2*)(cat + (size_t)tok * 1024 + 512 + c4) = o2;
    }
    {
      float ts[3][4];
#pragma unroll
      for (int sgi = 0; sgi < 3; ++sgi) {
        const int col = RW_OFF + sgi * 256 + c4;
        uint2 cu = *(const uint2*)(slab + (size_t)tok * PS + col);
        uint2 pu = pos > 0 ? *(const uint2*)(slab + (size_t)(tok - 1) * PS + col) : make_uint2(0, 0);
        uint2 nu = pos < n - 1 ? *(const uint2*)(slab + (size_t)(tok + 1) * PS + col) : make_uint2(0, 0);
        float uc[4] = {__uint_as_float(cu.x << 16), __uint_as_float(cu.x & 0xffff0000u), __uint_as_float(cu.y << 16), __uint_as_float(cu.y & 0xffff0000u)};
        float up[4] = {__uint_as_float(pu.x << 16), __uint_as_float(pu.x & 0xffff0000u), __uint_as_float(pu.y << 16), __uint_as_float(pu.y & 0xffff0000u)};
        float un[4] = {__uint_as_float(nu.x << 16), __uint_as_float(nu.x & 0xffff0000u), __uint_as_float(nu.y << 16), __uint_as_float(nu.y & 0xffff0000u)};
#pragma unroll
        for (int e = 0; e < 4; ++e) ts[sgi][e] = uc[e] + mu[sgi * 256 + c4 + e] * (up[e] - uc[e]) + mu[896 + sgi * 256 + c4 + e] * (un[e] - uc[e]);
      }
      float4 yv;
      {
        const uint2 f0 = *(const uint2*)(rwy + (size_t)tok * 256 + c4), f1 = *(const uint2*)(rwy + (size_t)TT * 256 + (size_t)tok * 256 + c4);
        yv.x = __uint_as_float(f0.x << 16) + __uint_as_float(f1.x << 16);
        yv.y = __uint_as_float(f0.x & 0xffff0000u) + __uint_as_float(f1.x & 0xffff0000u);
        yv.z = __uint_as_float(f0.y << 16) + __uint_as_float(f1.y << 16);
        yv.w = __uint_as_float(f0.y & 0xffff0000u) + __uint_as_float(f1.y & 0xffff0000u);
      }
      float y[4] = {yv.x, yv.y, yv.z, yv.w};
      float sm = y[0] + y[1] + y[2] + y[3];
      sm += __shfl_xor(sm, 1); sm += __shfl_xor(sm, 2); sm += __shfl_xor(sm, 4); sm += __shfl_xor(sm, 8);
      const float mean = sm * (1.f / 64.f);
      float sq = 0.f;
#pragma unroll
      for (int e = 0; e < 4; ++e) sq += (y[e] - mean) * (y[e] - mean);
      sq += __shfl_xor(sq, 1); sq += __shfl_xor(sq, 2); sq += __shfl_xor(sq, 4); sq += __shfl_xor(sq, 8);
      const float rstd = rsqrtf(sq * (1.f / 64.f) + 64e-5f);
      uint2 al0 = *(const uint2*)(rwl + (size_t)tok * 1024 + 256 + c4);
      uint2 al1 = *(const uint2*)(rwl + (size_t)tok * 1024 + 512 + 256 + c4);
      float a0l[4] = {__uint_as_float(al0.x << 16), __uint_as_float(al0.x & 0xffff0000u), __uint_as_float(al0.y << 16), __uint_as_float(al0.y & 0xffff0000u)};
      float a1l[4] = {__uint_as_float(al1.x << 16), __uint_as_float(al1.x & 0xffff0000u), __uint_as_float(al1.y << 16), __uint_as_float(al1.y & 0xffff0000u)};
      float bs = 0.f;
#pragma unroll
      for (int e = 0; e < 4; ++e) {
        const int ch = c4 + e;
        const float a0 = a0l[e];
        const float a1 = a1l[e];
        const float ka = p->in[I_RWKA][l * 256 + ch];
        const float ksum = ts[1][e] * (2.f + (a0 + a1 - 2.f) * ka);
        bs += ts[0][e] * ksum * p->in[I_RWRK][l * 256 + ch];
      }
      bs += __shfl_xor(bs, 1); bs += __shfl_xor(bs, 2); bs += __shfl_xor(bs, 4); bs += __shfl_xor(bs, 8);
      float outv[4];
#pragma unroll
      for (int e = 0; e < 4; ++e) {
        const int ch = c4 + e;
        const float yn = (y[e] - mean) * rstd * p->in[I_RWLNW][l * 256 + ch] + p->in[I_RWLNB][l * 256 + ch];
        outv[e] = (yn + bs * ts[2][e]) * g[e];
      }
      uint2 o2; o2.x = pack2(outv[0], outv[1]); o2.y = pack2(outv[2], outv[3]);
      *(uint2*)(cat + (size_t)tok * 1024 + 768 + c4) = o2;
    }
}

__device__ __attribute__((always_inline)) void combine_pass(PC p, int l, int ntok, unsigned char* smem) {
  const int tid = TID(), wave = tid >> 6, lane = tid & 63;
  float* sg = (float*)smem + wave * 192;
  const u16* slab = (const u16*)(p->ws + OFF_SLAB);
  const u16* rwl = (const u16*)(p->ws + OFF_RWL);
  const u16* dno = (const u16*)(p->ws + OFF_DNO);
  const u16* rwy = (const u16*)(p->ws + OFF_RWY);
  u16* cat = (u16*)(p->ws + OFF_H);
  const float* mu = p->in[I_RWMU] + l * 2 * 896;
  const float* gup = p->in[I_RWGUP] + (size_t)l * 64 * 256;
  const int c4 = lane * 4;
  __syncthreads();
  for (int tok0 = (BID() * 8 + wave) * 3; tok0 < ntok; tok0 += NBLK() * 8 * 3) {
#pragma unroll
    for (int tt = 0; tt < 3; ++tt) {
      const int tok = min(tok0 + tt, ntok - 1);
      int base, n;
      if (tok < TL) { base = (tok >> 11) << 11; n = 2048; } else { base = TL + (((tok - TL) >> 8) << 8); n = 256; }
      const int pos = tok - base;
      const int col = RW_OFF + 832 + lane;
      float u = bf2f(slab[(size_t)tok * PS + col]);
      float pv = pos > 0 ? bf2f(slab[(size_t)(tok - 1) * PS + col]) : 0.f;
      float nx = pos < n - 1 ? bf2f(slab[(size_t)(tok + 1) * PS + col]) : 0.f;
      float sv = u + mu[832 + lane] * (pv - u) + mu[896 + 832 + lane] * (nx - u);
      sg[tt * 64 + lane] = sigmoidf_(sv);
    }
    float g[3][4];
#pragma unroll
    for (int tt = 0; tt < 3; ++tt)
#pragma unroll
      for (int e = 0; e < 4; ++e) g[tt][e] = 0.f;
#pragma unroll 4
    for (int j = 0; j < 64; ++j) {
      const float4 gw = *(const float4*)(gup + j * 256 + c4);
#pragma unroll
      for (int tt = 0; tt < 3; ++tt) {
        const float sj = sg[tt * 64 + j];
        g[tt][0] = fmaf(sj, gw.x, g[tt][0]); g[tt][1] = fmaf(sj, gw.y, g[tt][1]); g[tt][2] = fmaf(sj, gw.z, g[tt][2]); g[tt][3] = fmaf(sj, gw.w, g[tt][3]);
      }
    }
#pragma unroll
    for (int tt = 0; tt < 3; ++tt)
      if (tok0 + tt < ntok) combine_token(p, l, tok0 + tt, g[tt], slab, rwl, dno, rwy, cat, mu, c4);
  }
}

#ifndef XB_ALL_RELEASE
#define XB_ALL_RELEASE 0
#endif
#define XB_TMO      128
#define XB_XCNT(j)  (256  + 64 * (j))
#define XB_XSUB(j)  (1280 + 64 * (j))
#define XB_XGEN(j)  (2304 + 64 * (j))
#define XB_TOP      3328
#define XB_TOPGEN   3392
#define XB_SPIN_CAP (1u << 18)
#define LAS __attribute__((address_space(3)))
DEV unsigned xb_ld(unsigned* p) { return __hip_atomic_load(p, __ATOMIC_RELAXED, __HIP_MEMORY_SCOPE_AGENT); }
DEV unsigned xb_add(unsigned* p, unsigned v) { return __hip_atomic_fetch_add(p, v, __ATOMIC_RELAXED, __HIP_MEMORY_SCOPE_AGENT); }
DEV unsigned xb_xcc_id() { return (unsigned)__builtin_amdgcn_s_getreg((3 << 11) | 20) & 0xFu; }
#define XB_SPIN(cond, bar) do { unsigned _sp = 0; while (cond) { __builtin_amdgcn_s_sleep(1); \
    if ((++_sp & 255u) == 0u) { if (xb_ld(&(bar)[XB_TMO])) break; if (_sp > XB_SPIN_CAP) { atomicAdd(&(bar)[XB_TMO], 1u); break; } } } } while (0)
struct XcdBarrier { unsigned* bar; unsigned x; volatile LAS unsigned* st; };
DEV XcdBarrier xcd_barrier_post(unsigned* bar, volatile LAS unsigned* st) {
  XcdBarrier b; b.bar = bar; b.x = xb_xcc_id(); b.st = st;
  if (threadIdx.x == 0) (void)xb_add(&bar[XB_XCNT(b.x)], 1u);
  return b;
}
DEV void xcd_barrier_complete(unsigned* bar, unsigned x, unsigned& nloc, unsigned& nx) {
  const unsigned G = gridDim.x * gridDim.y * gridDim.z;
  unsigned sum, cnt, mine, sp = 0u;
  for (;;) {
    sum = 0u; cnt = 0u; mine = 0u;
#pragma unroll
    for (unsigned j = 0; j < 16; ++j) { const unsigned c = xb_ld(&bar[XB_XCNT(j)]); sum += c; cnt += (c > 0u) ? 1u : 0u; mine = (j == x) ? c : mine; }
    if (sum == G) break;
    __builtin_amdgcn_s_sleep(1);
    if ((++sp & 255u) == 0u) { if (xb_ld(&bar[XB_TMO])) break; if (sp > XB_SPIN_CAP) { atomicAdd(&bar[XB_TMO], 1u); break; } }
  }
  nloc = mine > 0u ? mine : 1u; nx = cnt > 0u ? cnt : 1u;
}
DEV void xcd_barrier(const XcdBarrier& b) {
  asm volatile("s_waitcnt vmcnt(0)" ::: "memory");
  __syncthreads();
  if (threadIdx.x == 0) {
    unsigned* bar = b.bar;
    __builtin_amdgcn_s_waitcnt(0);
#if XB_ALL_RELEASE
    __builtin_amdgcn_fence(__ATOMIC_RELEASE, "agent");
    asm volatile("s_waitcnt vmcnt(0)" ::: "memory");
#endif
    unsigned nloc = b.st[0], nx = b.st[1];
    if (nloc == 0u) { xcd_barrier_complete(bar, b.x, nloc, nx); b.st[0] = nloc; b.st[1] = nx; }
    const unsigned old = xb_add(&bar[XB_XSUB(b.x)], 1u);
    const unsigned gen = old / nloc;
    if (old + 1u == (gen + 1u) * nloc) {
      __builtin_amdgcn_fence(__ATOMIC_RELEASE, "agent");
      asm volatile("s_waitcnt vmcnt(0)" ::: "memory");
      const unsigned og = xb_add(&bar[XB_TOP], 1u);
      const unsigned tg = og / nx;
      if (og + 1u == (tg + 1u) * nx) xb_add(&bar[XB_TOPGEN], 1u);
      else XB_SPIN(xb_ld(&bar[XB_TOPGEN]) == tg, bar);
      __builtin_amdgcn_fence(__ATOMIC_ACQUIRE, "agent");
      xb_add(&bar[XB_XGEN(b.x)], 1u);
      asm volatile("s_waitcnt vmcnt(0)" ::: "memory");
    } else {
      XB_SPIN(xb_ld(&bar[XB_XGEN(b.x)]) == gen, bar);
      __builtin_amdgcn_fence(__ATOMIC_ACQUIRE, "agent");
      asm volatile("s_waitcnt vmcnt(0)" ::: "memory");
    }
  }
  __syncthreads();
}

DEV void ctr_barrier(unsigned* ctr, unsigned& epoch) {
  asm volatile("s_waitcnt vmcnt(0)" ::: "memory");
  __syncthreads();
  if (threadIdx.x == 0) {
    __builtin_amdgcn_fence(__ATOMIC_RELEASE, "agent");
    asm volatile("s_waitcnt vmcnt(0)" ::: "memory");
    epoch += 1;
    const unsigned target = epoch * gridDim.x;
    (void)xb_add(ctr, 1u);
    unsigned sp = 0;
    while (xb_ld(ctr) < target) { __builtin_amdgcn_s_sleep(1); if (++sp > (1u << 24)) break; }
    __builtin_amdgcn_fence(__ATOMIC_ACQUIRE, "agent");
    asm volatile("s_waitcnt vmcnt(0)" ::: "memory");
  }
  __syncthreads();
}
#ifndef USE_CTR_BARRIER
#define USE_CTR_BARRIER 0
#endif
#if USE_CTR_BARRIER
#define GBAR() ctr_barrier((unsigned*)(launder(pk)->ws + OFF_BAR), gb_epoch)
#else
#define GBAR() xcd_barrier(xb)
#endif

__global__ void __launch_bounds__(512) fwd_megakernel(P p_unused) {
  cg::grid_group grid = cg::this_grid();
  PC pk = (PC)__builtin_amdgcn_kernarg_segment_ptr();
  __shared__ __attribute__((aligned(16))) unsigned char smem[SMEM_BYTES];
  __shared__ int s_task;
  __shared__ uint4 xb_words;
  if (threadIdx.x == 0) xb_words = make_uint4(0u, 0u, 0u, 0u);
  __syncthreads();
  const XcdBarrier xb = xcd_barrier_post((unsigned*)(launder(pk)->ws + OFF_BAR), (volatile LAS unsigned*)&xb_words);
  unsigned gb_epoch = 0;
  __shared__ int s_vbid;
  if (threadIdx.x == 0) s_vbid = (int)xb_add((unsigned*)(launder(pk)->ws + OFF_CNT) + 16 + xb.x, 1u) * 8 + (int)xb.x;
  const int tid = TID();
  const int nb = NBLK(), bid = BID();

  {
    LOADP();
    for (int rep = 0; rep <= PROBE_P0; ++rep) {
      for (int t = bid; t < 144 + 144; t += nb) {
        if (t < 144) task_mod(p, t, smem);
        else task_filter(p, t - 144, smem);
      }
      convert_all(p, 0, smem);
    }
  }
  grid.sync();
  int vbid;
  {
    unsigned* bar = (unsigned*)(launder(pk)->ws + OFF_BAR);
    bool ok = (gridDim.x == 256);
    for (int j = 0; j < 16; ++j) { const unsigned c = xb_ld(&bar[XB_XCNT(j)]); ok = ok && (c == (j < 8 ? 32u : 0u)); }
    vbid = ok ? s_vbid : -1;
    vbid = __builtin_amdgcn_readfirstlane(vbid);
  }

#pragma unroll 1
  for (int l = 0; l < 2; ++l) {
    const bool need_ctx = (l == 0);
    {
      LOADP();
      if (l == 1) convert_all(p, 1, smem);
      for (int rep = 0; rep <= PROBE_ADALN; ++rep) adaln_pass(p, l, 0, (l == 0) ? p->in[I_X] : p->out, (l == 0) ? p->in[I_CTX] : (const float*)(p->ws + OFF_XC), TT);
    }
    GBAR();
    {
      LOADP();
      Epi e{}; e.outb = (u16*)(p->ws + OFF_ACT);
      for (int rep = 0; rep <= PROBE_GEMM; ++rep) {
        gemm_phase_big<0>((const u16*)(p->ws + OFF_H), 1024, (const u16*)(p->ws + OFF_WGU), 1024, TT, 5632, e, smem, 1536);
        gemm_phase<0, 128>((const u16*)(p->ws + OFF_H), 1024, (const u16*)(p->ws + OFF_WGU), 1024, 48 * 256, 256, e, smem, vbid, 24 * 256, 21 * 256);
      }
    }
    GBAR();
    {
      LOADP();
      float* xc = (float*)(p->ws + OFF_XC);
      Epi e{}; e.xs_lat = (l == 0) ? p->in[I_X] : p->out; e.xs_ctx = (l == 0) ? p->in[I_CTX] : xc; e.xd_lat = p->out; e.xd_ctx = xc;
      e.gate = (const float*)(p->ws + OFF_MOD) + (size_t)l * 9 * 9216 + 2 * 1024; e.coef = 0.5f;
      gemm_phase_big<1>((const u16*)(p->ws + OFF_ACT), DFF, (const u16*)(p->ws + OFF_WDN), DFF, TL, 1024, e, smem);
      gemm_phase<1, 64>((const u16*)(p->ws + OFF_ACT), DFF, (const u16*)(p->ws + OFF_WDN), DFF, TC, 1024, e, smem, vbid, TL);
    }
    GBAR();
    {
      LOADP();
      for (int rep = 0; rep <= PROBE_ADALN; ++rep) adaln_pass(p, l, 1, p->out, (const float*)(p->ws + OFF_XC), TT);
    }
    GBAR();
    {
      LOADP();
      Epi e{}; e.outb = (u16*)(p->ws + OFF_SLAB);
      for (int rep = 0; rep <= PROBE_GEMM; ++rep) gemm_phase_big<2>((const u16*)(p->ws + OFF_H), 1024, (const u16*)(p->ws + OFF_WIN), 1024, TT, PS, e, smem);
    }
    GBAR();
    {
      LOADP();
      for (int rep = 0; rep <= PROBE_PREP; ++rep) {
        for (int t = bid; t < TL / 32; t += nb) prep_task<32>(p, l, t * 32, smem);
        for (int t = bid; t < TC / 8; t += nb) prep_task<8>(p, l, TL + t * 8, smem);
      }
    }
    GBAR();
    if (bid < 64) { LOADP(); dn_scan_unit(p, l, bid, smem); }
    else if (bid < 192) { LOADP(); rw_scan_unit(p, l, bid - 64, smem); }
    {
      const int n_hy = need_ctx ? 512 : 256;
      const int n_na = need_ctx ? 512 + 64 : 512;
      const int ntask = n_hy + n_na;
      while (true) {
        LOADP();
        __syncthreads();
        if (tid == 0) s_task = atomicAdd((int*)(p->ws + OFF_CNT) + l * 4, 1);
        __syncthreads();
        const int t = s_task;
        if (t >= ntask) break;
        if (t < n_hy) hyena_task(p, l, 0, t, smem);
        else na_task(p, l, t - n_hy, smem);
      }
    }
    GBAR();
#if PROBE_SCAN
    for (int rep = 0; rep < PROBE_SCAN; ++rep) {
      if (bid < 64) { if (!(PROBE_MODE & 8)) { LOADP(); dn_scan_unit(p, l, bid, smem, PROBE_MODE & 6); } }
      else if (bid < 192) { if (!(PROBE_MODE & 16)) { LOADP(); rw_scan_unit(p, l, bid - 64, smem, PROBE_MODE & 6); } }
      GBAR();
    }
#endif
    for (int rep = 0; rep <= PROBE_M2; ++rep) {
    {
      LOADP();
      const int n_hy = need_ctx ? 512 : 256;
      for (int t = bid; t < n_hy; t += nb) hyena_task(p, l, 1, t, smem);
    }
    {
      LOADP();
      combine_pass(p, l, need_ctx ? TT : TL, smem);
    }
    }
    GBAR();
    {
      LOADP();
      float* xc = (float*)(p->ws + OFF_XC);
      Epi e{}; e.xs_lat = p->out; e.xs_ctx = xc; e.xd_lat = p->out; e.xd_ctx = xc;
      e.gate = (const float*)(p->ws + OFF_MOD) + (size_t)l * 9 * 9216 + 5 * 1024; e.coef = 1.0f;
      gemm_phase_big<1>((const u16*)(p->ws + OFF_H), 1024, (const u16*)(p->ws + OFF_WOUT), 1024, TL, 1024, e, smem);
      if (need_ctx) gemm_phase<1, 64>((const u16*)(p->ws + OFF_H), 1024, (const u16*)(p->ws + OFF_WOUT), 1024, TC, 1024, e, smem, vbid, TL);
    }
    GBAR();
    {
      LOADP();
      for (int rep = 0; rep <= PROBE_ADALN; ++rep) adaln_pass(p, l, 2, p->out, (const float*)(p->ws + OFF_XC), need_ctx ? TT : TL);
    }
    GBAR();
    {
      LOADP();
      Epi e{}; e.outb = (u16*)(p->ws + OFF_ACT);
      for (int rep = 0; rep <= PROBE_GEMM; ++rep) {
        const u16* W2 = (const u16*)(p->ws + OFF_WGU) + (size_t)5632 * 1024;
        if (need_ctx) {
          gemm_phase_big<0>((const u16*)(p->ws + OFF_H), 1024, W2, 1024, TT, 5632, e, smem, 1536);
          gemm_phase<0, 128>((const u16*)(p->ws + OFF_H), 1024, W2, 1024, 48 * 256, 256, e, smem, vbid, 24 * 256, 21 * 256);
        } else {
          gemm_phase_big<0>((const u16*)(p->ws + OFF_H), 1024, W2, 1024, TL, 5632, e, smem, 1280);
          gemm_phase<0, 256>((const u16*)(p->ws + OFF_H), 1024, W2, 1024, TL, 512, e, smem, vbid, 0, 20 * 256);
        }
      }
    }
    GBAR();
    {
      LOADP();
      float* xc = (float*)(p->ws + OFF_XC);
      Epi e{}; e.xs_lat = p->out; e.xs_ctx = xc; e.xd_lat = p->out; e.xd_ctx = xc;
      e.gate = (const float*)(p->ws + OFF_MOD) + (size_t)l * 9 * 9216 + 8 * 1024; e.coef = 0.5f;
      gemm_phase_big<1>((const u16*)(p->ws + OFF_ACT), DFF, (const u16*)(p->ws + OFF_WDN) + (size_t)1024 * DFF, DFF, TL, 1024, e, smem);
      if (need_ctx) gemm_phase<1, 64>((const u16*)(p->ws + OFF_ACT), DFF, (const u16*)(p->ws + OFF_WDN) + (size_t)1024 * DFF, DFF, TC, 1024, e, smem, vbid, TL);
    }
    GBAR();
    for (int rep = 0; rep < PROBE_SYNC; ++rep) GBAR();
  }
}

extern "C" void kernel_launch(void* const* d_in, const int* in_sizes, int n_in, void* d_out, int out_size, void* d_ws, size_t ws_size,
                              hipStream_t stream) {
  P p{};
  for (int i = 0; i < 37; ++i) p.in[i] = (const float*)d_in[i];
  p.out = (float*)d_out;
  p.ws = (unsigned char*)d_ws;
  p.pad_ = 0;
  static int grid_blocks = 0;
  if (!grid_blocks) {
    int dev = 0, cus = 0, per_cu = 0;
    hipGetDevice(&dev);
    hipDeviceGetAttribute(&cus, hipDeviceAttributeMultiprocessorCount, dev);
    hipOccupancyMaxActiveBlocksPerMultiprocessor(&per_cu, fwd_megakernel, 512, 0);
    if (per_cu < 1) per_cu = 1;
    grid_blocks = cus;
    if (ws_size < WS_TOTAL) fprintf(stderr, "workspace too small: %zu < %zu\n", ws_size, (size_t)WS_TOTAL);
  }
  hipMemsetAsync((unsigned char*)d_ws + OFF_CNT, 0, 256 + 14080, stream);
  void* args[] = {&p};
  hipError_t e = hipLaunchCooperativeKernel((void*)fwd_megakernel, dim3(grid_blocks), dim3(512), args, 0, stream);
  if (e != hipSuccess) fprintf(stderr, "cooperative launch failed: %s (grid %d)\n", hipGetErrorString(e), grid_blocks);
}
```
